# Optimizing an MI355X kernel written in HIP

```python
import math
import jax, jax.numpy as jnp
from jax import lax
import numpy as np

D_MODEL = 4096
BATCH = 2
SEQ = 4096
DEPTH = 1

MEM_LEN = 256
MEM_HEADS = 4
MEM_HEAD_DIM = 128
MLA_HEADS = 16
MLA_Q_RANK = 896
MLA_KV_RANK = 512
MLA_NOPE = 128
MLA_ROPE = 64
MLA_V = 128
ROPE_THETA = 10000.0
SWA_HEADS = 32
SWA_KV_HEADS = 4
SWA_HEAD_DIM = 64
WINDOW = 128
REL_BUCKETS = 32
REL_MAX_DIST = 128
D_FF = 11008
BLOCK_Q = 128
EPS = 1e-6
NEG = -1e30

MLA_QK = MLA_NOPE + MLA_ROPE
MLA_WIDTH = MLA_HEADS * MLA_V
SWA_WIDTH = SWA_HEADS * SWA_HEAD_DIM
SWA_KV_WIDTH = SWA_KV_HEADS * SWA_HEAD_DIM
SWA_GROUP = SWA_HEADS // SWA_KV_HEADS
MIX_WIDTH = MLA_WIDTH + SWA_WIDTH
IN_CQ = MLA_Q_RANK
IN_CKV = IN_CQ + MLA_KV_RANK
IN_KR = IN_CKV + MLA_ROPE
IN_SQ = IN_KR + SWA_WIDTH
IN_SK = IN_SQ + SWA_KV_WIDTH
IN_WIDTH = IN_SK + SWA_KV_WIDTH

kernel_name = "hybrid_mla_swa_macaron_layer"


def rmsnorm(x, g):
    x32 = x.astype(jnp.float32)
    y = x32 * lax.rsqrt(jnp.mean(x32 * x32, axis=-1, keepdims=True) + EPS)
    return (y * g.astype(jnp.float32)).astype(x.dtype)


def swiglu(x, w_gate, w_up, w_down):
    return (jax.nn.silu(x @ w_gate) * (x @ w_up)) @ w_down


def rope(x, pos):
    half = x.shape[-1] // 2
    inv = ROPE_THETA ** (-jnp.arange(half, dtype=jnp.float32) / half)
    ang = pos.astype(jnp.float32)[:, None] * inv[None, :]
    cos = jnp.cos(ang)[:, None, :]
    sin = jnp.sin(ang)[:, None, :]
    x32 = x.astype(jnp.float32)
    x1, x2 = x32[..., :half], x32[..., half:]
    return jnp.concatenate([x1 * cos - x2 * sin, x2 * cos + x1 * sin], axis=-1).astype(x.dtype)


def t5_bucket(dist):
    max_exact = REL_BUCKETS // 2
    d = jnp.maximum(dist, 1).astype(jnp.float32)
    large = max_exact + (jnp.log(d / max_exact) / math.log(REL_MAX_DIST / max_exact)
                         * (REL_BUCKETS - max_exact)).astype(jnp.int32)
    large = jnp.minimum(large, REL_BUCKETS - 1)
    return jnp.where(dist < max_exact, dist, large)


def mla_group(c_q, c_kv, k_rope, q_a_norm, kv_a_norm, w_uq, w_ukv, q_norm, k_norm, pos):
    B, S, _ = c_q.shape
    q = (rmsnorm(c_q, q_a_norm) @ w_uq).reshape(B, S, MLA_HEADS, MLA_QK)
    kv = (rmsnorm(c_kv, kv_a_norm) @ w_ukv).reshape(B, S, MLA_HEADS, MLA_NOPE + MLA_V)
    k_nope, v = kv[..., :MLA_NOPE], kv[..., MLA_NOPE:]
    k_r = jnp.broadcast_to(k_rope[:, :, None, :], (B, S, MLA_HEADS, MLA_ROPE))
    k = jnp.concatenate([k_nope, k_r], axis=-1)
    q = rmsnorm(q, q_norm)
    k = rmsnorm(k, k_norm)
    q = jnp.concatenate([q[..., :MLA_NOPE], rope(q[..., MLA_NOPE:], pos)], axis=-1)
    k = jnp.concatenate([k[..., :MLA_NOPE], rope(k[..., MLA_NOPE:], pos)], axis=-1)
    nb = S // BLOCK_Q
    qb = q.reshape(B, nb, BLOCK_Q, MLA_HEADS, MLA_QK).transpose(1, 0, 2, 3, 4)
    scale = MLA_QK ** -0.5
    kpos = jnp.arange(S)

    def attend(args):
        qblk, bi = args
        s = jnp.einsum('bqhd,bkhd->bhqk', qblk, k).astype(jnp.float32) * scale
        qpos = bi * BLOCK_Q + jnp.arange(BLOCK_Q)
        mask = kpos[None, :] <= qpos[:, None]
        s = jnp.where(mask[None, None], s, NEG)
        p = jax.nn.softmax(s, axis=-1).astype(v.dtype)
        return jnp.einsum('bhqk,bkhd->bqhd', p, v)

    o = lax.map(attend, (qb, jnp.arange(nb)))
    return o.transpose(1, 0, 2, 3, 4).reshape(B, S, MLA_WIDTH)


def swa_group(q, k, v, q_norm, k_norm, sinks, rel_bias):
    B, S, _ = q.shape
    nb = S // BLOCK_Q
    q = rmsnorm(q.reshape(B, S, SWA_KV_HEADS, SWA_GROUP, SWA_HEAD_DIM), q_norm)
    k = rmsnorm(k.reshape(B, S, SWA_KV_HEADS, SWA_HEAD_DIM), k_norm)
    v = v.reshape(B, S, SWA_KV_HEADS, SWA_HEAD_DIM)
    qb = q.reshape(B, nb, BLOCK_Q, SWA_KV_HEADS, SWA_GROUP, SWA_HEAD_DIM)

    def band(t):
        tb = t.reshape(B, nb, BLOCK_Q, SWA_KV_HEADS, SWA_HEAD_DIM)
        prev = jnp.pad(tb, ((0, 0), (1, 0), (0, 0), (0, 0), (0, 0)))[:, :-1]
        return jnp.concatenate([prev, tb], axis=2)

    kb, vb = band(k), band(v)
    s = jnp.einsum('bnqkgd,bnckd->bnkgqc', qb, kb).astype(jnp.float32) * (SWA_HEAD_DIM ** -0.5)
    dist = jnp.arange(BLOCK_Q)[:, None] + BLOCK_Q - jnp.arange(2 * BLOCK_Q)[None, :]
    in_window = (dist >= 0) & (dist < WINDOW)
    key_exists = (jnp.arange(nb)[:, None] * BLOCK_Q + jnp.arange(2 * BLOCK_Q)[None, :] - BLOCK_Q) >= 0
    mask = in_window[None, :, :] & key_exists[:, None, :]
    bias = rel_bias.astype(jnp.float32)[t5_bucket(jnp.maximum(dist, 0))]
    bias = bias.transpose(2, 0, 1).reshape(SWA_KV_HEADS, SWA_GROUP, BLOCK_Q, 2 * BLOCK_Q)
    s = jnp.where(mask[None, :, None, None], s + bias[None, None], NEG)
    sink = sinks.astype(jnp.float32).reshape(SWA_KV_HEADS, SWA_GROUP)[None, None, :, :, None, None]
    m = jnp.maximum(jnp.max(s, axis=-1, keepdims=True), sink)
    e = jnp.exp(s - m)
    p = (e / (jnp.sum(e, axis=-1, keepdims=True) + jnp.exp(sink - m))).astype(v.dtype)
    o = jnp.einsum('bnkgqc,bnckd->bnqkgd', p, vb)
    return o.reshape(B, S, SWA_WIDTH)


def mem_cross_attn(h, mem_n, w_q, w_kv, q_norm, k_norm, w_o):
    B, S, _ = h.shape
    M = mem_n.shape[1]
    q = rmsnorm((h @ w_q).reshape(B, S, MEM_HEADS, MEM_HEAD_DIM), q_norm)
    kv = (mem_n @ w_kv).reshape(B, M, MEM_HEADS, 2 * MEM_HEAD_DIM)
    k = rmsnorm(kv[..., :MEM_HEAD_DIM], k_norm)
    v = kv[..., MEM_HEAD_DIM:]
    s = jnp.einsum('bshd,bmhd->bhsm', q, k).astype(jnp.float32) * (MEM_HEAD_DIM ** -0.5)
    p = jax.nn.softmax(s, axis=-1).astype(v.dtype)
    o = jnp.einsum('bhsm,bmhd->bshd', p, v).reshape(B, S, MEM_HEADS * MEM_HEAD_DIM)
    return o @ w_o


def hybrid_layer(h, mem, rel_bias, p):
    S = h.shape[1]
    pos = jnp.arange(S)
    h = h + 0.5 * swiglu(rmsnorm(h, p['ffn_a_norm']), p['ffn_a_gate'], p['ffn_a_up'], p['ffn_a_down'])
    u = rmsnorm(h, p['mix_norm']) @ p['w_in']
    o_a = mla_group(u[..., :IN_CQ], u[..., IN_CQ:IN_CKV], u[..., IN_CKV:IN_KR],
                    p['mla_q_a_norm'], p['mla_kv_a_norm'], p['mla_w_uq'], p['mla_w_ukv'],
                    p['mla_q_norm'], p['mla_k_norm'], pos)
    o_b = swa_group(u[..., IN_KR:IN_SQ], u[..., IN_SQ:IN_SK], u[..., IN_SK:IN_WIDTH],
                    p['swa_q_norm'], p['swa_k_norm'], p['swa_sinks'], rel_bias)
    o = jnp.concatenate([rmsnorm(o_a, p['out_norm_mla']), rmsnorm(o_b, p['out_norm_swa'])], axis=-1)
    h = h + o @ p['w_out']
    h = h + mem_cross_attn(rmsnorm(h, p['mem_attn_norm']), rmsnorm(mem, p['mem_norm']),
                           p['mem_w_q'], p['mem_w_kv'], p['mem_q_norm'], p['mem_k_norm'], p['mem_w_o'])
    h = h + 0.5 * swiglu(rmsnorm(h, p['ffn_b_norm']), p['ffn_b_gate'], p['ffn_b_up'], p['ffn_b_down'])
    return h


def setup_inputs(seed: int = 0) -> dict:
    key = jax.random.key(seed)
    ks = iter(jax.random.split(key, 40))
    f32 = jnp.float32

    def w(shape, fan_in):
        return jax.random.normal(next(ks), (DEPTH,) + shape, f32) * (fan_in ** -0.5)

    def g(n):
        return 1.0 + 0.02 * jax.random.normal(next(ks), (DEPTH, n), f32)

    inp = {}
    inp['x'] = jax.random.normal(next(ks), (BATCH, SEQ, D_MODEL), f32)
    inp['mem'] = jax.random.normal(next(ks), (BATCH, MEM_LEN, D_MODEL), f32)
    inp['rel_bias'] = 0.5 * jax.random.normal(next(ks), (REL_BUCKETS, SWA_HEADS), f32)
    inp['ffn_a_norm'] = g(D_MODEL)
    inp['ffn_a_gate'] = w((D_MODEL, D_FF), D_MODEL)
    inp['ffn_a_up'] = w((D_MODEL, D_FF), D_MODEL)
    inp['ffn_a_down'] = w((D_FF, D_MODEL), D_FF)
    inp['mix_norm'] = g(D_MODEL)
    inp['w_in'] = w((D_MODEL, IN_WIDTH), D_MODEL)
    inp['mla_q_a_norm'] = g(MLA_Q_RANK)
    inp['mla_kv_a_norm'] = g(MLA_KV_RANK)
    inp['mla_w_uq'] = w((MLA_Q_RANK, MLA_HEADS * MLA_QK), MLA_Q_RANK)
    inp['mla_w_ukv'] = w((MLA_KV_RANK, MLA_HEADS * (MLA_NOPE + MLA_V)), MLA_KV_RANK)
    inp['mla_q_norm'] = g(MLA_QK)
    inp['mla_k_norm'] = g(MLA_QK)
    inp['swa_q_norm'] = g(SWA_HEAD_DIM)
    inp['swa_k_norm'] = g(SWA_HEAD_DIM)
    inp['swa_sinks'] = jax.random.normal(next(ks), (DEPTH, SWA_HEADS), f32)
    inp['out_norm_mla'] = g(MLA_WIDTH)
    inp['out_norm_swa'] = g(SWA_WIDTH)
    inp['w_out'] = w((MIX_WIDTH, D_MODEL), MIX_WIDTH)
    inp['mem_attn_norm'] = g(D_MODEL)
    inp['mem_norm'] = g(D_MODEL)
    inp['mem_w_q'] = w((D_MODEL, MEM_HEADS * MEM_HEAD_DIM), D_MODEL)
    inp['mem_w_kv'] = w((D_MODEL, 2 * MEM_HEADS * MEM_HEAD_DIM), D_MODEL)
    inp['mem_q_norm'] = g(MEM_HEAD_DIM)
    inp['mem_k_norm'] = g(MEM_HEAD_DIM)
    inp['mem_w_o'] = w((MEM_HEADS * MEM_HEAD_DIM, D_MODEL), MEM_HEADS * MEM_HEAD_DIM)
    inp['ffn_b_norm'] = g(D_MODEL)
    inp['ffn_b_gate'] = w((D_MODEL, D_FF), D_MODEL)
    inp['ffn_b_up'] = w((D_MODEL, D_FF), D_MODEL)
    inp['ffn_b_down'] = w((D_FF, D_MODEL), D_FF)
    return inp


def reference(x, mem, rel_bias, ffn_a_norm, ffn_a_gate, ffn_a_up, ffn_a_down, mix_norm, w_in,
              mla_q_a_norm, mla_kv_a_norm, mla_w_uq, mla_w_ukv, mla_q_norm, mla_k_norm,
              swa_q_norm, swa_k_norm, swa_sinks, out_norm_mla, out_norm_swa, w_out,
              mem_attn_norm, mem_norm, mem_w_q, mem_w_kv, mem_q_norm, mem_k_norm, mem_w_o,
              ffn_b_norm, ffn_b_gate, ffn_b_up, ffn_b_down):
    h = x
    for l in range(DEPTH):
        p = dict(
            ffn_a_norm=ffn_a_norm[l], ffn_a_gate=ffn_a_gate[l], ffn_a_up=ffn_a_up[l], ffn_a_down=ffn_a_down[l],
            mix_norm=mix_norm[l], w_in=w_in[l],
            mla_q_a_norm=mla_q_a_norm[l], mla_kv_a_norm=mla_kv_a_norm[l],
            mla_w_uq=mla_w_uq[l], mla_w_ukv=mla_w_ukv[l],
            mla_q_norm=mla_q_norm[l], mla_k_norm=mla_k_norm[l],
            swa_q_norm=swa_q_norm[l], swa_k_norm=swa_k_norm[l], swa_sinks=swa_sinks[l],
            out_norm_mla=out_norm_mla[l], out_norm_swa=out_norm_swa[l], w_out=w_out[l],
            mem_attn_norm=mem_attn_norm[l], mem_norm=mem_norm[l],
            mem_w_q=mem_w_q[l], mem_w_kv=mem_w_kv[l],
            mem_q_norm=mem_q_norm[l], mem_k_norm=mem_k_norm[l], mem_w_o=mem_w_o[l],
            ffn_b_norm=ffn_b_norm[l], ffn_b_gate=ffn_b_gate[l], ffn_b_up=ffn_b_up[l], ffn_b_down=ffn_b_down[l],
        )
        h = hybrid_layer(h, mem, rel_bias, p)
    return h
```

```cpp
#include <hip/hip_runtime.h>
#include <cstdio>
#include <cstdint>

#ifndef MK_N_LAUNCHES
#define MK_N_LAUNCHES 19
#endif

#define GAS __attribute__((address_space(1)))
#define LAS __attribute__((address_space(3)))
typedef unsigned short bf16_t;
typedef short bf16x8 __attribute__((ext_vector_type(8)));
typedef short s16x4 __attribute__((ext_vector_type(4)));
typedef float f32x4 __attribute__((ext_vector_type(4)));
typedef float f32x16 __attribute__((ext_vector_type(16)));
typedef unsigned u32x4 __attribute__((ext_vector_type(4)));
typedef unsigned u32x2 __attribute__((ext_vector_type(2)));
typedef float f32x2_t __attribute__((ext_vector_type(2)));
typedef __bf16 bf16x2_t __attribute__((ext_vector_type(2)));
typedef GAS unsigned gu32;

#define LDS_WAIT() asm volatile("s_waitcnt lgkmcnt(0)" ::: "memory")
#define VM_WAIT() asm volatile("s_waitcnt vmcnt(0)" ::: "memory")
#define RLX_AGENT __ATOMIC_RELAXED, __HIP_MEMORY_SCOPE_AGENT

__device__ __forceinline__ unsigned cvtpk(float lo, float hi) { f32x2_t v = {lo, hi}; bf16x2_t b = __builtin_convertvector(v, bf16x2_t); return __builtin_bit_cast(unsigned, b); }
__device__ __forceinline__ float fast_exp2(float x) { return __builtin_amdgcn_exp2f(x); }
__device__ __forceinline__ float fast_rcp(float x) { return __builtin_amdgcn_rcpf(x); }
__device__ __forceinline__ float rsq(float x) { return 1.0f / __builtin_sqrtf(x); }

constexpr int SEQ = 4096, NB = 2, M = NB * SEQ, D = 4096, FF = 11008;
constexpr int MEML = 256, MROWS = NB * MEML;
constexpr int CQ = 896, CKV = 512, KRD = 64, INW = 4032;
constexpr int MLA_H = 16, MLA_QK = 192, MLA_NOPE = 128, MLA_V = 128;
constexpr int SWA_H = 32, SWA_KVH = 4, SWA_D = 64;
constexpr int MEM_H = 4, MEM_D = 128;
constexpr int NQ = MLA_H * MLA_QK;
constexpr int NKN = MLA_H * MLA_NOPE;
constexpr int NV = MLA_H * MLA_V;
constexpr int SWAW = SWA_H * SWA_D;
constexpr int SWAKW = SWA_KVH * SWA_D;
constexpr float EPS = 1e-6f;
constexpr float LOG2E = 1.4426950408889634f;
constexpr float NEGBIG = -1e30f;

constexpr size_t MiB = 1u << 20;
constexpr size_t WS_CTL = 0, CTL_ZERO_BYTES = 1 * MiB;
constexpr size_t WS_ROPE = 1 * MiB;
constexpr size_t WS_BIAS = 2 * MiB;
constexpr size_t WS_WGU_A = 4 * MiB;
constexpr size_t WS_WD_A = 176 * MiB;
constexpr size_t WS_WGU_B = 262 * MiB;
constexpr size_t WS_WD_B = 434 * MiB;
constexpr size_t WS_WIN = 520 * MiB;
constexpr size_t WS_WUQ = 552 * MiB;
constexpr size_t WS_WKN = 558 * MiB;
constexpr size_t WS_WV = 560 * MiB;
constexpr size_t WS_WOUT = 562 * MiB;
constexpr size_t WS_WMQ = 594 * MiB;
constexpr size_t WS_WMKV = 598 * MiB;
constexpr size_t WS_WMO = 606 * MiB;
constexpr size_t WS_XN = 610 * MiB;
constexpr size_t WS_ACT = 674 * MiB;
constexpr size_t WS_U = WS_ACT;
constexpr size_t WS_QRAW = WS_ACT;
constexpr size_t WS_KNRAW = WS_ACT + 96 * MiB;
constexpr size_t WS_O = WS_ACT;
constexpr size_t WS_QMP = WS_ACT;
constexpr size_t WS_QF = 846 * MiB;
constexpr size_t WS_KF = 894 * MiB;
constexpr size_t WS_VF = 942 * MiB;
constexpr size_t WS_QS = 974 * MiB;
constexpr size_t WS_KS = 1006 * MiB;
constexpr size_t WS_VS = 1010 * MiB;
constexpr size_t WS_CQN = 1014 * MiB;
constexpr size_t WS_CKVN = 1028 * MiB;
constexpr size_t WS_KRB = 1036 * MiB;
constexpr size_t WS_MEMN = 1038 * MiB;
constexpr size_t WS_KVM = 1042 * MiB;
constexpr size_t WS_KM = 1044 * MiB;
constexpr size_t WS_VM = 1044 * MiB + 512 * 1024;
constexpr size_t WS_QM = 1045 * MiB;
constexpr size_t WS_OM = 1053 * MiB;
constexpr size_t WS_END = 1061 * MiB;
constexpr int CW_TMO = 0;
constexpr int CW_BAR = 4096;

constexpr int RING_BYTES = 131072;
constexpr int MISC_OFF = RING_BYTES + 320;
constexpr int LDS_BYTES = 147456;
constexpr int NWAVES = 8;

namespace pg8 {
constexpr int BM = 256, BK = 64, HALF = 128, HTB = HALF * BK * 2, NXCD = 8, WGM = 8;
__host__ __device__ __forceinline__ int lds_byte(int r, int c) { const int st = (r >> 4) * 2 + (c >> 5), rr = r & 15, cc = c & 31, ob = rr * 64 + cc * 2; return st * 1024 + (ob ^ (((ob >> 9) & 1) << 5)); }
__host__ __device__ __forceinline__ void stage_rc(int b, int& R, int& C) { const int st = b / 1024, sb = b % 1024, swz = sb ^ (((sb >> 9) & 1) << 5); R = (st >> 1) * 16 + swz / 64; C = (st & 1) * 32 + (swz % 64) / 2; }
__host__ __device__ __forceinline__ int perm32(int rho) { const int n = rho >> 4, i = rho & 15; return 8 * (i >> 2) + 4 * n + (i & 3); }

struct Unit { int pm, pn, ks; };
struct Gemm { const bf16_t* A; const bf16_t* Bt; int lda, ldb, K; };

struct StaticOrder {
    int nM, nN, nwg, G, c;
    __device__ void init(int M_, int N_, int G_, int c_) { nM = M_ / BM; nN = N_ / BM; nwg = nM * nN; G = G_; c = c_; }
    __device__ bool next(int i, Unit& u) const {
        const long L = (long)i * G + c; if (L >= nwg) return false;
        int wgid = (int)L; { const int q = nwg / NXCD, r = nwg % NXCD, xcd = wgid % NXCD, off = wgid / NXCD; wgid = (xcd < r ? xcd * (q + 1) : r * (q + 1) + (xcd - r) * q) + off; }
        const int nig = WGM * nN, gid = wgid / nig, fm = gid * WGM, gsz = (nM - fm) < WGM ? (nM - fm) : WGM;
        u.pm = fm + ((wgid % nig) % gsz); u.pn = (wgid % nig) / gsz; u.ks = 0; return true;
    }
};
struct OffsetOrder {
    int n, c0, G, c, nN, nS;
    __device__ void init(int nM_, int nN_, int nS_, int G_, int c_, int c0_) { n = nM_ * nN_ * nS_; nN = nN_; nS = nS_; G = G_; c = c_; c0 = c0_; }
    __device__ bool next(int i, Unit& u) const {
        const int rel = (c - c0 + G) % G; const long L = (long)i * G + rel; if (L >= n) return false;
        const int t = (int)L; u.ks = t % nS; const int q = t / nS; u.pn = q % nN; u.pm = q / nN; return true;
    }
};

struct EpiF32 {
    static constexpr bool PERM = false;
    float* C; int ldc; size_t split_stride;
    __device__ __forceinline__ void operator()(const f32x4 (&acc)[2][2][4][2], const Unit& u, int wr, int wc, int fr, int fq) const {
        const int row0 = u.pm * BM + wr * 64 + fr, col0 = u.pn * BM + wc * 32 + 4 * fq;
        float* Cb = C + (size_t)u.ks * split_stride;
#pragma unroll
        for (int ai = 0; ai < 2; ++ai)
#pragma unroll
            for (int m = 0; m < 4; ++m) { float* rowp = Cb + (size_t)(row0 + ai * HALF + m * 16) * ldc + col0;
#pragma unroll
                for (int bj = 0; bj < 2; ++bj)
#pragma unroll
                    for (int n = 0; n < 2; ++n) *(f32x4*)(rowp + bj * HALF + n * 16) = acc[ai][bj][m][n]; }
    }
};
struct EpiRes {
    static constexpr bool PERM = false;
    const float* base; float* out; int ldc; float alpha;
    __device__ __forceinline__ void operator()(const f32x4 (&acc)[2][2][4][2], const Unit& u, int wr, int wc, int fr, int fq) const {
        const int row0 = u.pm * BM + wr * 64 + fr, col0 = u.pn * BM + wc * 32 + 4 * fq;
#pragma unroll
        for (int ai = 0; ai < 2; ++ai)
#pragma unroll
            for (int m = 0; m < 4; ++m) { const size_t off = (size_t)(row0 + ai * HALF + m * 16) * ldc + col0;
                f32x4 b[2][2];
#pragma unroll
                for (int bj = 0; bj < 2; ++bj)
#pragma unroll
                    for (int n = 0; n < 2; ++n) b[bj][n] = *(const f32x4*)(base + off + bj * HALF + n * 16);
#pragma unroll
                for (int bj = 0; bj < 2; ++bj)
#pragma unroll
                    for (int n = 0; n < 2; ++n) *(f32x4*)(out + off + bj * HALF + n * 16) = b[bj][n] + acc[ai][bj][m][n] * alpha; }
    }
};
struct EpiBf16 {
    static constexpr bool PERM = true;
    bf16_t* O; int ldc;
    __device__ __forceinline__ void operator()(const f32x4 (&acc)[2][2][4][2], const Unit& u, int wr, int wc, int fr, int fq) const {
        const int row0 = u.pm * BM + wr * 64 + fr, col0 = u.pn * BM + wc * 32 + 8 * fq;
#pragma unroll
        for (int ai = 0; ai < 2; ++ai)
#pragma unroll
            for (int m = 0; m < 4; ++m) { bf16_t* rowp = O + (size_t)(row0 + ai * HALF + m * 16) * ldc + col0;
#pragma unroll
                for (int bj = 0; bj < 2; ++bj) { const f32x4 v0 = acc[ai][bj][m][0], v1 = acc[ai][bj][m][1];
                    u32x4 w; w.x = cvtpk(v0[0], v0[1]); w.y = cvtpk(v0[2], v0[3]); w.z = cvtpk(v1[0], v1[1]); w.w = cvtpk(v1[2], v1[3]);
                    *(u32x4*)(rowp + bj * HALF) = w; } }
    }
};
struct EpiSwiGLU {
    static constexpr bool PERM = true;
    bf16_t* O; int ldc;
    __device__ __forceinline__ float sw(float g, float up) const { return g * fast_rcp(1.0f + fast_exp2(-LOG2E * g)) * up; }
    __device__ __forceinline__ void operator()(const f32x4 (&acc)[2][2][4][2], const Unit& u, int wr, int wc, int fr, int fq) const {
        const int row0 = u.pm * BM + wr * 64 + fr, col0 = u.pn * HALF + wc * 32 + 8 * fq;
#pragma unroll
        for (int ai = 0; ai < 2; ++ai)
#pragma unroll
            for (int m = 0; m < 4; ++m) { bf16_t* rowp = O + (size_t)(row0 + ai * HALF + m * 16) * ldc + col0;
                const f32x4 g0 = acc[ai][0][m][0], g1 = acc[ai][0][m][1], u0 = acc[ai][1][m][0], u1 = acc[ai][1][m][1];
                u32x4 w; w.x = cvtpk(sw(g0[0], u0[0]), sw(g0[1], u0[1])); w.y = cvtpk(sw(g0[2], u0[2]), sw(g0[3], u0[3]));
                w.z = cvtpk(sw(g1[0], u1[0]), sw(g1[1], u1[1])); w.w = cvtpk(sw(g1[2], u1[2]), sw(g1[3], u1[3]));
                *(u32x4*)rowp = w; }
    }
};

template <class Epi, class Sched, bool ALIGN_EPI>
__device__ __forceinline__ void gemm_phase(LAS unsigned char* lds, const Gemm g, const Sched& S, const Epi& E) {
    const int tid = threadIdx.x, wid = __builtin_amdgcn_readfirstlane(tid >> 6), lane = tid & 63, wr = wid >> 2, wc = wid & 3, fr = lane & 15, fq = lane >> 4;
    const int K = g.K, nt = K / BK;
    unsigned voffA[2], voffB[2];
#pragma unroll
    for (int i = 0; i < 2; ++i) { int R, C; stage_rc(tid * 16 + i * 8192, R, C); const int Rb = Epi::PERM ? ((R & ~31) + perm32(R & 31)) : R;
        voffA[i] = (unsigned)(R * g.lda + C) * 2u; voffB[i] = (unsigned)(Rb * g.ldb + C) * 2u; }
    const size_t kstep = (size_t)(BK * 2);
    const size_t hstepA = (size_t)HALF * g.lda * 2, hstepB = (size_t)HALF * g.ldb * 2;
    const size_t tstepA = 2 * hstepA, tstepB = 2 * hstepB;
    const unsigned ldsw = (unsigned)wid * 1024u;
    const int aoff = lds_byte(wr * 64 + fr, fq * 8), boff = lds_byte(wc * 32 + fr, fq * 8);
#define PG8_SA(b, h) (((b) * 2 + (h)) * HTB)
#define PG8_SB(b, h) ((4 + (b) * 2 + (h)) * HTB)
#define PG8_STAGE(bufoff, gbase, voff) do { _Pragma("unroll") for (int _i = 0; _i < 2; ++_i) \
        __builtin_amdgcn_global_load_lds((const unsigned*)((const char*)(gbase) + (voff)[_i]), (LAS unsigned*)(lds + (bufoff) + ldsw + _i * 8192), 16, 0, 0); } while (0)
#define PG8_LDA(dst, b, h) do { _Pragma("unroll") for (int m = 0; m < 4; ++m) _Pragma("unroll") for (int k = 0; k < 2; ++k) dst[m][k] = *(const LAS bf16x8*)(lds + PG8_SA(b, h) + aoff + m * 2048 + k * 1024); } while (0)
#define PG8_LDB(dst, b, h) do { _Pragma("unroll") for (int n = 0; n < 2; ++n) _Pragma("unroll") for (int k = 0; k < 2; ++k) dst[n][k] = *(const LAS bf16x8*)(lds + PG8_SB(b, h) + boff + n * 2048 + k * 1024); } while (0)
#define PG8_MMA(ai, bj, At, Bt) do { __builtin_amdgcn_s_setprio(1); _Pragma("unroll") for (int m = 0; m < 4; ++m) _Pragma("unroll") for (int n = 0; n < 2; ++n) _Pragma("unroll") for (int k = 0; k < 2; ++k) \
        acc[ai][bj][m][n] = __builtin_amdgcn_mfma_f32_16x16x32_bf16(Bt[n][k], At[m][k], acc[ai][bj][m][n], 0, 0, 0); __builtin_amdgcn_s_setprio(0); } while (0)
#define PG8_WAIT_V(n) asm volatile("s_waitcnt vmcnt(" #n ")" ::: "memory")
#define PG8_WAIT_L(n) asm volatile("s_waitcnt lgkmcnt(" #n ")" ::: "memory")
#define PG8_BAR __builtin_amdgcn_s_barrier()
#define PG8_SCHED __builtin_amdgcn_sched_barrier(0)
    Unit cur, nxt; int ui = 0;
    if (!S.next(0, cur)) return;
    f32x4 acc[2][2][4][2];
#pragma unroll
    for (int a = 0; a < 2; ++a)
#pragma unroll
        for (int b = 0; b < 2; ++b)
#pragma unroll
            for (int m = 0; m < 4; ++m)
#pragma unroll
                for (int n = 0; n < 2; ++n) acc[a][b][m][n] = (f32x4){0.f, 0.f, 0.f, 0.f};
    bf16x8 At[4][2], B0[2][2], B1[2][2];
    const char* cA = (const char*)g.A + (size_t)cur.pm * tstepA + (size_t)cur.ks * K * 2; const char* cB = (const char*)g.Bt + (size_t)cur.pn * tstepB + (size_t)cur.ks * K * 2;
    PG8_STAGE(PG8_SB(0, 0), cB, voffB); PG8_STAGE(PG8_SB(0, 1), cB + hstepB, voffB); PG8_STAGE(PG8_SA(0, 0), cA, voffA); PG8_STAGE(PG8_SA(0, 1), cA + hstepA, voffA);
    if (wr == 1) PG8_BAR;
    PG8_WAIT_V(2); PG8_BAR;
    PG8_STAGE(PG8_SB(1, 0), cB + kstep, voffB); PG8_STAGE(PG8_SA(1, 0), cA + kstep, voffA); PG8_STAGE(PG8_SB(1, 1), cB + hstepB + kstep, voffB);
    PG8_WAIT_V(6); PG8_BAR;
    for (;;) {
        const bool has_next = S.next(ui + 1, nxt);
        const char* nA = has_next ? (const char*)g.A + (size_t)nxt.pm * tstepA + (size_t)nxt.ks * K * 2 : cA;
        const char* nB = has_next ? (const char*)g.Bt + (size_t)nxt.pn * tstepB + (size_t)nxt.ks * K * 2 : cB;
        for (int t = 0; t < nt; t += 2) {
            const bool last = (t == nt - 2);
            const char* a1 = cA + (size_t)(t + 1) * kstep;
            const char* a2 = last ? nA : cA + (size_t)(t + 2) * kstep; const char* b2 = last ? nB : cB + (size_t)(t + 2) * kstep;
            const char* a3 = a2 + kstep; const char* b3 = b2 + kstep;
            PG8_LDB(B0, 0, 0); PG8_LDB(B1, 0, 1); PG8_SCHED; PG8_LDA(At, 0, 0); PG8_STAGE(PG8_SA(1, 1), a1 + hstepA, voffA);
            PG8_WAIT_V(8); PG8_WAIT_L(0); PG8_BAR; PG8_MMA(0, 0, At, B0); PG8_MMA(0, 1, At, B1); PG8_BAR; PG8_SCHED;
            PG8_LDA(At, 0, 1); PG8_STAGE(PG8_SB(0, 0), b2, voffB); PG8_STAGE(PG8_SB(0, 1), b2 + hstepB, voffB); PG8_STAGE(PG8_SA(0, 0), a2, voffA);
            PG8_WAIT_V(8); PG8_WAIT_L(0); PG8_BAR; PG8_MMA(1, 0, At, B0); PG8_MMA(1, 1, At, B1); PG8_BAR; PG8_SCHED;
            PG8_LDB(B0, 1, 0); PG8_LDB(B1, 1, 1); PG8_SCHED; PG8_LDA(At, 1, 0); PG8_STAGE(PG8_SA(0, 1), a2 + hstepA, voffA);
            PG8_WAIT_V(8); PG8_WAIT_L(0); PG8_BAR; PG8_MMA(0, 0, At, B0); PG8_MMA(0, 1, At, B1); PG8_BAR; PG8_SCHED;
            PG8_LDA(At, 1, 1); PG8_STAGE(PG8_SB(1, 0), b3, voffB); PG8_STAGE(PG8_SB(1, 1), b3 + hstepB, voffB); PG8_STAGE(PG8_SA(1, 0), a3, voffA);
            PG8_WAIT_V(8); PG8_WAIT_L(0); PG8_BAR; PG8_MMA(1, 0, At, B0); PG8_MMA(1, 1, At, B1); PG8_BAR; PG8_SCHED;
        }
        if constexpr (ALIGN_EPI) { if (wr == 0) PG8_BAR; }
        E(acc, cur, wr, wc, fr, fq);
        if (!has_next) break;
#pragma unroll
        for (int a = 0; a < 2; ++a)
#pragma unroll
            for (int b = 0; b < 2; ++b)
#pragma unroll
                for (int m = 0; m < 4; ++m)
#pragma unroll
                    for (int n = 0; n < 2; ++n) acc[a][b][m][n] = (f32x4){0.f, 0.f, 0.f, 0.f};
        cur = nxt; cA = nA; cB = nB; ++ui;
        if constexpr (ALIGN_EPI) { if (wr == 1) PG8_BAR; }
    }
    PG8_WAIT_V(0);
    if constexpr (!ALIGN_EPI) { if (wr == 0) PG8_BAR; }
    PG8_BAR;
#undef PG8_SA
#undef PG8_SB
#undef PG8_STAGE
#undef PG8_LDA
#undef PG8_LDB
#undef PG8_MMA
#undef PG8_WAIT_V
#undef PG8_WAIT_L
#undef PG8_BAR
#undef PG8_SCHED
}
}

#define XB_TMO      128
#define XB_XCNT(j)  (256  + 64 * (j))
#define XB_XSUB(j)  (1280 + 64 * (j))
#define XB_XGEN(j)  (2304 + 64 * (j))
#define XB_TOP      3328
#define XB_TOPGEN   3392
#define XCD_BAR_WORDS 3456
#define XB_SPIN_CAP (1u << 18)
__device__ __forceinline__ unsigned xb_ld(unsigned* p)              { return __hip_atomic_load(p, __ATOMIC_RELAXED, __HIP_MEMORY_SCOPE_AGENT); }
__device__ __forceinline__ unsigned xb_add(unsigned* p, unsigned v) { return __hip_atomic_fetch_add(p, v, __ATOMIC_RELAXED, __HIP_MEMORY_SCOPE_AGENT); }
__device__ __forceinline__ unsigned xb_xcc_id() { return (unsigned)__builtin_amdgcn_s_getreg((3 << 11) | 20) & 0xFu; }
#define XB_SPIN(cond, bar) do { unsigned _sp = 0; while (cond) { __builtin_amdgcn_s_sleep(1); \
    if ((++_sp & 255u) == 0u) { if (xb_ld(&(bar)[XB_TMO])) break; if (_sp > XB_SPIN_CAP) { atomicAdd(&(bar)[XB_TMO], 1u); break; } } } } while (0)
struct XcdBarrier { unsigned* bar; unsigned x; volatile LAS unsigned* st; };
__device__ __forceinline__ XcdBarrier xcd_barrier_post(unsigned* bar, volatile LAS unsigned* st) {
    XcdBarrier b; b.bar = bar; b.x = xb_xcc_id(); b.st = st;
    if (threadIdx.x == 0) (void)xb_add(&bar[XB_XCNT(b.x)], 1u);
    return b;
}
__device__ __forceinline__ void xcd_barrier_complete(unsigned* bar, unsigned x, unsigned& nloc, unsigned& nx) {
    const unsigned G = gridDim.x * gridDim.y * gridDim.z;
    unsigned sum, cnt, mine, sp = 0u;
    for (;;) {
        sum = 0u; cnt = 0u; mine = 0u;
#pragma unroll
        for (unsigned j = 0; j < 16; ++j) { const unsigned c = xb_ld(&bar[XB_XCNT(j)]); sum += c; cnt += (c > 0u) ? 1u : 0u; mine = (j == x) ? c : mine; }
        if (sum == G) break;
        __builtin_amdgcn_s_sleep(1);
        if ((++sp & 255u) == 0u) { if (xb_ld(&bar[XB_TMO])) break; if (sp > XB_SPIN_CAP) { atomicAdd(&bar[XB_TMO], 1u); break; } }
    }
    nloc = mine > 0u ? mine : 1u; nx = cnt > 0u ? cnt : 1u;
}
__device__ __forceinline__ void xcd_barrier(const XcdBarrier& b) {
    asm volatile("s_waitcnt vmcnt(0)" ::: "memory");
    __syncthreads();
    if (threadIdx.x == 0) {
        unsigned* bar = b.bar;
        __builtin_amdgcn_s_waitcnt(0);
        unsigned nloc = b.st[0], nx = b.st[1];
        if (nloc == 0u) { xcd_barrier_complete(bar, b.x, nloc, nx); b.st[0] = nloc; b.st[1] = nx; }
        const unsigned old = xb_add(&bar[XB_XSUB(b.x)], 1u);
        const unsigned gen = old / nloc;
        if (old + 1u == (gen + 1u) * nloc) {
            __builtin_amdgcn_fence(__ATOMIC_RELEASE, "agent");
            asm volatile("s_waitcnt vmcnt(0)" ::: "memory");
            const unsigned og = xb_add(&bar[XB_TOP], 1u);
            const unsigned tg = og / nx;
            if (og + 1u == (tg + 1u) * nx) xb_add(&bar[XB_TOPGEN], 1u);
            else XB_SPIN(xb_ld(&bar[XB_TOPGEN]) == tg, bar);
            __builtin_amdgcn_fence(__ATOMIC_ACQUIRE, "agent");
            xb_add(&bar[XB_XGEN(b.x)], 1u);
            asm volatile("s_waitcnt vmcnt(0)" ::: "memory");
        } else {
            XB_SPIN(xb_ld(&bar[XB_XGEN(b.x)]) == gen, bar);
            __builtin_amdgcn_fence(__ATOMIC_ACQUIRE, "agent");
            asm volatile("s_waitcnt vmcnt(0)" ::: "memory");
        }
    }
    __syncthreads();
}

__device__ __forceinline__ float wave_sum(float v) {
#pragma unroll
    for (int o = 1; o < 64; o <<= 1) v += __shfl_xor(v, o);
    return v;
}
__device__ __forceinline__ float g16_sum(float v) {
#pragma unroll
    for (int o = 1; o < 16; o <<= 1) v += __shfl_xor(v, o);
    return v;
}
__device__ __forceinline__ float sq4(f32x4 v) { return (v.x * v.x + v.y * v.y) + (v.z * v.z + v.w * v.w); }
__device__ __forceinline__ u32x2 pack4(f32x4 v) { u32x2 w; w.x = cvtpk(v.x, v.y); w.y = cvtpk(v.z, v.w); return w; }

__device__ __forceinline__ void xpose_item(const float* W, int srcN, int col0, int K, bf16_t* WT, int dst_row0, int k0, LAS float* scr, int lane) {
    if (col0 >= 0) {
#pragma unroll 8
        for (int i = 0; i < 32; ++i) { const int kk = 2 * i + (lane >> 5); scr[kk * 33 + (lane & 31)] = W[(size_t)(k0 + kk) * srcN + col0 + (lane & 31)]; }
    } else {
#pragma unroll 8
        for (int i = 0; i < 32; ++i) { const int kk = 2 * i + (lane >> 5); scr[kk * 33 + (lane & 31)] = 0.f; }
    }
    LDS_WAIT(); asm volatile("" ::: "memory");
    const int c = lane & 7;
#pragma unroll
    for (int j = 0; j < 4; ++j) { const int n = (lane >> 3) + 8 * j; const LAS float* s = scr + (8 * c) * 33 + n;
        u32x4 o; o.x = cvtpk(s[0 * 33], s[1 * 33]); o.y = cvtpk(s[2 * 33], s[3 * 33]); o.z = cvtpk(s[4 * 33], s[5 * 33]); o.w = cvtpk(s[6 * 33], s[7 * 33]);
        *(GAS u32x4*)(WT + (size_t)(dst_row0 + n) * K + k0 + 8 * c) = o; }
    LDS_WAIT(); asm volatile("" ::: "memory");
}
__device__ __forceinline__ void rms_row4096(const float* xrow, const float* gain, bf16_t* orow, int lane) {
    const f32x4* xr = (const f32x4*)xrow + lane; const f32x4* gr = (const f32x4*)gain + lane;
    f32x4 v[16]; float s = 0.f;
#pragma unroll
    for (int j = 0; j < 16; ++j) { v[j] = xr[64 * j]; s += sq4(v[j]); }
    const float rstd = rsq(wave_sum(s) * (1.f / 4096.f) + EPS);
    u32x2* o8 = (u32x2*)orow + lane;
#pragma unroll
    for (int j = 0; j < 16; ++j) { const f32x4 gg = gr[64 * j]; o8[64 * j] = pack4(v[j] * rstd * gg); }
}

template <int DQK, int DV> struct ACfg {
    static constexpr int PK = DQK * 2 + 16, PV = DV * 2 + 64;
    static constexpr int KT = 64 * PK, VT = 64 * PV, STAGE = KT + VT;
    static constexpr int KCH = DQK / 8, VCH = DV / 8, NKL = 64 * KCH / 512, NVL = 64 * VCH / 512;
};
#define MFMA32(a, b, c) __builtin_amdgcn_mfma_f32_32x32x16_bf16((a), (b), (c), 0, 0, 0)
__device__ __forceinline__ s16x4 vtr(const LAS unsigned char* p) { return __builtin_bit_cast(s16x4, __builtin_amdgcn_ds_read_tr16_b64_v4i16((LAS s16x4*)p)); }

template <int DQK, int DV, int MODE, bool OBF16>
__device__ __forceinline__ void attn_unit(LAS unsigned char* lds, int tid, int lane,
                                          const bf16_t* Qw, int qpitch, const bf16_t* Kb, int kpitch, const bf16_t* Vb, int vpitch,
                                          void* Ow, int opitch, int q0, int jt0, int jt1, float m_init, float l_init, const LAS float* biasw) {
    using C = ACfg<DQK, DV>;
    const int r = lane & 31, h = lane >> 5;
    bf16x8 qf[DQK / 16];
#pragma unroll
    for (int ks = 0; ks < DQK / 16; ++ks) qf[ks] = *(const bf16x8*)(Qw + (size_t)r * qpitch + ks * 16 + h * 8);
    f32x16 O[DV / 32];
#pragma unroll
    for (int d = 0; d < DV / 32; ++d)
#pragma unroll
        for (int i = 0; i < 16; ++i) O[d][i] = 0.f;
    float m = m_init, l = (h == 0) ? l_init : 0.f;
    u32x4 kst[C::NKL], vst[C::NVL];
    unsigned kgo[C::NKL], vgo[C::NVL];
#pragma unroll
    for (int i = 0; i < C::NKL; ++i) { const int c = tid + 512 * i, row = c / C::KCH, cc = c % C::KCH; kgo[i] = (unsigned)(row * kpitch + cc * 8) * 2u; }
#pragma unroll
    for (int i = 0; i < C::NVL; ++i) { const int c = tid + 512 * i, row = c / C::VCH, cc = c % C::VCH; vgo[i] = (unsigned)(row * vpitch + cc * 8) * 2u; }
#define ATT_LOAD(jt) do { const char* kt_ = (const char*)Kb + (size_t)(jt) * 64 * kpitch * 2; const char* vt_ = (const char*)Vb + (size_t)(jt) * 64 * vpitch * 2; \
        _Pragma("unroll") for (int i = 0; i < C::NKL; ++i) kst[i] = *(const u32x4*)(kt_ + kgo[i]); \
        _Pragma("unroll") for (int i = 0; i < C::NVL; ++i) vst[i] = *(const u32x4*)(vt_ + vgo[i]); } while (0)
#define ATT_STORE(buf) do { \
        _Pragma("unroll") for (int i = 0; i < C::NKL; ++i) { const int c = tid + 512 * i, row = c / C::KCH, cc = c % C::KCH; *(LAS u32x4*)(lds + (buf) * C::STAGE + row * C::PK + cc * 16) = kst[i]; } \
        _Pragma("unroll") for (int i = 0; i < C::NVL; ++i) { const int c = tid + 512 * i, row = c / C::VCH, cc = c % C::VCH; *(LAS u32x4*)(lds + (buf) * C::STAGE + C::KT + row * C::PV + cc * 16) = vst[i]; } } while (0)
    __syncthreads();
    ATT_LOAD(jt0); ATT_STORE(0);
    for (int jt = jt0; jt < jt1; ++jt) {
        const int buf = (jt - jt0) & 1;
        __syncthreads();
        const bool more = (jt + 1 < jt1);
        if (more) ATT_LOAD(jt + 1);
        const bool active = (MODE == 1) ? (jt * 64 <= q0 + 31) : true;
        if (active) {
            const LAS unsigned char* kb_ = lds + buf * C::STAGE; const LAS unsigned char* vb_ = kb_ + C::KT;
            const int qpos = q0 + r;
#pragma unroll 1
            for (int kb = 0; kb < 2; ++kb) {
                if (MODE == 1 && jt * 64 + 32 * kb > q0 + 31) break;
                f32x16 S;
#pragma unroll
                for (int i = 0; i < 16; ++i) S[i] = 0.f;
                const LAS unsigned char* kp = kb_ + (32 * kb + r) * C::PK + h * 16;
#pragma unroll
                for (int ks = 0; ks < DQK / 16; ++ks) { const bf16x8 a0 = *(const LAS bf16x8*)(kp + ks * 32); S = MFMA32(a0, qf[ks], S); }
                const int kbase = jt * 64 + 32 * kb + 4 * h;
                if (MODE == 1) {
                    if (kbase - 4 * h + 31 > q0) {
#pragma unroll
                        for (int i = 0; i < 16; ++i) { const int key = kbase + (i & 3) + 8 * (i >> 2); if (key > qpos) S[i] = NEGBIG; }
                    }
                }
                if (MODE == 2) {
#pragma unroll
                    for (int i = 0; i < 16; ++i) { const int d0 = qpos - (kbase + (i & 3) + 8 * (i >> 2));
                        const float b0 = biasw[d0 & 127];
                        S[i] = ((unsigned)d0 < 128u) ? S[i] + b0 : NEGBIG; }
                }
                float mx = S[0];
#pragma unroll
                for (int i = 1; i < 16; ++i) mx = fmaxf(mx, S[i]);
                mx = fmaxf(mx, __shfl_xor(mx, 32));
                const float mn = fmaxf(m, mx); const float alpha = fast_exp2(m - mn); m = mn;
                float ps = 0.f;
#pragma unroll
                for (int i = 0; i < 16; ++i) { S[i] = fast_exp2(S[i] - mn); ps += S[i]; }
                l = l * alpha + ps;
#pragma unroll
                for (int d = 0; d < DV / 32; ++d)
#pragma unroll
                    for (int i = 0; i < 16; ++i) O[d][i] *= alpha;
                bf16x8 pf[2];
#pragma unroll
                for (int t = 0; t < 2; ++t) { u32x4 w; const int o = 8 * t;
                    w.x = cvtpk(S[o], S[o + 1]); w.y = cvtpk(S[o + 2], S[o + 3]); w.z = cvtpk(S[o + 4], S[o + 5]); w.w = cvtpk(S[o + 6], S[o + 7]);
                    pf[t] = __builtin_bit_cast(bf16x8, w); }
                const LAS unsigned char* vp = vb_ + (32 * kb + 4 * h + ((lane & 15) >> 2)) * C::PV + ((lane >> 4) & 1) * 32 + (lane & 3) * 8;
#pragma unroll
                for (int d = 0; d < DV / 32; ++d)
#pragma unroll
                    for (int t = 0; t < 2; ++t) { const s16x4 lo = vtr(vp + t * 16 * C::PV + d * 64), hi = vtr(vp + t * 16 * C::PV + 8 * C::PV + d * 64);
                        const bf16x8 vf = {lo.x, lo.y, lo.z, lo.w, hi.x, hi.y, hi.z, hi.w};
                        O[d] = MFMA32(vf, pf[t], O[d]); }
            }
        }
        if (more) ATT_STORE(buf ^ 1);
    }
#undef ATT_LOAD
#undef ATT_STORE
    l += __shfl_xor(l, 32);
    const float inv = 1.0f / l;
#pragma unroll
    for (int d = 0; d < DV / 32; ++d)
#pragma unroll
        for (int tq = 0; tq < 4; ++tq) { const int dv = 32 * d + 8 * tq + 4 * h;
            const f32x4 o = (f32x4){O[d][4 * tq], O[d][4 * tq + 1], O[d][4 * tq + 2], O[d][4 * tq + 3]} * inv;
            if (OBF16) *(u32x2*)((bf16_t*)Ow + (size_t)r * opitch + dv) = pack4(o);
            else *(f32x4*)((float*)Ow + (size_t)r * opitch + dv) = o; }
}

constexpr int NPHASE = 19;
struct Args { const float* in[32]; float* out; unsigned char* ws; int ph_lo, ph_hi; };
static_assert(sizeof(Args) == 32 * 8 + 8 + 8 + 8, "Args has no padding");

__global__ void __launch_bounds__(NWAVES * 64, 2) fwd_kernel(Args args) {
    extern __shared__ __attribute__((aligned(16))) unsigned char lds_raw[];
    LAS unsigned char* lds = (LAS unsigned char*)lds_raw;
    volatile LAS unsigned* MISC = (volatile LAS unsigned*)(lds + MISC_OFF);
    const int tid = threadIdx.x, lane = tid & 63, wave = __builtin_amdgcn_readfirstlane(tid >> 6);
    const int G = gridDim.x; const int bx = blockIdx.x; const int vcu = (G % 8 == 0) ? (bx % 8) * (G / 8) + bx / 8 : bx;
    const int gw = vcu * NWAVES + wave, NGW = G * NWAVES;
    unsigned char* ws = args.ws;
    gu32* ctl = (gu32*)(ws + WS_CTL);
    for (int u = tid; u < (LDS_BYTES - RING_BYTES) / 4; u += NWAVES * 64) ((LAS unsigned*)(lds + RING_BYTES))[u] = 0u;
    __syncthreads();
    XcdBarrier bar; bar.bar = (unsigned*)(ctl + CW_BAR); bar.x = 0; bar.st = nullptr;
    if (MK_N_LAUNCHES == 1) bar = xcd_barrier_post((unsigned*)(ctl + CW_BAR), MISC + 8);
    const int lo = args.ph_lo, hi = args.ph_hi;
#ifndef ONLYP
#define ONLYP -1
#endif
#define IN(k) ((ONLYP < 0 || ONLYP == (k)) && lo <= (k) && (k) < hi)
#define SEAM(k) do { if (IN(k) && IN((k) + 1)) xcd_barrier(bar); } while (0)

    const float* x = args.in[0]; const float* mem = args.in[1]; const float* rel_bias = args.in[2];
    float* out = args.out;
    bf16_t* XN = (bf16_t*)(ws + WS_XN); bf16_t* ACT = (bf16_t*)(ws + WS_ACT);
    float* U = (float*)(ws + WS_U); float* QRAW = (float*)(ws + WS_QRAW); float* KNRAW = (float*)(ws + WS_KNRAW); float* OB = (float*)(ws + WS_O); float* QMP = (float*)(ws + WS_QMP);
    bf16_t* QF = (bf16_t*)(ws + WS_QF); bf16_t* KF = (bf16_t*)(ws + WS_KF); bf16_t* VF = (bf16_t*)(ws + WS_VF);
    bf16_t* QS = (bf16_t*)(ws + WS_QS); bf16_t* KS = (bf16_t*)(ws + WS_KS); bf16_t* VS = (bf16_t*)(ws + WS_VS);
    bf16_t* CQN = (bf16_t*)(ws + WS_CQN); bf16_t* CKVN = (bf16_t*)(ws + WS_CKVN); float* KRB = (float*)(ws + WS_KRB);
    bf16_t* MEMN = (bf16_t*)(ws + WS_MEMN); float* KVM = (float*)(ws + WS_KVM); bf16_t* KM = (bf16_t*)(ws + WS_KM); bf16_t* VM = (bf16_t*)(ws + WS_VM);
    bf16_t* QM = (bf16_t*)(ws + WS_QM); bf16_t* OM = (bf16_t*)(ws + WS_OM);
    float* ROPE = (float*)(ws + WS_ROPE); float* BIAS = (float*)(ws + WS_BIAS);

    if (IN(0)) {
        LAS float* scr = (LAS float*)(lds + wave * 16384);
        const float* wgate_a = args.in[4]; const float* wup_a = args.in[5]; const float* wdown_a = args.in[6];
        const float* wgate_b = args.in[29]; const float* wup_b = args.in[30]; const float* wdown_b = args.in[31];
        constexpr int I_GU = 64 * 688, I_D = 172 * 128, I_IN = 64 * 128, I_UQ = 14 * 96, I_KN = 8 * 64, I_OUT = 64 * 128, I_MQ = 64 * 16, I_MKV = 64 * 32, I_MO = 8 * 128;
        constexpr int NITEMS = 2 * I_GU + 2 * I_D + I_IN + I_UQ + 2 * I_KN + I_OUT + I_MQ + I_MKV + I_MO;
        for (int it = gw; it < NITEMS; it += NGW) {
            int r = it;
            if (r < 2 * I_GU) { const int which = r >= I_GU; if (which) r -= I_GU;
                const int nb = r % 688, kb = r / 688, t = nb >> 3, w = nb & 7;
                const float* src = which ? ((w >> 2) ? wup_b : wgate_b) : ((w >> 2) ? wup_a : wgate_a);
                xpose_item(src, FF, 128 * t + 32 * (w & 3), D, (bf16_t*)(ws + (which ? WS_WGU_B : WS_WGU_A)), 32 * nb, 64 * kb, scr, lane); continue; }
            r -= 2 * I_GU;
            if (r < 2 * I_D) { const int which = r >= I_D; if (which) r -= I_D;
                const int nb = r % 128, kb = r / 128;
                xpose_item(which ? wdown_b : wdown_a, D, 32 * nb, FF, (bf16_t*)(ws + (which ? WS_WD_B : WS_WD_A)), 32 * nb, 64 * kb, scr, lane); continue; }
            r -= 2 * I_D;
            if (r < I_IN) { const int nb = r % 128, kb = r / 128;
                xpose_item(args.in[8], INW, (32 * nb < INW) ? 32 * nb : -1, D, (bf16_t*)(ws + WS_WIN), 32 * nb, 64 * kb, scr, lane); continue; }
            r -= I_IN;
            if (r < I_UQ) { const int nb = r % 96, kb = r / 96;
                xpose_item(args.in[11], NQ, 32 * nb, CQ, (bf16_t*)(ws + WS_WUQ), 32 * nb, 64 * kb, scr, lane); continue; }
            r -= I_UQ;
            if (r < 2 * I_KN) { const int which = r >= I_KN; if (which) r -= I_KN;
                const int nb = r % 64, kb = r / 64;
                xpose_item(args.in[12], 4096, (nb >> 2) * 256 + which * 128 + 32 * (nb & 3), CKV, (bf16_t*)(ws + (which ? WS_WV : WS_WKN)), 32 * nb, 64 * kb, scr, lane); continue; }
            r -= 2 * I_KN;
            if (r < I_OUT) { const int nb = r % 128, kb = r / 128;
                xpose_item(args.in[20], D, 32 * nb, D, (bf16_t*)(ws + WS_WOUT), 32 * nb, 64 * kb, scr, lane); continue; }
            r -= I_OUT;
            if (r < I_MQ) { const int nb = r % 16, kb = r / 16;
                xpose_item(args.in[23], 512, 32 * nb, D, (bf16_t*)(ws + WS_WMQ), 32 * nb, 64 * kb, scr, lane); continue; }
            r -= I_MQ;
            if (r < I_MKV) { const int nb = r % 32, kb = r / 32;
                xpose_item(args.in[24], 1024, 32 * nb, D, (bf16_t*)(ws + WS_WMKV), 32 * nb, 64 * kb, scr, lane); continue; }
            r -= I_MKV;
            { const int nb = r % 128, kb = r / 128;
                xpose_item(args.in[27], D, 32 * nb, 512, (bf16_t*)(ws + WS_WMO), 32 * nb, 64 * kb, scr, lane); }
        }
        for (int row = gw; row < M; row += NGW) rms_row4096(x + (size_t)row * D, args.in[3], XN + (size_t)row * D, lane);
        for (int row = gw; row < MROWS; row += NGW) rms_row4096(mem + (size_t)row * D, args.in[22], MEMN + (size_t)row * D, lane);
        for (int i = gw * 64 + lane; i < SEQ * 32; i += NGW * 64) { const int pos = i >> 5, j = i & 31;
            const float inv = exp2f(-(float)j * (13.287712379549449f / 32.f)); const float ang = (float)pos * inv;
            ROPE[2 * i] = cosf(ang); ROPE[2 * i + 1] = sinf(ang); }
        for (int i = gw * 64 + lane; i < SWA_H * 128; i += NGW * 64) { const int hh = i >> 7, d = i & 127;
            int bk = d; if (d >= 16) { bk = 16 + (int)(logf((float)d / 16.f) / 2.0794415416798357f * 16.f); if (bk > 31) bk = 31; }
            BIAS[i] = rel_bias[bk * SWA_H + hh] * LOG2E; }
    }
    SEAM(0);

    if (IN(1)) {
        { pg8::Gemm g{XN, (const bf16_t*)(ws + WS_WGU_A), D, D, D}; pg8::StaticOrder S; S.init(M, 2 * FF, G, bx);
          pg8::EpiSwiGLU E{ACT, FF}; pg8::gemm_phase<pg8::EpiSwiGLU, pg8::StaticOrder, true>(lds, g, S, E); }
        { pg8::Gemm g{MEMN, (const bf16_t*)(ws + WS_WMKV), D, D, D}; pg8::OffsetOrder S; S.init(MROWS / 256, 1024 / 256, 1, G, bx, 192 % G);
          pg8::EpiF32 E{KVM, 1024, 0}; pg8::gemm_phase<pg8::EpiF32, pg8::OffsetOrder, true>(lds, g, S, E); }
    }
    SEAM(1);
    if (IN(2)) {
        pg8::Gemm g{ACT, (const bf16_t*)(ws + WS_WD_A), FF, FF, FF}; pg8::StaticOrder S; S.init(M, D, G, bx);
        pg8::EpiRes E{x, out, D, 0.5f}; pg8::gemm_phase<pg8::EpiRes, pg8::StaticOrder, true>(lds, g, S, E);
    }
    SEAM(2);
    if (IN(3)) { for (int row = gw; row < M; row += NGW) rms_row4096(out + (size_t)row * D, args.in[7], XN + (size_t)row * D, lane); }
    SEAM(3);
    if (IN(4)) {
        pg8::Gemm g{XN, (const bf16_t*)(ws + WS_WIN), D, D, D}; pg8::StaticOrder S; S.init(M, D, G, bx);
        pg8::EpiF32 E{U, D, 0}; pg8::gemm_phase<pg8::EpiF32, pg8::StaticOrder, true>(lds, g, S, E);
    }
    SEAM(4);
    if (IN(5)) {
        const float* g_qa = args.in[9]; const float* g_kva = args.in[10]; const float* g_sq = args.in[15]; const float* g_sk = args.in[16];
        for (int row = gw; row < M; row += NGW) {
            const f32x4* ur = (const f32x4*)(U + (size_t)row * D);
            { f32x4 v[4]; float s = 0.f;
#pragma unroll
              for (int j = 0; j < 4; ++j) { const int c = lane + 64 * j; v[j] = (c < 224) ? ur[c] : (f32x4){0.f, 0.f, 0.f, 0.f}; s += sq4(v[j]); }
              const float rstd = rsq(wave_sum(s) * (1.f / CQ) + EPS);
#pragma unroll
              for (int j = 0; j < 4; ++j) { const int c = lane + 64 * j; if (c < 224) *((u32x2*)(CQN + (size_t)row * CQ) + c) = pack4(v[j] * rstd * ((const f32x4*)g_qa)[c]); } }
            { f32x4 v[2]; float s = 0.f;
#pragma unroll
              for (int j = 0; j < 2; ++j) { v[j] = ur[224 + lane + 64 * j]; s += sq4(v[j]); }
              const float rstd = rsq(wave_sum(s) * (1.f / CKV) + EPS);
#pragma unroll
              for (int j = 0; j < 2; ++j) { const int c = lane + 64 * j; *((u32x2*)(CKVN + (size_t)row * CKV) + c) = pack4(v[j] * rstd * ((const f32x4*)g_kva)[c]); } }
            if (lane < 16) *((f32x4*)(KRB + (size_t)row * KRD) + lane) = ur[352 + lane];
            { const f32x4 gq = ((const f32x4*)g_sq)[lane & 15];
#pragma unroll
              for (int j = 0; j < 8; ++j) { const int c = lane + 64 * j; const f32x4 v = ur[368 + c];
                  const float rstd = rsq(g16_sum(sq4(v)) * (1.f / SWA_D) + EPS) * (0.125f * LOG2E);
                  *((u32x2*)(QS + (size_t)row * SWAW) + c) = pack4(v * rstd * gq); } }
            { const f32x4 v = ur[880 + lane]; const float rstd = rsq(g16_sum(sq4(v)) * (1.f / SWA_D) + EPS);
              *((u32x2*)(KS + (size_t)row * SWAKW) + lane) = pack4(v * rstd * ((const f32x4*)g_sk)[lane & 15]); }
            *((u32x2*)(VS + (size_t)row * SWAKW) + lane) = pack4(ur[944 + lane]);
        }
    }
    SEAM(5);
    if (IN(6)) {
        { pg8::Gemm g{CQN, (const bf16_t*)(ws + WS_WUQ), CQ, CQ, CQ}; pg8::StaticOrder S; S.init(M, NQ, G, bx);
          pg8::EpiF32 E{QRAW, NQ, 0}; pg8::gemm_phase<pg8::EpiF32, pg8::StaticOrder, true>(lds, g, S, E); }
        { pg8::Gemm g{CKVN, (const bf16_t*)(ws + WS_WKN), CKV, CKV, CKV}; pg8::StaticOrder S; S.init(M, NKN, G, (bx + G / 2) % G);
          pg8::EpiF32 E{KNRAW, NKN, 0}; pg8::gemm_phase<pg8::EpiF32, pg8::StaticOrder, true>(lds, g, S, E); }
        { pg8::Gemm g{CKVN, (const bf16_t*)(ws + WS_WV), CKV, CKV, CKV}; pg8::StaticOrder S; S.init(M, NV, G, (bx + G / 2) % G);
          pg8::EpiBf16 E{VF, NV}; pg8::gemm_phase<pg8::EpiBf16, pg8::StaticOrder, true>(lds, g, S, E); }
    }
    SEAM(6);
    if (IN(7)) {
        const float* g_q = args.in[13]; const float* g_k = args.in[14]; const float* g_mk = args.in[26];
        const int l16 = lane & 15, hg = lane >> 4;
        const float qscale = 0.07216878364870322f * LOG2E;
        for (int row = gw; row < M; row += NGW) {
            const int pos = row & (SEQ - 1);
            const f32x4* rp = (const f32x4*)(ROPE + (size_t)pos * 64);
            f32x4 cs0 = (f32x4){1.f, 0.f, 1.f, 0.f}, cs1 = cs0;
            if (l16 < 8) { cs0 = rp[2 * l16]; cs1 = rp[2 * l16 + 1]; }
#pragma unroll
            for (int it = 0; it < 4; ++it) { const int hh = 4 * it + hg; const f32x4* qr = (const f32x4*)(QRAW + (size_t)row * NQ + hh * MLA_QK);
                f32x4 a0 = qr[2 * l16], a1 = qr[2 * l16 + 1], x1 = (f32x4){0.f, 0.f, 0.f, 0.f}, x2 = x1;
                if (l16 < 8) { x1 = qr[32 + l16]; x2 = qr[40 + l16]; }
                const float rstd = rsq(g16_sum(sq4(a0) + sq4(a1) + sq4(x1) + sq4(x2)) * (1.f / MLA_QK) + EPS) * qscale;
                u32x2* qo = (u32x2*)(QF + (size_t)row * NQ + hh * MLA_QK);
                qo[2 * l16] = pack4(a0 * rstd * ((const f32x4*)g_q)[2 * l16]); qo[2 * l16 + 1] = pack4(a1 * rstd * ((const f32x4*)g_q)[2 * l16 + 1]);
                if (l16 < 8) { x1 = x1 * rstd * ((const f32x4*)g_q)[32 + l16]; x2 = x2 * rstd * ((const f32x4*)g_q)[40 + l16];
                    const f32x4 co = (f32x4){cs0.x, cs0.z, cs1.x, cs1.z}, si = (f32x4){cs0.y, cs0.w, cs1.y, cs1.w};
                    qo[32 + l16] = pack4(x1 * co - x2 * si); qo[40 + l16] = pack4(x2 * co + x1 * si); } }
            { f32x4 r1 = (f32x4){0.f, 0.f, 0.f, 0.f}, r2 = r1;
              if (l16 < 8) { r1 = ((const f32x4*)(KRB + (size_t)row * KRD))[l16]; r2 = ((const f32x4*)(KRB + (size_t)row * KRD))[8 + l16]; }
              const float ssr = g16_sum(sq4(r1) + sq4(r2));
              const f32x4 co = (f32x4){cs0.x, cs0.z, cs1.x, cs1.z}, si = (f32x4){cs0.y, cs0.w, cs1.y, cs1.w};
              f32x4 y1 = r1, y2 = r2;
              if (l16 < 8) { r1 = r1 * ((const f32x4*)g_k)[32 + l16]; r2 = r2 * ((const f32x4*)g_k)[40 + l16]; y1 = r1 * co - r2 * si; y2 = r2 * co + r1 * si; }
#pragma unroll
              for (int it = 0; it < 4; ++it) { const int hh = 4 * it + hg; const f32x4* kr = (const f32x4*)(KNRAW + (size_t)row * NKN + hh * MLA_NOPE);
                  const f32x4 a0 = kr[2 * l16], a1 = kr[2 * l16 + 1];
                  const float rstd = rsq((g16_sum(sq4(a0) + sq4(a1)) + ssr) * (1.f / MLA_QK) + EPS);
                  u32x2* ko = (u32x2*)(KF + (size_t)row * NQ + hh * MLA_QK);
                  ko[2 * l16] = pack4(a0 * rstd * ((const f32x4*)g_k)[2 * l16]); ko[2 * l16 + 1] = pack4(a1 * rstd * ((const f32x4*)g_k)[2 * l16 + 1]);
                  if (l16 < 8) { ko[32 + l16] = pack4(y1 * rstd); ko[40 + l16] = pack4(y2 * rstd); } } }
        }
        for (int row = gw; row < MROWS; row += NGW) {
            const f32x4* kr = (const f32x4*)(KVM + (size_t)row * 1024 + hg * 256);
            const f32x4 a0 = kr[2 * l16], a1 = kr[2 * l16 + 1], v0 = kr[32 + 2 * l16], v1 = kr[32 + 2 * l16 + 1];
            const float rstd = rsq(g16_sum(sq4(a0) + sq4(a1)) * (1.f / MEM_D) + EPS);
            u32x2* ko = (u32x2*)(KM + (size_t)row * 512 + hg * MEM_D); u32x2* vo = (u32x2*)(VM + (size_t)row * 512 + hg * MEM_D);
            ko[2 * l16] = pack4(a0 * rstd * ((const f32x4*)g_mk)[2 * l16]); ko[2 * l16 + 1] = pack4(a1 * rstd * ((const f32x4*)g_mk)[2 * l16 + 1]);
            vo[2 * l16] = pack4(v0); vo[2 * l16 + 1] = pack4(v1);
        }
    }
    SEAM(7);
    if (IN(8)) {
        for (int u = bx; u < 256; u += G) { const int b = u >> 7, hh = (u >> 3) & 15, pi = u & 7;
            for (int sub = 0; sub < 2; ++sub) { const int qb = sub ? 15 - pi : pi; const int q0 = qb * 256 + 32 * wave; const size_t row0 = (size_t)b * SEQ + q0;
                attn_unit<MLA_QK, MLA_V, 1, false>(lds, tid, lane, QF + row0 * NQ + hh * MLA_QK, NQ, KF + (size_t)b * SEQ * NQ + hh * MLA_QK, NQ,
                    VF + (size_t)b * SEQ * NV + hh * MLA_V, NV, OB + row0 * D + hh * MLA_V, D, q0, 0, 4 * (qb + 1), NEGBIG, 0.f, nullptr); } }
        LAS float* biasL = (LAS float*)(lds + 98304);
        const float* sinks = args.in[17];
        for (int u = bx; u < 1024; u += G) { const int b = u >> 9, kvh = (u >> 7) & 3, qblk = u & 127; const int q0 = 32 * qblk, head = kvh * 8 + wave; const size_t row0 = (size_t)b * SEQ + q0;
            __syncthreads();
            for (int i = tid; i < 1024; i += 512) biasL[i] = BIAS[kvh * 1024 + i];
            const int jt0 = (q0 < 127) ? 0 : ((q0 - 127) >> 6), jt1 = ((q0 + 31) >> 6) + 1;
            attn_unit<SWA_D, SWA_D, 2, false>(lds, tid, lane, QS + row0 * SWAW + head * SWA_D, SWAW, KS + (size_t)b * SEQ * SWAKW + kvh * SWA_D, SWAKW,
                VS + (size_t)b * SEQ * SWAKW + kvh * SWA_D, SWAKW, OB + row0 * D + NV + head * SWA_D, D, q0, jt0, jt1, sinks[head] * LOG2E, 1.f, biasL + wave * 128); }
    }
    SEAM(8);
    if (IN(9)) {
        const float* g_a = args.in[18]; const float* g_b = args.in[19];
        for (int row = gw; row < M; row += NGW) { const f32x4* orow = (const f32x4*)(OB + (size_t)row * D) + lane;
            f32x4 v[16]; float sa = 0.f, sb = 0.f;
#pragma unroll
            for (int j = 0; j < 8; ++j) { v[j] = orow[64 * j]; sa += sq4(v[j]); v[8 + j] = orow[64 * (8 + j)]; sb += sq4(v[8 + j]); }
            const float ra = rsq(wave_sum(sa) * (1.f / NV) + EPS), rb = rsq(wave_sum(sb) * (1.f / SWAW) + EPS);
            u32x2* o8 = (u32x2*)(XN + (size_t)row * D) + lane;
#pragma unroll
            for (int j = 0; j < 8; ++j) { o8[64 * j] = pack4(v[j] * ra * ((const f32x4*)g_a)[lane + 64 * j]); o8[64 * (8 + j)] = pack4(v[8 + j] * rb * ((const f32x4*)g_b)[lane + 64 * j]); } }
    }
    SEAM(9);
    if (IN(10)) {
        pg8::Gemm g{XN, (const bf16_t*)(ws + WS_WOUT), D, D, D}; pg8::StaticOrder S; S.init(M, D, G, bx);
        pg8::EpiRes E{out, out, D, 1.0f}; pg8::gemm_phase<pg8::EpiRes, pg8::StaticOrder, true>(lds, g, S, E);
    }
    SEAM(10);
    if (IN(11)) { for (int row = gw; row < M; row += NGW) rms_row4096(out + (size_t)row * D, args.in[21], XN + (size_t)row * D, lane); }
    SEAM(11);
    if (IN(12)) {
        pg8::Gemm g{XN, (const bf16_t*)(ws + WS_WMQ), D, D, 1024}; pg8::OffsetOrder S; S.init(M / 256, 2, 4, G, bx, 0);
        pg8::EpiF32 E{QMP, 512, (size_t)M * 512}; pg8::gemm_phase<pg8::EpiF32, pg8::OffsetOrder, true>(lds, g, S, E);
    }
    SEAM(12);
    if (IN(13)) {
        const float* g_mq = args.in[25]; const int l16 = lane & 15, hg = lane >> 4; const float sc = 0.08838834764831845f * LOG2E;
        for (int row = gw; row < M; row += NGW) {
            f32x4 a0 = (f32x4){0.f, 0.f, 0.f, 0.f}, a1 = a0;
#pragma unroll
            for (int ks = 0; ks < 4; ++ks) { const f32x4* p = (const f32x4*)(QMP + ((size_t)ks * M + row) * 512 + hg * MEM_D); a0 += p[2 * l16]; a1 += p[2 * l16 + 1]; }
            const float rstd = rsq(g16_sum(sq4(a0) + sq4(a1)) * (1.f / MEM_D) + EPS) * sc;
            u32x2* qo = (u32x2*)(QM + (size_t)row * 512 + hg * MEM_D);
            qo[2 * l16] = pack4(a0 * rstd * ((const f32x4*)g_mq)[2 * l16]); qo[2 * l16 + 1] = pack4(a1 * rstd * ((const f32x4*)g_mq)[2 * l16 + 1]);
        }
    }
    SEAM(13);
    if (IN(14)) {
        for (int u = bx; u < 128; u += G) { const int b = u >> 6, hh = (u >> 4) & 3, qb = u & 15; const int q0 = qb * 256 + 32 * wave; const size_t row0 = (size_t)b * SEQ + q0;
            attn_unit<MEM_D, MEM_D, 0, true>(lds, tid, lane, QM + row0 * 512 + hh * MEM_D, 512, KM + (size_t)b * MEML * 512 + hh * MEM_D, 512,
                VM + (size_t)b * MEML * 512 + hh * MEM_D, 512, OM + row0 * 512 + hh * MEM_D, 512, q0, 0, 4, NEGBIG, 0.f, nullptr); }
    }
    SEAM(14);
    if (IN(15)) {
        pg8::Gemm g{OM, (const bf16_t*)(ws + WS_WMO), 512, 512, 512}; pg8::StaticOrder S; S.init(M, D, G, bx);
        pg8::EpiRes E{out, out, D, 1.0f}; pg8::gemm_phase<pg8::EpiRes, pg8::StaticOrder, true>(lds, g, S, E);
    }
    SEAM(15);
    if (IN(16)) { for (int row = gw; row < M; row += NGW) rms_row4096(out + (size_t)row * D, args.in[28], XN + (size_t)row * D, lane); }
    SEAM(16);
    if (IN(17)) {
        pg8::Gemm g{XN, (const bf16_t*)(ws + WS_WGU_B), D, D, D}; pg8::StaticOrder S; S.init(M, 2 * FF, G, bx);
        pg8::EpiSwiGLU E{ACT, FF}; pg8::gemm_phase<pg8::EpiSwiGLU, pg8::StaticOrder, true>(lds, g, S, E);
    }
    SEAM(17);
    if (IN(18)) {
        pg8::Gemm g{ACT, (const bf16_t*)(ws + WS_WD_B), FF, FF, FF}; pg8::StaticOrder S; S.init(M, D, G, bx);
        pg8::EpiRes E{out, out, D, 0.5f}; pg8::gemm_phase<pg8::EpiRes, pg8::StaticOrder, true>(lds, g, S, E);
    }
#undef IN
#undef SEAM
}

extern "C" void kernel_launch(void* const* d_in, const int* in_sizes, int n_in, void* d_out, int out_size, void* d_ws, size_t ws_size, hipStream_t stream) {
    static int grid = 0;
    if (grid == 0) {
        if (n_in != 32 || out_size != M * D || ws_size < WS_END) { fprintf(stderr, "kernel_launch: unexpected problem (n_in %d, out %d, ws %zu); nothing launched\n", n_in, out_size, ws_size); grid = -1; return; }
        int dev = 0, cus = 0, per_cu = 0;
        if (hipGetDevice(&dev) != hipSuccess || hipDeviceGetAttribute(&cus, hipDeviceAttributeMultiprocessorCount, dev) != hipSuccess) { grid = -1; return; }
        if (hipFuncSetAttribute((const void*)fwd_kernel, hipFuncAttributeMaxDynamicSharedMemorySize, LDS_BYTES) != hipSuccess) { fprintf(stderr, "kernel_launch: hipFuncSetAttribute failed\n"); grid = -1; return; }
        if (hipOccupancyMaxActiveBlocksPerMultiprocessor(&per_cu, (const void*)fwd_kernel, NWAVES * 64, LDS_BYTES) != hipSuccess || per_cu < 1)
            fprintf(stderr, "kernel_launch: note: occupancy query reports %d workgroups per CU\n", per_cu);
        (void)hipGetLastError();
        grid = cus;
    }
    if (grid < 0) return;
    if (hipMemsetAsync((char*)d_ws + WS_CTL, 0, CTL_ZERO_BYTES, stream) != hipSuccess) return;
    Args a{};
    for (int i = 0; i < 32; ++i) a.in[i] = (const float*)d_in[i];
    a.out = (float*)d_out; a.ws = (unsigned char*)d_ws;
    if (MK_N_LAUNCHES == 1) {
        a.ph_lo = 0; a.ph_hi = NPHASE;
        hipLaunchKernelGGL(fwd_kernel, dim3(grid), dim3(NWAVES * 64), LDS_BYTES, stream, a);
    } else {
        for (int p = 0; p < NPHASE; ++p) { a.ph_lo = p; a.ph_hi = p + 1; hipLaunchKernelGGL(fwd_kernel, dim3(grid), dim3(NWAVES * 64), LDS_BYTES, stream, a); }
    }
}
```

```cpp
#include <hip/hip_runtime.h>
#include <cstdio>
#include <cstdint>

#ifndef MK_N_LAUNCHES
#define MK_N_LAUNCHES 1
#endif

#define GAS __attribute__((address_space(1)))
#define LAS __attribute__((address_space(3)))
typedef unsigned short bf16_t;
typedef short bf16x8 __attribute__((ext_vector_type(8)));
typedef short s16x4 __attribute__((ext_vector_type(4)));
typedef float f32x4 __attribute__((ext_vector_type(4)));
typedef float f32x16 __attribute__((ext_vector_type(16)));
typedef unsigned u32x4 __attribute__((ext_vector_type(4)));
typedef unsigned u32x2 __attribute__((ext_vector_type(2)));
typedef float f32x2_t __attribute__((ext_vector_type(2)));
typedef __bf16 bf16x2_t __attribute__((ext_vector_type(2)));
typedef GAS unsigned gu32;

#define LDS_WAIT() asm volatile("s_waitcnt lgkmcnt(0)" ::: "memory")
#define VM_WAIT() asm volatile("s_waitcnt vmcnt(0)" ::: "memory")
#define RLX_AGENT __ATOMIC_RELAXED, __HIP_MEMORY_SCOPE_AGENT

__device__ __forceinline__ unsigned cvtpk(float lo, float hi) { f32x2_t v = {lo, hi}; bf16x2_t b = __builtin_convertvector(v, bf16x2_t); return __builtin_bit_cast(unsigned, b); }
__device__ __forceinline__ float fast_exp2(float x) { return __builtin_amdgcn_exp2f(x); }
__device__ __forceinline__ float fast_rcp(float x) { return __builtin_amdgcn_rcpf(x); }
__device__ __forceinline__ float rsq(float x) { return 1.0f / __builtin_sqrtf(x); }

constexpr int SEQ = 4096, NB = 2, M = NB * SEQ, D = 4096, FF = 11008;
constexpr int MEML = 256, MROWS = NB * MEML;
constexpr int CQ = 896, CKV = 512, KRD = 64, INW = 4032;
constexpr int MLA_H = 16, MLA_QK = 192, MLA_NOPE = 128, MLA_V = 128;
constexpr int SWA_H = 32, SWA_KVH = 4, SWA_D = 64;
constexpr int MEM_H = 4, MEM_D = 128;
constexpr int NQ = MLA_H * MLA_QK;
constexpr int NKN = MLA_H * MLA_NOPE;
constexpr int NV = MLA_H * MLA_V;
constexpr int SWAW = SWA_H * SWA_D;
constexpr int SWAKW = SWA_KVH * SWA_D;
constexpr float EPS = 1e-6f;
constexpr float LOG2E = 1.4426950408889634f;
constexpr float NEGBIG = -1e30f;

constexpr size_t MiB = 1u << 20;
constexpr size_t WS_CTL = 0, CTL_ZERO_BYTES = 1 * MiB;
constexpr size_t WS_ROPE = 1 * MiB;
constexpr size_t WS_BIAS = 2 * MiB;
constexpr size_t WS_WGU_A = 4 * MiB;
constexpr size_t WS_WD_A = 176 * MiB;
constexpr size_t WS_WGU_B = 262 * MiB;
constexpr size_t WS_WD_B = 434 * MiB;
constexpr size_t WS_WIN = 520 * MiB;
constexpr size_t WS_WUQ = 552 * MiB;
constexpr size_t WS_WKN = 558 * MiB;
constexpr size_t WS_WV = 560 * MiB;
constexpr size_t WS_WOUT = 562 * MiB;
constexpr size_t WS_WMQ = 594 * MiB;
constexpr size_t WS_WMKV = 598 * MiB;
constexpr size_t WS_WMO = 606 * MiB;
constexpr size_t WS_XN = 610 * MiB;
constexpr size_t WS_ACT = 674 * MiB;
constexpr size_t WS_U = WS_ACT;
constexpr size_t WS_QRAW = WS_ACT;
constexpr size_t WS_KNRAW = WS_ACT + 96 * MiB;
constexpr size_t WS_O = WS_ACT;
constexpr size_t WS_QMP = WS_ACT;
constexpr size_t WS_QF = 846 * MiB;
constexpr size_t WS_KF = 894 * MiB;
constexpr size_t WS_VF = 942 * MiB;
constexpr size_t WS_QS = 974 * MiB;
constexpr size_t WS_KS = 1006 * MiB;
constexpr size_t WS_VS = 1010 * MiB;
constexpr size_t WS_CQN = 1014 * MiB;
constexpr size_t WS_CKVN = 1028 * MiB;
constexpr size_t WS_KRB = 1036 * MiB;
constexpr size_t WS_MEMN = 1038 * MiB;
constexpr size_t WS_KVM = 1042 * MiB;
constexpr size_t WS_KM = 1044 * MiB;
constexpr size_t WS_VM = 1044 * MiB + 512 * 1024;
constexpr size_t WS_QM = 1045 * MiB;
constexpr size_t WS_OM = 1053 * MiB;
constexpr size_t WS_END = 1061 * MiB;
constexpr int CW_TMO = 0;
constexpr int CW_BAR = 4096;

constexpr int RING_BYTES = 131072;
constexpr int MISC_OFF = RING_BYTES + 320;
constexpr int LDS_BYTES = 147456;
constexpr int NWAVES = 8;

namespace pg8 {
constexpr int BM = 256, BK = 64, HALF = 128, HTB = HALF * BK * 2, NXCD = 8, WGM = 8;
__host__ __device__ __forceinline__ int lds_byte(int r, int c) { const int st = (r >> 4) * 2 + (c >> 5), rr = r & 15, cc = c & 31, ob = rr * 64 + cc * 2; return st * 1024 + (ob ^ (((ob >> 9) & 1) << 5)); }
__host__ __device__ __forceinline__ void stage_rc(int b, int& R, int& C) { const int st = b / 1024, sb = b % 1024, swz = sb ^ (((sb >> 9) & 1) << 5); R = (st >> 1) * 16 + swz / 64; C = (st & 1) * 32 + (swz % 64) / 2; }
__host__ __device__ __forceinline__ int perm32(int rho) { const int n = rho >> 4, i = rho & 15; return 8 * (i >> 2) + 4 * n + (i & 3); }

struct Unit { int pm, pn, ks; };
struct Gemm { const bf16_t* A; const bf16_t* Bt; int lda, ldb, K; };

struct StaticOrder {
    int nM, nN, nwg, G, c;
    __device__ void init(int M_, int N_, int G_, int c_) { nM = M_ / BM; nN = N_ / BM; nwg = nM * nN; G = G_; c = c_; }
    __device__ bool next(int i, Unit& u) const {
        const long L = (long)i * G + c; if (L >= nwg) return false;
        int wgid = (int)L; { const int q = nwg / NXCD, r = nwg % NXCD, xcd = wgid % NXCD, off = wgid / NXCD; wgid = (xcd < r ? xcd * (q + 1) : r * (q + 1) + (xcd - r) * q) + off; }
        const int nig = WGM * nN, gid = wgid / nig, fm = gid * WGM, gsz = (nM - fm) < WGM ? (nM - fm) : WGM;
        u.pm = fm + ((wgid % nig) % gsz); u.pn = (wgid % nig) / gsz; u.ks = 0; return true;
    }
};
struct OffsetOrder {
    int n, c0, G, c, nN, nS;
    __device__ void init(int nM_, int nN_, int nS_, int G_, int c_, int c0_) { n = nM_ * nN_ * nS_; nN = nN_; nS = nS_; G = G_; c = c_; c0 = c0_; }
    __device__ bool next(int i, Unit& u) const {
        const int rel = (c - c0 + G) % G; const long L = (long)i * G + rel; if (L >= n) return false;
        const int t = (int)L; u.ks = t % nS; const int q = t / nS; u.pn = q % nN; u.pm = q / nN; return true;
    }
};

struct EpiF32 {
    static constexpr bool PERM = false;
    float* C; int ldc; size_t split_stride;
    __device__ __forceinline__ void operator()(const f32x4 (&acc)[2][2][4][2], const Unit& u, int wr, int wc, int fr, int fq) const {
        const int row0 = u.pm * BM + wr * 64 + fr, col0 = u.pn * BM + wc * 32 + 4 * fq;
        float* Cb = C + (size_t)u.ks * split_stride;
#pragma unroll
        for (int ai = 0; ai < 2; ++ai)
#pragma unroll
            for (int m = 0; m < 4; ++m) { float* rowp = Cb + (size_t)(row0 + ai * HALF + m * 16) * ldc + col0;
#pragma unroll
                for (int bj = 0; bj < 2; ++bj)
#pragma unroll
                    for (int n = 0; n < 2; ++n) *(f32x4*)(rowp + bj * HALF + n * 16) = acc[ai][bj][m][n]; }
    }
};
struct EpiRes {
    static constexpr bool PERM = false;
    const float* base; float* out; int ldc; float alpha;
    __device__ __forceinline__ void operator()(const f32x4 (&acc)[2][2][4][2], const Unit& u, int wr, int wc, int fr, int fq) const {
        const int row0 = u.pm * BM + wr * 64 + fr, col0 = u.pn * BM + wc * 32 + 4 * fq;
#pragma unroll
        for (int ai = 0; ai < 2; ++ai)
#pragma unroll
            for (int m = 0; m < 4; ++m) { const size_t off = (size_t)(row0 + ai * HALF + m * 16) * ldc + col0;
                f32x4 b[2][2];
#pragma unroll
                for (int bj = 0; bj < 2; ++bj)
#pragma unroll
                    for (int n = 0; n < 2; ++n) b[bj][n] = *(const f32x4*)(base + off + bj * HALF + n * 16);
#pragma unroll
                for (int bj = 0; bj < 2; ++bj)
#pragma unroll
                    for (int n = 0; n < 2; ++n) *(f32x4*)(out + off + bj * HALF + n * 16) = b[bj][n] + acc[ai][bj][m][n] * alpha; }
    }
};
struct EpiBf16 {
    static constexpr bool PERM = true;
    bf16_t* O; int ldc;
    __device__ __forceinline__ void operator()(const f32x4 (&acc)[2][2][4][2], const Unit& u, int wr, int wc, int fr, int fq) const {
        const int row0 = u.pm * BM + wr * 64 + fr, col0 = u.pn * BM + wc * 32 + 8 * fq;
#pragma unroll
        for (int ai = 0; ai < 2; ++ai)
#pragma unroll
            for (int m = 0; m < 4; ++m) { bf16_t* rowp = O + (size_t)(row0 + ai * HALF + m * 16) * ldc + col0;
#pragma unroll
                for (int bj = 0; bj < 2; ++bj) { const f32x4 v0 = acc[ai][bj][m][0], v1 = acc[ai][bj][m][1];
                    u32x4 w; w.x = cvtpk(v0[0], v0[1]); w.y = cvtpk(v0[2], v0[3]); w.z = cvtpk(v1[0], v1[1]); w.w = cvtpk(v1[2], v1[3]);
                    *(u32x4*)(rowp + bj * HALF) = w; } }
    }
};
struct EpiSwiGLU {
    static constexpr bool PERM = true;
    bf16_t* O; int ldc;
    __device__ __forceinline__ float sw(float g, float up) const { return g * fast_rcp(1.0f + fast_exp2(-LOG2E * g)) * up; }
    __device__ __forceinline__ void operator()(const f32x4 (&acc)[2][2][4][2], const Unit& u, int wr, int wc, int fr, int fq) const {
        const int row0 = u.pm * BM + wr * 64 + fr, col0 = u.pn * HALF + wc * 32 + 8 * fq;
#pragma unroll
        for (int ai = 0; ai < 2; ++ai)
#pragma unroll
            for (int m = 0; m < 4; ++m) { bf16_t* rowp = O + (size_t)(row0 + ai * HALF + m * 16) * ldc + col0;
                const f32x4 g0 = acc[ai][0][m][0], g1 = acc[ai][0][m][1], u0 = acc[ai][1][m][0], u1 = acc[ai][1][m][1];
                u32x4 w; w.x = cvtpk(sw(g0[0], u0[0]), sw(g0[1], u0[1])); w.y = cvtpk(sw(g0[2], u0[2]), sw(g0[3], u0[3]));
                w.z = cvtpk(sw(g1[0], u1[0]), sw(g1[1], u1[1])); w.w = cvtpk(sw(g1[2], u1[2]), sw(g1[3], u1[3]));
                *(u32x4*)rowp = w; }
    }
};

template <class Epi, class Sched, bool ALIGN_EPI>
__device__ __forceinline__ void gemm_phase(LAS unsigned char* lds, const Gemm g, const Sched& S, const Epi& E) {
    const int tid = threadIdx.x, wid = __builtin_amdgcn_readfirstlane(tid >> 6), lane = tid & 63, wr = wid >> 2, wc = wid & 3, fr = lane & 15, fq = lane >> 4;
    const int K = g.K, nt = K / BK;
    unsigned voffA[2], voffB[2];
#pragma unroll
    for (int i = 0; i < 2; ++i) { int R, C; stage_rc(tid * 16 + i * 8192, R, C); const int Rb = Epi::PERM ? ((R & ~31) + perm32(R & 31)) : R;
        voffA[i] = (unsigned)(R * g.lda + C) * 2u; voffB[i] = (unsigned)(Rb * g.ldb + C) * 2u; }
    const size_t kstep = (size_t)(BK * 2);
    const size_t hstepA = (size_t)HALF * g.lda * 2, hstepB = (size_t)HALF * g.ldb * 2;
    const size_t tstepA = 2 * hstepA, tstepB = 2 * hstepB;
    const unsigned ldsw = (unsigned)wid * 1024u;
    const int aoff = lds_byte(wr * 64 + fr, fq * 8), boff = lds_byte(wc * 32 + fr, fq * 8);
#define PG8_SA(b, h) (((b) * 2 + (h)) * HTB)
#define PG8_SB(b, h) ((4 + (b) * 2 + (h)) * HTB)
#define PG8_STAGE(bufoff, gbase, voff) do { _Pragma("unroll") for (int _i = 0; _i < 2; ++_i) \
        __builtin_amdgcn_global_load_lds((const unsigned*)((const char*)(gbase) + (voff)[_i]), (LAS unsigned*)(lds + (bufoff) + ldsw + _i * 8192), 16, 0, 0); } while (0)
#define PG8_LDA(dst, b, h) do { _Pragma("unroll") for (int m = 0; m < 4; ++m) _Pragma("unroll") for (int k = 0; k < 2; ++k) dst[m][k] = *(const LAS bf16x8*)(lds + PG8_SA(b, h) + aoff + m * 2048 + k * 1024); } while (0)
#define PG8_LDB(dst, b, h) do { _Pragma("unroll") for (int n = 0; n < 2; ++n) _Pragma("unroll") for (int k = 0; k < 2; ++k) dst[n][k] = *(const LAS bf16x8*)(lds + PG8_SB(b, h) + boff + n * 2048 + k * 1024); } while (0)
#define PG8_MMA(ai, bj, At, Bt) do { __builtin_amdgcn_s_setprio(1); _Pragma("unroll") for (int m = 0; m < 4; ++m) _Pragma("unroll") for (int n = 0; n < 2; ++n) _Pragma("unroll") for (int k = 0; k < 2; ++k) \
        acc[ai][bj][m][n] = __builtin_amdgcn_mfma_f32_16x16x32_bf16(Bt[n][k], At[m][k], acc[ai][bj][m][n], 0, 0, 0); __builtin_amdgcn_s_setprio(0); } while (0)
#define PG8_WAIT_V(n) asm volatile("s_waitcnt vmcnt(" #n ")" ::: "memory")
#define PG8_WAIT_L(n) asm volatile("s_waitcnt lgkmcnt(" #n ")" ::: "memory")
#define PG8_BAR __builtin_amdgcn_s_barrier()
#define PG8_SCHED __builtin_amdgcn_sched_barrier(0)
    Unit cur, nxt; int ui = 0;
    if (!S.next(0, cur)) return;
    f32x4 acc[2][2][4][2];
#pragma unroll
    for (int a = 0; a < 2; ++a)
#pragma unroll
        for (int b = 0; b < 2; ++b)
#pragma unroll
            for (int m = 0; m < 4; ++m)
#pragma unroll
                for (int n = 0; n < 2; ++n) acc[a][b][m][n] = (f32x4){0.f, 0.f, 0.f, 0.f};
    bf16x8 At[4][2], B0[2][2], B1[2][2];
    const char* cA = (const char*)g.A + (size_t)cur.pm * tstepA + (size_t)cur.ks * K * 2; const char* cB = (const char*)g.Bt + (size_t)cur.pn * tstepB + (size_t)cur.ks * K * 2;
    PG8_STAGE(PG8_SB(0, 0), cB, voffB); PG8_STAGE(PG8_SB(0, 1), cB + hstepB, voffB); PG8_STAGE(PG8_SA(0, 0), cA, voffA); PG8_STAGE(PG8_SA(0, 1), cA + hstepA, voffA);
    if (wr == 1) PG8_BAR;
    PG8_WAIT_V(2); PG8_BAR;
    PG8_STAGE(PG8_SB(1, 0), cB + kstep, voffB); PG8_STAGE(PG8_SA(1, 0), cA + kstep, voffA); PG8_STAGE(PG8_SB(1, 1), cB + hstepB + kstep, voffB);
    PG8_WAIT_V(6); PG8_BAR;
    for (;;) {
        const bool has_next = S.next(ui + 1, nxt);
        const char* nA = has_next ? (const char*)g.A + (size_t)nxt.pm * tstepA + (size_t)nxt.ks * K * 2 : cA;
        const char* nB = has_next ? (const char*)g.Bt + (size_t)nxt.pn * tstepB + (size_t)nxt.ks * K * 2 : cB;
        for (int t = 0; t < nt; t += 2) {
            const bool last = (t == nt - 2);
            const char* a1 = cA + (size_t)(t + 1) * kstep;
            const char* a2 = last ? nA : cA + (size_t)(t + 2) * kstep; const char* b2 = last ? nB : cB + (size_t)(t + 2) * kstep;
            const char* a3 = a2 + kstep; const char* b3 = b2 + kstep;
            PG8_LDB(B0, 0, 0); PG8_LDB(B1, 0, 1); PG8_SCHED; PG8_LDA(At, 0, 0); PG8_STAGE(PG8_SA(1, 1), a1 + hstepA, voffA);
            PG8_WAIT_V(8); PG8_WAIT_L(0); PG8_BAR; PG8_MMA(0, 0, At, B0); PG8_MMA(0, 1, At, B1); PG8_BAR; PG8_SCHED;
            PG8_LDA(At, 0, 1); PG8_STAGE(PG8_SB(0, 0), b2, voffB); PG8_STAGE(PG8_SB(0, 1), b2 + hstepB, voffB); PG8_STAGE(PG8_SA(0, 0), a2, voffA);
            PG8_WAIT_V(8); PG8_WAIT_L(0); PG8_BAR; PG8_MMA(1, 0, At, B0); PG8_MMA(1, 1, At, B1); PG8_BAR; PG8_SCHED;
            PG8_LDB(B0, 1, 0); PG8_LDB(B1, 1, 1); PG8_SCHED; PG8_LDA(At, 1, 0); PG8_STAGE(PG8_SA(0, 1), a2 + hstepA, voffA);
            PG8_WAIT_V(8); PG8_WAIT_L(0); PG8_BAR; PG8_MMA(0, 0, At, B0); PG8_MMA(0, 1, At, B1); PG8_BAR; PG8_SCHED;
            PG8_LDA(At, 1, 1); PG8_STAGE(PG8_SB(1, 0), b3, voffB); PG8_STAGE(PG8_SB(1, 1), b3 + hstepB, voffB); PG8_STAGE(PG8_SA(1, 0), a3, voffA);
            PG8_WAIT_V(8); PG8_WAIT_L(0); PG8_BAR; PG8_MMA(1, 0, At, B0); PG8_MMA(1, 1, At, B1); PG8_BAR; PG8_SCHED;
        }
        if constexpr (ALIGN_EPI) { if (wr == 0) PG8_BAR; }
        E(acc, cur, wr, wc, fr, fq);
        if (!has_next) break;
#pragma unroll
        for (int a = 0; a < 2; ++a)
#pragma unroll
            for (int b = 0; b < 2; ++b)
#pragma unroll
                for (int m = 0; m < 4; ++m)
#pragma unroll
                    for (int n = 0; n < 2; ++n) acc[a][b][m][n] = (f32x4){0.f, 0.f, 0.f, 0.f};
        cur = nxt; cA = nA; cB = nB; ++ui;
        if constexpr (ALIGN_EPI) { if (wr == 1) PG8_BAR; }
    }
    PG8_WAIT_V(0);
    if constexpr (!ALIGN_EPI) { if (wr == 0) PG8_BAR; }
    PG8_BAR;
#undef PG8_SA
#undef PG8_SB
#undef PG8_STAGE
#undef PG8_LDA
#undef PG8_LDB
#undef PG8_MMA
#undef PG8_WAIT_V
#undef PG8_WAIT_L
#undef PG8_BAR
#undef PG8_SCHED
}
}

#define XB_TMO      128
#define XB_XCNT(j)  (256  + 64 * (j))
#define XB_XSUB(j)  (1280 + 64 * (j))
#define XB_XGEN(j)  (2304 + 64 * (j))
#define XB_TOP      3328
#define XB_TOPGEN   3392
#define XCD_BAR_WORDS 3456
#define XB_SPIN_CAP (1u << 18)
__device__ __forceinline__ unsigned xb_ld(unsigned* p)              { return __hip_atomic_load(p, __ATOMIC_RELAXED, __HIP_MEMORY_SCOPE_AGENT); }
__device__ __forceinline__ unsigned xb_add(unsigned* p, unsigned v) { return __hip_atomic_fetch_add(p, v, __ATOMIC_RELAXED, __HIP_MEMORY_SCOPE_AGENT); }
__device__ __forceinline__ unsigned xb_xcc_id() { return (unsigned)__builtin_amdgcn_s_getreg((3 << 11) | 20) & 0xFu; }
#define XB_SPIN(cond, bar) do { unsigned _sp = 0; while (cond) { __builtin_amdgcn_s_sleep(1); \
    if ((++_sp & 255u) == 0u) { if (xb_ld(&(bar)[XB_TMO])) break; if (_sp > XB_SPIN_CAP) { atomicAdd(&(bar)[XB_TMO], 1u); break; } } } } while (0)
struct XcdBarrier { unsigned* bar; unsigned x; volatile LAS unsigned* st; };
__device__ __forceinline__ XcdBarrier xcd_barrier_post(unsigned* bar, volatile LAS unsigned* st) {
    XcdBarrier b; b.bar = bar; b.x = xb_xcc_id(); b.st = st;
    if (threadIdx.x == 0) (void)xb_add(&bar[XB_XCNT(b.x)], 1u);
    return b;
}
__device__ __forceinline__ void xcd_barrier_complete(unsigned* bar, unsigned x, unsigned& nloc, unsigned& nx) {
    const unsigned G = gridDim.x * gridDim.y * gridDim.z;
    unsigned sum, cnt, mine, sp = 0u;
    for (;;) {
        sum = 0u; cnt = 0u; mine = 0u;
#pragma unroll
        for (unsigned j = 0; j < 16; ++j) { const unsigned c = xb_ld(&bar[XB_XCNT(j)]); sum += c; cnt += (c > 0u) ? 1u : 0u; mine = (j == x) ? c : mine; }
        if (sum == G) break;
        __builtin_amdgcn_s_sleep(1);
        if ((++sp & 255u) == 0u) { if (xb_ld(&bar[XB_TMO])) break; if (sp > XB_SPIN_CAP) { atomicAdd(&bar[XB_TMO], 1u); break; } }
    }
    nloc = mine > 0u ? mine : 1u; nx = cnt > 0u ? cnt : 1u;
}
__device__ __forceinline__ void xcd_barrier(const XcdBarrier& b) {
    asm volatile("s_waitcnt vmcnt(0)" ::: "memory");
    __syncthreads();
    if (threadIdx.x == 0) {
        unsigned* bar = b.bar;
        __builtin_amdgcn_s_waitcnt(0);
        unsigned nloc = b.st[0], nx = b.st[1];
        if (nloc == 0u) { xcd_barrier_complete(bar, b.x, nloc, nx); b.st[0] = nloc; b.st[1] = nx; }
        const unsigned old = xb_add(&bar[XB_XSUB(b.x)], 1u);
        const unsigned gen = old / nloc;
        if (old + 1u == (gen + 1u) * nloc) {
            __builtin_amdgcn_fence(__ATOMIC_RELEASE, "agent");
            asm volatile("s_waitcnt vmcnt(0)" ::: "memory");
            const unsigned og = xb_add(&bar[XB_TOP], 1u);
            const unsigned tg = og / nx;
            if (og + 1u == (tg + 1u) * nx) xb_add(&bar[XB_TOPGEN], 1u);
            else XB_SPIN(xb_ld(&bar[XB_TOPGEN]) == tg, bar);
            __builtin_amdgcn_fence(__ATOMIC_ACQUIRE, "agent");
            xb_add(&bar[XB_XGEN(b.x)], 1u);
            asm volatile("s_waitcnt vmcnt(0)" ::: "memory");
        } else {
            XB_SPIN(xb_ld(&bar[XB_XGEN(b.x)]) == gen, bar);
            __builtin_amdgcn_fence(__ATOMIC_ACQUIRE, "agent");
            asm volatile("s_waitcnt vmcnt(0)" ::: "memory");
        }
    }
    __syncthreads();
}

__device__ __forceinline__ float wave_sum(float v) {
#pragma unroll
    for (int o = 1; o < 64; o <<= 1) v += __shfl_xor(v, o);
    return v;
}
__device__ __forceinline__ float g16_sum(float v) {
#pragma unroll
    for (int o = 1; o < 16; o <<= 1) v += __shfl_xor(v, o);
    return v;
}
__device__ __forceinline__ float sq4(f32x4 v) { return (v.x * v.x + v.y * v.y) + (v.z * v.z + v.w * v.w); }
__device__ __forceinline__ u32x2 pack4(f32x4 v) { u32x2 w; w.x = cvtpk(v.x, v.y); w.y = cvtpk(v.z, v.w); return w; }

struct XItem { const float* src; bf16_t* dst; int srcN, col0, K, row0, k0; };
__device__ __forceinline__ void xi_load(const XItem& x, f32x4 (&v)[8], int lane) {
    const int kr = lane >> 3, c4 = lane & 7;
    if (x.col0 >= 0) {
        const float* p = x.src + (size_t)(x.k0 + kr) * x.srcN + x.col0 + 4 * c4;
#pragma unroll
        for (int i = 0; i < 8; ++i) v[i] = *(const f32x4*)(p + (size_t)(8 * i) * x.srcN);
    } else {
#pragma unroll
        for (int i = 0; i < 8; ++i) v[i] = (f32x4){0.f, 0.f, 0.f, 0.f};
    }
}
__device__ __forceinline__ void xi_lds_write(const f32x4 (&v)[8], LAS float* scr, int lane) {
    const int kr = lane >> 3, c4 = lane & 7;
#pragma unroll
    for (int i = 0; i < 8; ++i) { LAS float* d = scr + (8 * i + kr) * 33 + 4 * c4; d[0] = v[i].x; d[1] = v[i].y; d[2] = v[i].z; d[3] = v[i].w; }
}
__device__ __forceinline__ void xi_store(const XItem& x, const LAS float* scr, int lane) {
    const int c = lane & 7;
#pragma unroll
    for (int j = 0; j < 4; ++j) { const int n = (lane >> 3) + 8 * j; const LAS float* s = scr + (8 * c) * 33 + n;
        u32x4 o; o.x = cvtpk(s[0 * 33], s[1 * 33]); o.y = cvtpk(s[2 * 33], s[3 * 33]); o.z = cvtpk(s[4 * 33], s[5 * 33]); o.w = cvtpk(s[6 * 33], s[7 * 33]);
        *(GAS u32x4*)(x.dst + (size_t)(x.row0 + n) * x.K + x.k0 + 8 * c) = o; }
}
__device__ __forceinline__ void rms_row4096(const float* xrow, const float* gain, bf16_t* orow, int lane) {
    const f32x4* xr = (const f32x4*)xrow + lane; const f32x4* gr = (const f32x4*)gain + lane;
    f32x4 v[16]; float s = 0.f;
#pragma unroll
    for (int j = 0; j < 16; ++j) { v[j] = xr[64 * j]; s += sq4(v[j]); }
    const float rstd = rsq(wave_sum(s) * (1.f / 4096.f) + EPS);
    u32x2* o8 = (u32x2*)orow + lane;
#pragma unroll
    for (int j = 0; j < 16; ++j) { const f32x4 gg = gr[64 * j]; o8[64 * j] = pack4(v[j] * rstd * gg); }
}

template <int DQK, int DV> struct ACfg {
    static constexpr int PK = DQK * 2 + 16, PV = DV * 2 + 64;
    static constexpr int KT = 64 * PK, VT = 64 * PV, STAGE = KT + VT;
    static constexpr int KCH = DQK / 8, VCH = DV / 8, NKL = 64 * KCH / 512, NVL = 64 * VCH / 512;
};
#define MFMA32(a, b, c) __builtin_amdgcn_mfma_f32_32x32x16_bf16((a), (b), (c), 0, 0, 0)
__device__ __forceinline__ s16x4 vtr(const LAS unsigned char* p) { return __builtin_bit_cast(s16x4, __builtin_amdgcn_ds_read_tr16_b64_v4i16((LAS s16x4*)p)); }

template <int DQK, int DV, int MODE, bool OBF16>
__device__ __forceinline__ void attn_unit(LAS unsigned char* lds, int tid, int lane,
                                          const bf16_t* Qw, int qpitch, const bf16_t* Kb, int kpitch, const bf16_t* Vb, int vpitch,
                                          void* Ow, int opitch, int q0, int jt0, int jt1, float m_init, float l_init, const LAS float* biasw) {
    using C = ACfg<DQK, DV>;
    const int r = lane & 31, h = lane >> 5;
    bf16x8 qf[DQK / 16];
#pragma unroll
    for (int ks = 0; ks < DQK / 16; ++ks) qf[ks] = *(const bf16x8*)(Qw + (size_t)r * qpitch + ks * 16 + h * 8);
    f32x16 O[DV / 32];
#pragma unroll
    for (int d = 0; d < DV / 32; ++d)
#pragma unroll
        for (int i = 0; i < 16; ++i) O[d][i] = 0.f;
    float m = m_init, l = (h == 0) ? l_init : 0.f;
    u32x4 kst[C::NKL], vst[C::NVL];
    unsigned kgo[C::NKL], vgo[C::NVL];
#pragma unroll
    for (int i = 0; i < C::NKL; ++i) { const int c = tid + 512 * i, row = c / C::KCH, cc = c % C::KCH; kgo[i] = (unsigned)(row * kpitch + cc * 8) * 2u; }
#pragma unroll
    for (int i = 0; i < C::NVL; ++i) { const int c = tid + 512 * i, row = c / C::VCH, cc = c % C::VCH; vgo[i] = (unsigned)(row * vpitch + cc * 8) * 2u; }
#define ATT_LOAD(jt) do { const char* kt_ = (const char*)Kb + (size_t)(jt) * 64 * kpitch * 2; const char* vt_ = (const char*)Vb + (size_t)(jt) * 64 * vpitch * 2; \
        _Pragma("unroll") for (int i = 0; i < C::NKL; ++i) kst[i] = *(const u32x4*)(kt_ + kgo[i]); \
        _Pragma("unroll") for (int i = 0; i < C::NVL; ++i) vst[i] = *(const u32x4*)(vt_ + vgo[i]); } while (0)
#define ATT_STORE(buf) do { \
        _Pragma("unroll") for (int i = 0; i < C::NKL; ++i) { const int c = tid + 512 * i, row = c / C::KCH, cc = c % C::KCH; *(LAS u32x4*)(lds + (buf) * C::STAGE + row * C::PK + cc * 16) = kst[i]; } \
        _Pragma("unroll") for (int i = 0; i < C::NVL; ++i) { const int c = tid + 512 * i, row = c / C::VCH, cc = c % C::VCH; *(LAS u32x4*)(lds + (buf) * C::STAGE + C::KT + row * C::PV + cc * 16) = vst[i]; } } while (0)
    __syncthreads();
    ATT_LOAD(jt0); ATT_STORE(0);
    for (int jt = jt0; jt < jt1; ++jt) {
        const int buf = (jt - jt0) & 1;
        __syncthreads();
        const bool more = (jt + 1 < jt1);
        if (more) ATT_LOAD(jt + 1);
        const bool active = (MODE == 1) ? (jt * 64 <= q0 + 31) : true;
        if (active) {
            const LAS unsigned char* kb_ = lds + buf * C::STAGE; const LAS unsigned char* vb_ = kb_ + C::KT;
            const int qpos = q0 + r;
#pragma unroll 1
            for (int kb = 0; kb < 2; ++kb) {
                if (MODE == 1 && jt * 64 + 32 * kb > q0 + 31) break;
                f32x16 S;
#pragma unroll
                for (int i = 0; i < 16; ++i) S[i] = 0.f;
                const LAS unsigned char* kp = kb_ + (32 * kb + r) * C::PK + h * 16;
#pragma unroll
                for (int ks = 0; ks < DQK / 16; ++ks) { const bf16x8 a0 = *(const LAS bf16x8*)(kp + ks * 32); S = MFMA32(a0, qf[ks], S); }
                const int kbase = jt * 64 + 32 * kb + 4 * h;
                if (MODE == 1) {
                    if (kbase - 4 * h + 31 > q0) {
#pragma unroll
                        for (int i = 0; i < 16; ++i) { const int key = kbase + (i & 3) + 8 * (i >> 2); if (key > qpos) S[i] = NEGBIG; }
                    }
                }
                if (MODE == 2) {
#pragma unroll
                    for (int i = 0; i < 16; ++i) { const int d0 = qpos - (kbase + (i & 3) + 8 * (i >> 2));
                        const float b0 = biasw[d0 & 127];
                        S[i] = ((unsigned)d0 < 128u) ? S[i] + b0 : NEGBIG; }
                }
                float mx = S[0];
#pragma unroll
                for (int i = 1; i < 16; ++i) mx = fmaxf(mx, S[i]);
                mx = fmaxf(mx, __shfl_xor(mx, 32));
                const float mn = fmaxf(m, mx); const float alpha = fast_exp2(m - mn); m = mn;
                float ps = 0.f;
#pragma unroll
                for (int i = 0; i < 16; ++i) { S[i] = fast_exp2(S[i] - mn); ps += S[i]; }
                l = l * alpha + ps;
#pragma unroll
                for (int d = 0; d < DV / 32; ++d)
#pragma unroll
                    for (int i = 0; i < 16; ++i) O[d][i] *= alpha;
                bf16x8 pf[2];
#pragma unroll
                for (int t = 0; t < 2; ++t) { u32x4 w; const int o = 8 * t;
                    w.x = cvtpk(S[o], S[o + 1]); w.y = cvtpk(S[o + 2], S[o + 3]); w.z = cvtpk(S[o + 4], S[o + 5]); w.w = cvtpk(S[o + 6], S[o + 7]);
                    pf[t] = __builtin_bit_cast(bf16x8, w); }
                const LAS unsigned char* vp = vb_ + (32 * kb + 4 * h + ((lane & 15) >> 2)) * C::PV + ((lane >> 4) & 1) * 32 + (lane & 3) * 8;
#pragma unroll
                for (int d = 0; d < DV / 32; ++d)
#pragma unroll
                    for (int t = 0; t < 2; ++t) { const s16x4 lo = vtr(vp + t * 16 * C::PV + d * 64), hi = vtr(vp + t * 16 * C::PV + 8 * C::PV + d * 64);
                        const bf16x8 vf = {lo.x, lo.y, lo.z, lo.w, hi.x, hi.y, hi.z, hi.w};
                        O[d] = MFMA32(vf, pf[t], O[d]); }
            }
        }
        if (more) ATT_STORE(buf ^ 1);
    }
#undef ATT_LOAD
#undef ATT_STORE
    l += __shfl_xor(l, 32);
    const float inv = 1.0f / l;
#pragma unroll
    for (int d = 0; d < DV / 32; ++d)
#pragma unroll
        for (int tq = 0; tq < 4; ++tq) { const int dv = 32 * d + 8 * tq + 4 * h;
            const f32x4 o = (f32x4){O[d][4 * tq], O[d][4 * tq + 1], O[d][4 * tq + 2], O[d][4 * tq + 3]} * inv;
            if (OBF16) *(u32x2*)((bf16_t*)Ow + (size_t)r * opitch + dv) = pack4(o);
            else *(f32x4*)((float*)Ow + (size_t)r * opitch + dv) = o; }
}

constexpr int NPHASE = 19;
struct Args { const float* in[32]; float* out; unsigned char* ws; int ph_lo, ph_hi; };
static_assert(sizeof(Args) == 32 * 8 + 8 + 8 + 8, "Args has no padding");

__global__ void __launch_bounds__(NWAVES * 64, 2) fwd_kernel(Args args) {
    extern __shared__ __attribute__((aligned(16))) unsigned char lds_raw[];
    LAS unsigned char* lds = (LAS unsigned char*)lds_raw;
    volatile LAS unsigned* MISC = (volatile LAS unsigned*)(lds + MISC_OFF);
    const int tid = threadIdx.x, lane = tid & 63, wave = __builtin_amdgcn_readfirstlane(tid >> 6);
    const int G = gridDim.x; const int bx = blockIdx.x; const int vcu = (G % 8 == 0) ? (bx % 8) * (G / 8) + bx / 8 : bx;
    const int gw = vcu * NWAVES + wave, NGW = G * NWAVES;
    unsigned char* ws = args.ws;
    gu32* ctl = (gu32*)(ws + WS_CTL);
    for (int u = tid; u < (LDS_BYTES - RING_BYTES) / 4; u += NWAVES * 64) ((LAS unsigned*)(lds + RING_BYTES))[u] = 0u;
    __syncthreads();
    XcdBarrier bar; bar.bar = (unsigned*)(ctl + CW_BAR); bar.x = 0; bar.st = nullptr;
    if (MK_N_LAUNCHES == 1) bar = xcd_barrier_post((unsigned*)(ctl + CW_BAR), MISC + 8);
    const int lo = args.ph_lo, hi = args.ph_hi;
#ifndef ONLYP
#define ONLYP -1
#endif
#define IN(k) ((ONLYP < 0 || ONLYP == (k)) && lo <= (k) && (k) < hi)
#define SEAM(k) do { if (IN(k) && IN((k) + 1)) xcd_barrier(bar); } while (0)
#ifndef DUPP
#define DUPP -1
#endif
#define REP(k) for (int rep_ = 0; rep_ < ((DUPP == (k)) ? 2 : 1); ++rep_)

    const float* x = args.in[0]; const float* mem = args.in[1]; const float* rel_bias = args.in[2];
    float* out = args.out;
    bf16_t* XN = (bf16_t*)(ws + WS_XN); bf16_t* ACT = (bf16_t*)(ws + WS_ACT);
    float* U = (float*)(ws + WS_U); float* QRAW = (float*)(ws + WS_QRAW); float* KNRAW = (float*)(ws + WS_KNRAW); float* OB = (float*)(ws + WS_O); float* QMP = (float*)(ws + WS_QMP);
    bf16_t* QF = (bf16_t*)(ws + WS_QF); bf16_t* KF = (bf16_t*)(ws + WS_KF); bf16_t* VF = (bf16_t*)(ws + WS_VF);
    bf16_t* QS = (bf16_t*)(ws + WS_QS); bf16_t* KS = (bf16_t*)(ws + WS_KS); bf16_t* VS = (bf16_t*)(ws + WS_VS);
    bf16_t* CQN = (bf16_t*)(ws + WS_CQN); bf16_t* CKVN = (bf16_t*)(ws + WS_CKVN); float* KRB = (float*)(ws + WS_KRB);
    bf16_t* MEMN = (bf16_t*)(ws + WS_MEMN); float* KVM = (float*)(ws + WS_KVM); bf16_t* KM = (bf16_t*)(ws + WS_KM); bf16_t* VM = (bf16_t*)(ws + WS_VM);
    bf16_t* QM = (bf16_t*)(ws + WS_QM); bf16_t* OM = (bf16_t*)(ws + WS_OM);
    float* ROPE = (float*)(ws + WS_ROPE); float* BIAS = (float*)(ws + WS_BIAS);

    REP(0) if (IN(0)) {
        LAS float* scr = (LAS float*)(lds + wave * 16384);
        const float* wgate_a = args.in[4]; const float* wup_a = args.in[5]; const float* wdown_a = args.in[6];
        const float* wgate_b = args.in[29]; const float* wup_b = args.in[30]; const float* wdown_b = args.in[31];
        constexpr int I_GU = 64 * 688, I_D = 172 * 128, I_IN = 64 * 128, I_UQ = 14 * 96, I_KN = 8 * 64, I_OUT = 64 * 128, I_MQ = 64 * 16, I_MKV = 64 * 32, I_MO = 8 * 128;
        constexpr int NITEMS = 2 * I_GU + 2 * I_D + I_IN + I_UQ + 2 * I_KN + I_OUT + I_MQ + I_MKV + I_MO;
#define XI_DECODE(X, IT) do { int r = (IT); \
            if (r < 2 * I_GU) { const int which = r >= I_GU; if (which) r -= I_GU; const int nb = r % 688, kb = r / 688, t = nb >> 3, w = nb & 7; \
                X.src = which ? ((w >> 2) ? wup_b : wgate_b) : ((w >> 2) ? wup_a : wgate_a); X.srcN = FF; X.col0 = 128 * t + 32 * (w & 3); X.K = D; X.dst = (bf16_t*)(ws + (which ? WS_WGU_B : WS_WGU_A)); X.row0 = 32 * nb; X.k0 = 64 * kb; break; } \
            r -= 2 * I_GU; \
            if (r < 2 * I_D) { const int which = r >= I_D; if (which) r -= I_D; const int nb = r % 128, kb = r / 128; \
                X.src = which ? wdown_b : wdown_a; X.srcN = D; X.col0 = 32 * nb; X.K = FF; X.dst = (bf16_t*)(ws + (which ? WS_WD_B : WS_WD_A)); X.row0 = 32 * nb; X.k0 = 64 * kb; break; } \
            r -= 2 * I_D; \
            if (r < I_IN) { const int nb = r % 128, kb = r / 128; \
                X.src = args.in[8]; X.srcN = INW; X.col0 = (32 * nb < INW) ? 32 * nb : -1; X.K = D; X.dst = (bf16_t*)(ws + WS_WIN); X.row0 = 32 * nb; X.k0 = 64 * kb; break; } \
            r -= I_IN; \
            if (r < I_UQ) { const int nb = r % 96, kb = r / 96; \
                X.src = args.in[11]; X.srcN = NQ; X.col0 = 32 * nb; X.K = CQ; X.dst = (bf16_t*)(ws + WS_WUQ); X.row0 = 32 * nb; X.k0 = 64 * kb; break; } \
            r -= I_UQ; \
            if (r < 2 * I_KN) { const int which = r >= I_KN; if (which) r -= I_KN; const int nb = r % 64, kb = r / 64; \
                X.src = args.in[12]; X.srcN = 4096; X.col0 = (nb >> 2) * 256 + which * 128 + 32 * (nb & 3); X.K = CKV; X.dst = (bf16_t*)(ws + (which ? WS_WV : WS_WKN)); X.row0 = 32 * nb; X.k0 = 64 * kb; break; } \
            r -= 2 * I_KN; \
            if (r < I_OUT) { const int nb = r % 128, kb = r / 128; \
                X.src = args.in[20]; X.srcN = D; X.col0 = 32 * nb; X.K = D; X.dst = (bf16_t*)(ws + WS_WOUT); X.row0 = 32 * nb; X.k0 = 64 * kb; break; } \
            r -= I_OUT; \
            if (r < I_MQ) { const int nb = r % 16, kb = r / 16; \
                X.src = args.in[23]; X.srcN = 512; X.col0 = 32 * nb; X.K = D; X.dst = (bf16_t*)(ws + WS_WMQ); X.row0 = 32 * nb; X.k0 = 64 * kb; break; } \
            r -= I_MQ; \
            if (r < I_MKV) { const int nb = r % 32, kb = r / 32; \
                X.src = args.in[24]; X.srcN = 1024; X.col0 = 32 * nb; X.K = D; X.dst = (bf16_t*)(ws + WS_WMKV); X.row0 = 32 * nb; X.k0 = 64 * kb; break; } \
            r -= I_MKV; \
            { const int nb = r % 128, kb = r / 128; \
                X.src = args.in[27]; X.srcN = D; X.col0 = 32 * nb; X.K = 512; X.dst = (bf16_t*)(ws + WS_WMO); X.row0 = 32 * nb; X.k0 = 64 * kb; } } while (0)
        { int it = gw; XItem cur, nx; f32x4 v[8];
          if (it < NITEMS) { XI_DECODE(cur, it); xi_load(cur, v, lane); }
          while (it < NITEMS) {
              xi_lds_write(v, scr, lane);
              const int itn = it + NGW;
              if (itn < NITEMS) { XI_DECODE(nx, itn); xi_load(nx, v, lane); }
              LDS_WAIT(); asm volatile("" ::: "memory");
              xi_store(cur, scr, lane);
              LDS_WAIT(); asm volatile("" ::: "memory");
              cur = nx; it = itn;
          } }
#undef XI_DECODE
        for (int row = gw; row < M; row += NGW) rms_row4096(x + (size_t)row * D, args.in[3], XN + (size_t)row * D, lane);
        for (int row = gw; row < MROWS; row += NGW) rms_row4096(mem + (size_t)row * D, args.in[22], MEMN + (size_t)row * D, lane);
        for (int i = gw * 64 + lane; i < SEQ * 32; i += NGW * 64) { const int pos = i >> 5, j = i & 31;
            const float inv = exp2f(-(float)j * (13.287712379549449f / 32.f)); const float ang = (float)pos * inv;
            ROPE[2 * i] = cosf(ang); ROPE[2 * i + 1] = sinf(ang); }
        for (int i = gw * 64 + lane; i < SWA_H * 128; i += NGW * 64) { const int hh = i >> 7, d = i & 127;
            int bk = d; if (d >= 16) { bk = 16 + (int)(logf((float)d / 16.f) / 2.0794415416798357f * 16.f); if (bk > 31) bk = 31; }
            BIAS[i] = rel_bias[bk * SWA_H + hh] * LOG2E; }
    }
    SEAM(0);

    if (IN(1)) {
        { pg8::Gemm g{XN, (const bf16_t*)(ws + WS_WGU_A), D, D, D}; pg8::StaticOrder S; S.init(M, 2 * FF, G, bx);
          pg8::EpiSwiGLU E{ACT, FF}; pg8::gemm_phase<pg8::EpiSwiGLU, pg8::StaticOrder, true>(lds, g, S, E);
          if (DUPP == 1) pg8::gemm_phase<pg8::EpiSwiGLU, pg8::StaticOrder, true>(lds, g, S, E); }
        { pg8::Gemm g{MEMN, (const bf16_t*)(ws + WS_WMKV), D, D, D}; pg8::OffsetOrder S; S.init(MROWS / 256, 1024 / 256, 1, G, bx, 192 % G);
          pg8::EpiF32 E{KVM, 1024, 0}; pg8::gemm_phase<pg8::EpiF32, pg8::OffsetOrder, true>(lds, g, S, E); }
    }
    SEAM(1);
    if (IN(2)) {
        pg8::Gemm g{ACT, (const bf16_t*)(ws + WS_WD_A), FF, FF, FF}; pg8::StaticOrder S; S.init(M, D, G, bx);
        pg8::EpiRes E{x, out, D, 0.5f}; pg8::gemm_phase<pg8::EpiRes, pg8::StaticOrder, true>(lds, g, S, E);
        if (DUPP == 2) pg8::gemm_phase<pg8::EpiRes, pg8::StaticOrder, true>(lds, g, S, E);
    }
    SEAM(2);
    REP(3) if (IN(3)) { for (int row = gw; row < M; row += NGW) rms_row4096(out + (size_t)row * D, args.in[7], XN + (size_t)row * D, lane); }
    SEAM(3);
    if (IN(4)) {
        pg8::Gemm g{XN, (const bf16_t*)(ws + WS_WIN), D, D, D}; pg8::StaticOrder S; S.init(M, D, G, bx);
        pg8::EpiF32 E{U, D, 0}; pg8::gemm_phase<pg8::EpiF32, pg8::StaticOrder, true>(lds, g, S, E);
        if (DUPP == 4) pg8::gemm_phase<pg8::EpiF32, pg8::StaticOrder, true>(lds, g, S, E);
    }
    SEAM(4);
    REP(5) if (IN(5)) {
        const float* g_qa = args.in[9]; const float* g_kva = args.in[10]; const float* g_sq = args.in[15]; const float* g_sk = args.in[16];
        for (int row = gw; row < M; row += NGW) {
            const f32x4* ur = (const f32x4*)(U + (size_t)row * D);
            { f32x4 v[4]; float s = 0.f;
#pragma unroll
              for (int j = 0; j < 4; ++j) { const int c = lane + 64 * j; v[j] = (c < 224) ? ur[c] : (f32x4){0.f, 0.f, 0.f, 0.f}; s += sq4(v[j]); }
              const float rstd = rsq(wave_sum(s) * (1.f / CQ) + EPS);
#pragma unroll
              for (int j = 0; j < 4; ++j) { const int c = lane + 64 * j; if (c < 224) *((u32x2*)(CQN + (size_t)row * CQ) + c) = pack4(v[j] * rstd * ((const f32x4*)g_qa)[c]); } }
            { f32x4 v[2]; float s = 0.f;
#pragma unroll
              for (int j = 0; j < 2; ++j) { v[j] = ur[224 + lane + 64 * j]; s += sq4(v[j]); }
              const float rstd = rsq(wave_sum(s) * (1.f / CKV) + EPS);
#pragma unroll
              for (int j = 0; j < 2; ++j) { const int c = lane + 64 * j; *((u32x2*)(CKVN + (size_t)row * CKV) + c) = pack4(v[j] * rstd * ((const f32x4*)g_kva)[c]); } }
            if (lane < 16) *((f32x4*)(KRB + (size_t)row * KRD) + lane) = ur[352 + lane];
            { const f32x4 gq = ((const f32x4*)g_sq)[lane & 15];
#pragma unroll
              for (int j = 0; j < 8; ++j) { const int c = lane + 64 * j; const f32x4 v = ur[368 + c];
                  const float rstd = rsq(g16_sum(sq4(v)) * (1.f / SWA_D) + EPS) * (0.125f * LOG2E);
                  *((u32x2*)(QS + (size_t)row * SWAW) + c) = pack4(v * rstd * gq); } }
            { const f32x4 v = ur[880 + lane]; const float rstd = rsq(g16_sum(sq4(v)) * (1.f / SWA_D) + EPS);
              *((u32x2*)(KS + (size_t)row * SWAKW) + lane) = pack4(v * rstd * ((const f32x4*)g_sk)[lane & 15]); }
            *((u32x2*)(VS + (size_t)row * SWAKW) + lane) = pack4(ur[944 + lane]);
        }
    }
    SEAM(5);
    if (IN(6)) {
        { pg8::Gemm g{CQN, (const bf16_t*)(ws + WS_WUQ), CQ, CQ, CQ}; pg8::StaticOrder S; S.init(M, NQ, G, bx);
          pg8::EpiF32 E{QRAW, NQ, 0}; pg8::gemm_phase<pg8::EpiF32, pg8::StaticOrder, true>(lds, g, S, E); }
        { pg8::Gemm g{CKVN, (const bf16_t*)(ws + WS_WKN), CKV, CKV, CKV}; pg8::StaticOrder S; S.init(M, NKN, G, (bx + G / 2) % G);
          pg8::EpiF32 E{KNRAW, NKN, 0}; pg8::gemm_phase<pg8::EpiF32, pg8::StaticOrder, true>(lds, g, S, E); }
        { pg8::Gemm g{CKVN, (const bf16_t*)(ws + WS_WV), CKV, CKV, CKV}; pg8::StaticOrder S; S.init(M, NV, G, (bx + G / 2) % G);
          pg8::EpiBf16 E{VF, NV}; pg8::gemm_phase<pg8::EpiBf16, pg8::StaticOrder, true>(lds, g, S, E); }
    }
    SEAM(6);
    REP(7) if (IN(7)) {
        const float* g_q = args.in[13]; const float* g_k = args.in[14]; const float* g_mk = args.in[26];
        const int l16 = lane & 15, hg = lane >> 4;
        const float qscale = 0.07216878364870322f * LOG2E;
        for (int row = gw; row < M; row += NGW) {
            const int pos = row & (SEQ - 1);
            const f32x4* rp = (const f32x4*)(ROPE + (size_t)pos * 64);
            f32x4 cs0 = (f32x4){1.f, 0.f, 1.f, 0.f}, cs1 = cs0;
            if (l16 < 8) { cs0 = rp[2 * l16]; cs1 = rp[2 * l16 + 1]; }
#pragma unroll
            for (int it = 0; it < 4; ++it) { const int hh = 4 * it + hg; const f32x4* qr = (const f32x4*)(QRAW + (size_t)row * NQ + hh * MLA_QK);
                f32x4 a0 = qr[2 * l16], a1 = qr[2 * l16 + 1], x1 = (f32x4){0.f, 0.f, 0.f, 0.f}, x2 = x1;
                if (l16 < 8) { x1 = qr[32 + l16]; x2 = qr[40 + l16]; }
                const float rstd = rsq(g16_sum(sq4(a0) + sq4(a1) + sq4(x1) + sq4(x2)) * (1.f / MLA_QK) + EPS) * qscale;
                u32x2* qo = (u32x2*)(QF + (size_t)row * NQ + hh * MLA_QK);
                qo[2 * l16] = pack4(a0 * rstd * ((const f32x4*)g_q)[2 * l16]); qo[2 * l16 + 1] = pack4(a1 * rstd * ((const f32x4*)g_q)[2 * l16 + 1]);
                if (l16 < 8) { x1 = x1 * rstd * ((const f32x4*)g_q)[32 + l16]; x2 = x2 * rstd * ((const f32x4*)g_q)[40 + l16];
                    const f32x4 co = (f32x4){cs0.x, cs0.z, cs1.x, cs1.z}, si = (f32x4){cs0.y, cs0.w, cs1.y, cs1.w};
                    qo[32 + l16] = pack4(x1 * co - x2 * si); qo[40 + l16] = pack4(x2 * co + x1 * si); } }
            { f32x4 r1 = (f32x4){0.f, 0.f, 0.f, 0.f}, r2 = r1;
              if (l16 < 8) { r1 = ((const f32x4*)(KRB + (size_t)row * KRD))[l16]; r2 = ((const f32x4*)(KRB + (size_t)row * KRD))[8 + l16]; }
              const float ssr = g16_sum(sq4(r1) + sq4(r2));
              const f32x4 co = (f32x4){cs0.x, cs0.z, cs1.x, cs1.z}, si = (f32x4){cs0.y, cs0.w, cs1.y, cs1.w};
              f32x4 y1 = r1, y2 = r2;
              if (l16 < 8) { r1 = r1 * ((const f32x4*)g_k)[32 + l16]; r2 = r2 * ((const f32x4*)g_k)[40 + l16]; y1 = r1 * co - r2 * si; y2 = r2 * co + r1 * si; }
#pragma unroll
              for (int it = 0; it < 4; ++it) { const int hh = 4 * it + hg; const f32x4* kr = (const f32x4*)(KNRAW + (size_t)row * NKN + hh * MLA_NOPE);
                  const f32x4 a0 = kr[2 * l16], a1 = kr[2 * l16 + 1];
                  const float rstd = rsq((g16_sum(sq4(a0) + sq4(a1)) + ssr) * (1.f / MLA_QK) + EPS);
                  u32x2* ko = (u32x2*)(KF + (size_t)row * NQ + hh * MLA_QK);
                  ko[2 * l16] = pack4(a0 * rstd * ((const f32x4*)g_k)[2 * l16]); ko[2 * l16 + 1] = pack4(a1 * rstd * ((const f32x4*)g_k)[2 * l16 + 1]);
                  if (l16 < 8) { ko[32 + l16] = pack4(y1 * rstd); ko[40 + l16] = pack4(y2 * rstd); } } }
        }
        for (int row = gw; row < MROWS; row += NGW) {
            const f32x4* kr = (const f32x4*)(KVM + (size_t)row * 1024 + hg * 256);
            const f32x4 a0 = kr[2 * l16], a1 = kr[2 * l16 + 1], v0 = kr[32 + 2 * l16], v1 = kr[32 + 2 * l16 + 1];
            const float rstd = rsq(g16_sum(sq4(a0) + sq4(a1)) * (1.f / MEM_D) + EPS);
            u32x2* ko = (u32x2*)(KM + (size_t)row * 512 + hg * MEM_D); u32x2* vo = (u32x2*)(VM + (size_t)row * 512 + hg * MEM_D);
            ko[2 * l16] = pack4(a0 * rstd * ((const f32x4*)g_mk)[2 * l16]); ko[2 * l16 + 1] = pack4(a1 * rstd * ((const f32x4*)g_mk)[2 * l16 + 1]);
            vo[2 * l16] = pack4(v0); vo[2 * l16 + 1] = pack4(v1);
        }
    }
    SEAM(7);
    REP(8) if (IN(8)) {
        for (int u = bx; u < 256; u += G) { const int b = u >> 7, hh = (u >> 3) & 15, pi = u & 7;
            for (int sub = 0; sub < 2; ++sub) { const int qb = sub ? 15 - pi : pi; const int q0 = qb * 256 + 32 * wave; const size_t row0 = (size_t)b * SEQ + q0;
                attn_unit<MLA_QK, MLA_V, 1, false>(lds, tid, lane, QF + row0 * NQ + hh * MLA_QK, NQ, KF + (size_t)b * SEQ * NQ + hh * MLA_QK, NQ,
                    VF + (size_t)b * SEQ * NV + hh * MLA_V, NV, OB + row0 * D + hh * MLA_V, D, q0, 0, 4 * (qb + 1), NEGBIG, 0.f, nullptr); } }
        LAS float* biasL = (LAS float*)(lds + 98304);
        const float* sinks = args.in[17];
        for (int u = bx; u < 1024; u += G) { const int b = u >> 9, kvh = (u >> 7) & 3, qblk = u & 127; const int q0 = 32 * qblk, head = kvh * 8 + wave; const size_t row0 = (size_t)b * SEQ + q0;
            __syncthreads();
            for (int i = tid; i < 1024; i += 512) biasL[i] = BIAS[kvh * 1024 + i];
            const int jt0 = (q0 < 127) ? 0 : ((q0 - 127) >> 6), jt1 = ((q0 + 31) >> 6) + 1;
            attn_unit<SWA_D, SWA_D, 2, false>(lds, tid, lane, QS + row0 * SWAW + head * SWA_D, SWAW, KS + (size_t)b * SEQ * SWAKW + kvh * SWA_D, SWAKW,
                VS + (size_t)b * SEQ * SWAKW + kvh * SWA_D, SWAKW, OB + row0 * D + NV + head * SWA_D, D, q0, jt0, jt1, sinks[head] * LOG2E, 1.f, biasL + wave * 128); }
    }
    SEAM(8);
    REP(9) if (IN(9)) {
        const float* g_a = args.in[18]; const float* g_b = args.in[19];
        for (int row = gw; row < M; row += NGW) { const f32x4* orow = (const f32x4*)(OB + (size_t)row * D) + lane;
            f32x4 v[16]; float sa = 0.f, sb = 0.f;
#pragma unroll
            for (int j = 0; j < 8; ++j) { v[j] = orow[64 * j]; sa += sq4(v[j]); v[8 + j] = orow[64 * (8 + j)]; sb += sq4(v[8 + j]); }
            const float ra = rsq(wave_sum(sa) * (1.f / NV) + EPS), rb = rsq(wave_sum(sb) * (1.f / SWAW) + EPS);
            u32x2* o8 = (u32x2*)(XN + (size_t)row * D) + lane;
#pragma unroll
            for (int j = 0; j < 8; ++j) { o8[64 * j] = pack4(v[j] * ra * ((const f32x4*)g_a)[lane + 64 * j]); o8[64 * (8 + j)] = pack4(v[8 + j] * rb * ((const f32x4*)g_b)[lane + 64 * j]); } }
    }
    SEAM(9);
    if (IN(10)) {
        pg8::Gemm g{XN, (const bf16_t*)(ws + WS_WOUT), D, D, D}; pg8::StaticOrder S; S.init(M, D, G, bx);
        pg8::EpiRes E{out, out, D, 1.0f}; pg8::gemm_phase<pg8::EpiRes, pg8::StaticOrder, true>(lds, g, S, E);
    }
    SEAM(10);
    REP(11) if (IN(11)) { for (int row = gw; row < M; row += NGW) rms_row4096(out + (size_t)row * D, args.in[21], XN + (size_t)row * D, lane); }
    SEAM(11);
    if (IN(12)) {
        pg8::Gemm g{XN, (const bf16_t*)(ws + WS_WMQ), D, D, 1024}; pg8::OffsetOrder S; S.init(M / 256, 2, 4, G, bx, 0);
        pg8::EpiF32 E{QMP, 512, (size_t)M * 512}; pg8::gemm_phase<pg8::EpiF32, pg8::OffsetOrder, true>(lds, g, S, E);
    }
    SEAM(12);
    REP(13) if (IN(13)) {
        const float* g_mq = args.in[25]; const int l16 = lane & 15, hg = lane >> 4; const float sc = 0.08838834764831845f * LOG2E;
        for (int row = gw; row < M; row += NGW) {
            f32x4 a0 = (f32x4){0.f, 0.f, 0.f, 0.f}, a1 = a0;
#pragma unroll
            for (int ks = 0; ks < 4; ++ks) { const f32x4* p = (const f32x4*)(QMP + ((size_t)ks * M + row) * 512 + hg * MEM_D); a0 += p[2 * l16]; a1 += p[2 * l16 + 1]; }
            const float rstd = rsq(g16_sum(sq4(a0) + sq4(a1)) * (1.f / MEM_D) + EPS) * sc;
            u32x2* qo = (u32x2*)(QM + (size_t)row * 512 + hg * MEM_D);
            qo[2 * l16] = pack4(a0 * rstd * ((const f32x4*)g_mq)[2 * l16]); qo[2 * l16 + 1] = pack4(a1 * rstd * ((const f32x4*)g_mq)[2 * l16 + 1]);
        }
    }
    SEAM(13);
    REP(14) if (IN(14)) {
        for (int u = bx; u < 128; u += G) { const int b = u >> 6, hh = (u >> 4) & 3, qb = u & 15; const int q0 = qb * 256 + 32 * wave; const size_t row0 = (size_t)b * SEQ + q0;
            attn_unit<MEM_D, MEM_D, 0, true>(lds, tid, lane, QM + row0 * 512 + hh * MEM_D, 512, KM + (size_t)b * MEML * 512 + hh * MEM_D, 512,
                VM + (size_t)b * MEML * 512 + hh * MEM_D, 512, OM + row0 * 512 + hh * MEM_D, 512, q0, 0, 4, NEGBIG, 0.f, nullptr); }
    }
    SEAM(14);
    if (IN(15)) {
        pg8::Gemm g{OM, (const bf16_t*)(ws + WS_WMO), 512, 512, 512}; pg8::StaticOrder S; S.init(M, D, G, bx);
        pg8::EpiRes E{out, out, D, 1.0f}; pg8::gemm_phase<pg8::EpiRes, pg8::StaticOrder, true>(lds, g, S, E);
    }
    SEAM(15);
    REP(16) if (IN(16)) { for (int row = gw; row < M; row += NGW) rms_row4096(out + (size_t)row * D, args.in[28], XN + (size_t)row * D, lane); }
    SEAM(16);
    if (IN(17)) {
        pg8::Gemm g{XN, (const bf16_t*)(ws + WS_WGU_B), D, D, D}; pg8::StaticOrder S; S.init(M, 2 * FF, G, bx);
        pg8::EpiSwiGLU E{ACT, FF}; pg8::gemm_phase<pg8::EpiSwiGLU, pg8::StaticOrder, true>(lds, g, S, E);
    }
    SEAM(17);
    if (IN(18)) {
        pg8::Gemm g{ACT, (const bf16_t*)(ws + WS_WD_B), FF, FF, FF}; pg8::StaticOrder S; S.init(M, D, G, bx);
        pg8::EpiRes E{out, out, D, 0.5f}; pg8::gemm_phase<pg8::EpiRes, pg8::StaticOrder, true>(lds, g, S, E);
    }
#undef IN
#undef SEAM
}

extern "C" void kernel_launch(void* const* d_in, const int* in_sizes, int n_in, void* d_out, int out_size, void* d_ws, size_t ws_size, hipStream_t stream) {
    static int grid = 0;
    if (grid == 0) {
        if (n_in != 32 || out_size != M * D || ws_size < WS_END) { fprintf(stderr, "kernel_launch: unexpected problem (n_in %d, out %d, ws %zu); nothing launched\n", n_in, out_size, ws_size); grid = -1; return; }
        int dev = 0, cus = 0, per_cu = 0;
        if (hipGetDevice(&dev) != hipSuccess || hipDeviceGetAttribute(&cus, hipDeviceAttributeMultiprocessorCount, dev) != hipSuccess) { grid = -1; return; }
        if (hipFuncSetAttribute((const void*)fwd_kernel, hipFuncAttributeMaxDynamicSharedMemorySize, LDS_BYTES) != hipSuccess) { fprintf(stderr, "kernel_launch: hipFuncSetAttribute failed\n"); grid = -1; return; }
        if (hipOccupancyMaxActiveBlocksPerMultiprocessor(&per_cu, (const void*)fwd_kernel, NWAVES * 64, LDS_BYTES) != hipSuccess || per_cu < 1)
            fprintf(stderr, "kernel_launch: note: occupancy query reports %d workgroups per CU\n", per_cu);
        (void)hipGetLastError();
        grid = cus;
    }
    if (grid < 0) return;
    if (hipMemsetAsync((char*)d_ws + WS_CTL, 0, CTL_ZERO_BYTES, stream) != hipSuccess) return;
    Args a{};
    for (int i = 0; i < 32; ++i) a.in[i] = (const float*)d_in[i];
    a.out = (float*)d_out; a.ws = (unsigned char*)d_ws;
    if (MK_N_LAUNCHES == 1) {
        a.ph_lo = 0; a.ph_hi = NPHASE;
        hipLaunchKernelGGL(fwd_kernel, dim3(grid), dim3(NWAVES * 64), LDS_BYTES, stream, a);
    } else {
        for (int p = 0; p < NPHASE; ++p) { a.ph_lo = p; a.ph_hi = p + 1; hipLaunchKernelGGL(fwd_kernel, dim3(grid), dim3(NWAVES * 64), LDS_BYTES, stream, a); }
    }
}
```

```cpp
#include <hip/hip_runtime.h>
#include <cstdio>
#include <cstdint>

#ifndef MK_N_LAUNCHES
#define MK_N_LAUNCHES 1
#endif

#define GAS __attribute__((address_space(1)))
#define LAS __attribute__((address_space(3)))
typedef unsigned short bf16_t;
typedef short bf16x8 __attribute__((ext_vector_type(8)));
typedef short s16x4 __attribute__((ext_vector_type(4)));
typedef float f32x4 __attribute__((ext_vector_type(4)));
typedef float f32x16 __attribute__((ext_vector_type(16)));
typedef unsigned u32x4 __attribute__((ext_vector_type(4)));
typedef unsigned u32x2 __attribute__((ext_vector_type(2)));
typedef float f32x2_t __attribute__((ext_vector_type(2)));
typedef __bf16 bf16x2_t __attribute__((ext_vector_type(2)));
typedef GAS unsigned gu32;

#define LDS_WAIT() asm volatile("s_waitcnt lgkmcnt(0)" ::: "memory")
#define VM_WAIT() asm volatile("s_waitcnt vmcnt(0)" ::: "memory")
#define RLX_AGENT __ATOMIC_RELAXED, __HIP_MEMORY_SCOPE_AGENT

__device__ __forceinline__ unsigned cvtpk(float lo, float hi) { f32x2_t v = {lo, hi}; bf16x2_t b = __builtin_convertvector(v, bf16x2_t); return __builtin_bit_cast(unsigned, b); }
__device__ __forceinline__ float fast_exp2(float x) { return __builtin_amdgcn_exp2f(x); }
__device__ __forceinline__ float fast_rcp(float x) { return __builtin_amdgcn_rcpf(x); }
__device__ __forceinline__ float rsq(float x) { return 1.0f / __builtin_sqrtf(x); }

constexpr int SEQ = 4096, NB = 2, M = NB * SEQ, D = 4096, FF = 11008;
constexpr int MEML = 256, MROWS = NB * MEML;
constexpr int CQ = 896, CKV = 512, KRD = 64, INW = 4032;
constexpr int MLA_H = 16, MLA_QK = 192, MLA_NOPE = 128, MLA_V = 128;
constexpr int SWA_H = 32, SWA_KVH = 4, SWA_D = 64;
constexpr int MEM_H = 4, MEM_D = 128;
constexpr int NQ = MLA_H * MLA_QK;
constexpr int NKN = MLA_H * MLA_NOPE;
constexpr int NV = MLA_H * MLA_V;
constexpr int SWAW = SWA_H * SWA_D;
constexpr int SWAKW = SWA_KVH * SWA_D;
constexpr float EPS = 1e-6f;
constexpr float LOG2E = 1.4426950408889634f;
constexpr float NEGBIG = -1e30f;

constexpr size_t MiB = 1u << 20;
constexpr size_t WS_CTL = 0, CTL_ZERO_BYTES = 1 * MiB;
constexpr size_t WS_ROPE = 1 * MiB;
constexpr size_t WS_BIAS = 2 * MiB;
constexpr size_t WS_WGU_A = 4 * MiB;
constexpr size_t WS_WD_A = 176 * MiB;
constexpr size_t WS_WGU_B = 262 * MiB;
constexpr size_t WS_WD_B = 434 * MiB;
constexpr size_t WS_WIN = 520 * MiB;
constexpr size_t WS_WUQ = 552 * MiB;
constexpr size_t WS_WKN = 558 * MiB;
constexpr size_t WS_WV = 560 * MiB;
constexpr size_t WS_WOUT = 562 * MiB;
constexpr size_t WS_WMQ = 594 * MiB;
constexpr size_t WS_WMKV = 598 * MiB;
constexpr size_t WS_WMO = 606 * MiB;
constexpr size_t WS_XN = 610 * MiB;
constexpr size_t WS_ACT = 674 * MiB;
constexpr size_t WS_U = WS_ACT;
constexpr size_t WS_QRAW = WS_ACT;
constexpr size_t WS_KNRAW = WS_ACT + 96 * MiB;
constexpr size_t WS_O = WS_ACT;
constexpr size_t WS_QMP = WS_ACT;
constexpr size_t WS_QF = 846 * MiB;
constexpr size_t WS_KF = 894 * MiB;
constexpr size_t WS_VF = 942 * MiB;
constexpr size_t WS_QS = 974 * MiB;
constexpr size_t WS_KS = 1006 * MiB;
constexpr size_t WS_VS = 1010 * MiB;
constexpr size_t WS_CQN = 1014 * MiB;
constexpr size_t WS_CKVN = 1028 * MiB;
constexpr size_t WS_KRB = 1036 * MiB;
constexpr size_t WS_MEMN = 1038 * MiB;
constexpr size_t WS_KVM = 1042 * MiB;
constexpr size_t WS_KM = 1044 * MiB;
constexpr size_t WS_VM = 1044 * MiB + 512 * 1024;
constexpr size_t WS_QM = 1045 * MiB;
constexpr size_t WS_OM = 1053 * MiB;
constexpr size_t WS_END = 1061 * MiB;
constexpr int CW_TMO = 0;
constexpr int CW_BAR = 4096;

constexpr int RING_BYTES = 131072;
constexpr int MISC_OFF = RING_BYTES + 320;
constexpr int LDS_BYTES = 147456;
constexpr int NWAVES = 8;

namespace pg8 {
constexpr int BM = 256, BK = 64, HALF = 128, HTB = HALF * BK * 2, NXCD = 8, WGM = 8;
__host__ __device__ __forceinline__ int lds_byte(int r, int c) { const int st = (r >> 4) * 2 + (c >> 5), rr = r & 15, cc = c & 31, ob = rr * 64 + cc * 2; return st * 1024 + (ob ^ (((ob >> 9) & 1) << 5)); }
__host__ __device__ __forceinline__ void stage_rc(int b, int& R, int& C) { const int st = b / 1024, sb = b % 1024, swz = sb ^ (((sb >> 9) & 1) << 5); R = (st >> 1) * 16 + swz / 64; C = (st & 1) * 32 + (swz % 64) / 2; }
__host__ __device__ __forceinline__ int perm32(int rho) { const int n = rho >> 4, i = rho & 15; return 8 * (i >> 2) + 4 * n + (i & 3); }

struct Unit { int pm, pn, ks; };
struct Gemm { const bf16_t* A; const bf16_t* Bt; int lda, ldb, K; };

struct StaticOrder {
    int nM, nN, nwg, G, c;
    __device__ void init(int M_, int N_, int G_, int c_) { nM = M_ / BM; nN = N_ / BM; nwg = nM * nN; G = G_; c = c_; }
    __device__ bool next(int i, Unit& u) const {
        const long L = (long)i * G + c; if (L >= nwg) return false;
        int wgid = (int)L; { const int q = nwg / NXCD, r = nwg % NXCD, xcd = wgid % NXCD, off = wgid / NXCD; wgid = (xcd < r ? xcd * (q + 1) : r * (q + 1) + (xcd - r) * q) + off; }
        const int nig = WGM * nN, gid = wgid / nig, fm = gid * WGM, gsz = (nM - fm) < WGM ? (nM - fm) : WGM;
        u.pm = fm + ((wgid % nig) % gsz); u.pn = (wgid % nig) / gsz; u.ks = 0; return true;
    }
};
struct OffsetOrder {
    int n, c0, G, c, nN, nS;
    __device__ void init(int nM_, int nN_, int nS_, int G_, int c_, int c0_) { n = nM_ * nN_ * nS_; nN = nN_; nS = nS_; G = G_; c = c_; c0 = c0_; }
    __device__ bool next(int i, Unit& u) const {
        const int rel = (c - c0 + G) % G; const long L = (long)i * G + rel; if (L >= n) return false;
        const int t = (int)L; u.ks = t % nS; const int q = t / nS; u.pn = q % nN; u.pm = q / nN; return true;
    }
};

struct EpiF32 {
    static constexpr bool PERM = false;
    float* C; int ldc; size_t split_stride;
    __device__ __forceinline__ void operator()(const f32x4 (&acc)[2][2][4][2], const Unit& u, int wr, int wc, int fr, int fq) const {
        const int row0 = u.pm * BM + wr * 64 + fr, col0 = u.pn * BM + wc * 32 + 4 * fq;
        float* Cb = C + (size_t)u.ks * split_stride;
#pragma unroll
        for (int ai = 0; ai < 2; ++ai)
#pragma unroll
            for (int m = 0; m < 4; ++m) { float* rowp = Cb + (size_t)(row0 + ai * HALF + m * 16) * ldc + col0;
#pragma unroll
                for (int bj = 0; bj < 2; ++bj)
#pragma unroll
                    for (int n = 0; n < 2; ++n) *(f32x4*)(rowp + bj * HALF + n * 16) = acc[ai][bj][m][n]; }
    }
};
struct EpiRes {
    static constexpr bool PERM = false;
    const float* base; float* out; int ldc; float alpha;
    __device__ __forceinline__ void operator()(const f32x4 (&acc)[2][2][4][2], const Unit& u, int wr, int wc, int fr, int fq) const {
        const int row0 = u.pm * BM + wr * 64 + fr, col0 = u.pn * BM + wc * 32 + 4 * fq;
#pragma unroll
        for (int ai = 0; ai < 2; ++ai)
#pragma unroll
            for (int m = 0; m < 4; ++m) { const size_t off = (size_t)(row0 + ai * HALF + m * 16) * ldc + col0;
                f32x4 b[2][2];
#pragma unroll
                for (int bj = 0; bj < 2; ++bj)
#pragma unroll
                    for (int n = 0; n < 2; ++n) b[bj][n] = *(const f32x4*)(base + off + bj * HALF + n * 16);
#pragma unroll
                for (int bj = 0; bj < 2; ++bj)
#pragma unroll
                    for (int n = 0; n < 2; ++n) *(f32x4*)(out + off + bj * HALF + n * 16) = b[bj][n] + acc[ai][bj][m][n] * alpha; }
    }
};
struct EpiBf16 {
    static constexpr bool PERM = true;
    bf16_t* O; int ldc;
    __device__ __forceinline__ void operator()(const f32x4 (&acc)[2][2][4][2], const Unit& u, int wr, int wc, int fr, int fq) const {
        const int row0 = u.pm * BM + wr * 64 + fr, col0 = u.pn * BM + wc * 32 + 8 * fq;
#pragma unroll
        for (int ai = 0; ai < 2; ++ai)
#pragma unroll
            for (int m = 0; m < 4; ++m) { bf16_t* rowp = O + (size_t)(row0 + ai * HALF + m * 16) * ldc + col0;
#pragma unroll
                for (int bj = 0; bj < 2; ++bj) { const f32x4 v0 = acc[ai][bj][m][0], v1 = acc[ai][bj][m][1];
                    u32x4 w; w.x = cvtpk(v0[0], v0[1]); w.y = cvtpk(v0[2], v0[3]); w.z = cvtpk(v1[0], v1[1]); w.w = cvtpk(v1[2], v1[3]);
                    *(u32x4*)(rowp + bj * HALF) = w; } }
    }
};
struct EpiSwiGLU {
    static constexpr bool PERM = true;
    bf16_t* O; int ldc;
    __device__ __forceinline__ float sw(float g, float up) const { return g * fast_rcp(1.0f + fast_exp2(-LOG2E * g)) * up; }
    __device__ __forceinline__ void operator()(const f32x4 (&acc)[2][2][4][2], const Unit& u, int wr, int wc, int fr, int fq) const {
        const int row0 = u.pm * BM + wr * 64 + fr, col0 = u.pn * HALF + wc * 32 + 8 * fq;
#pragma unroll
        for (int ai = 0; ai < 2; ++ai)
#pragma unroll
            for (int m = 0; m < 4; ++m) { bf16_t* rowp = O + (size_t)(row0 + ai * HALF + m * 16) * ldc + col0;
                const f32x4 g0 = acc[ai][0][m][0], g1 = acc[ai][0][m][1], u0 = acc[ai][1][m][0], u1 = acc[ai][1][m][1];
                u32x4 w; w.x = cvtpk(sw(g0[0], u0[0]), sw(g0[1], u0[1])); w.y = cvtpk(sw(g0[2], u0[2]), sw(g0[3], u0[3]));
                w.z = cvtpk(sw(g1[0], u1[0]), sw(g1[1], u1[1])); w.w = cvtpk(sw(g1[2], u1[2]), sw(g1[3], u1[3]));
                *(u32x4*)rowp = w; }
    }
};

template <class Epi, class Sched, bool ALIGN_EPI>
__device__ __forceinline__ void gemm_phase(LAS unsigned char* lds, const Gemm g, const Sched& S, const Epi& E) {
    const int tid = threadIdx.x, wid = __builtin_amdgcn_readfirstlane(tid >> 6), lane = tid & 63, wr = wid >> 2, wc = wid & 3, fr = lane & 15, fq = lane >> 4;
    const int K = g.K, nt = K / BK;
    unsigned voffA[2], voffB[2];
#pragma unroll
    for (int i = 0; i < 2; ++i) { int R, C; stage_rc(tid * 16 + i * 8192, R, C); const int Rb = Epi::PERM ? ((R & ~31) + perm32(R & 31)) : R;
        voffA[i] = (unsigned)(R * g.lda + C) * 2u; voffB[i] = (unsigned)(Rb * g.ldb + C) * 2u; }
    const size_t kstep = (size_t)(BK * 2);
    const size_t hstepA = (size_t)HALF * g.lda * 2, hstepB = (size_t)HALF * g.ldb * 2;
    const size_t tstepA = 2 * hstepA, tstepB = 2 * hstepB;
    const unsigned ldsw = (unsigned)wid * 1024u;
    const int aoff = lds_byte(wr * 64 + fr, fq * 8), boff = lds_byte(wc * 32 + fr, fq * 8);
#define PG8_SA(b, h) (((b) * 2 + (h)) * HTB)
#define PG8_SB(b, h) ((4 + (b) * 2 + (h)) * HTB)
#define PG8_STAGE(bufoff, gbase, voff) do { _Pragma("unroll") for (int _i = 0; _i < 2; ++_i) \
        __builtin_amdgcn_global_load_lds((const unsigned*)((const char*)(gbase) + (voff)[_i]), (LAS unsigned*)(lds + (bufoff) + ldsw + _i * 8192), 16, 0, 0); } while (0)
#define PG8_LDA(dst, b, h) do { _Pragma("unroll") for (int m = 0; m < 4; ++m) _Pragma("unroll") for (int k = 0; k < 2; ++k) dst[m][k] = *(const LAS bf16x8*)(lds + PG8_SA(b, h) + aoff + m * 2048 + k * 1024); } while (0)
#define PG8_LDB(dst, b, h) do { _Pragma("unroll") for (int n = 0; n < 2; ++n) _Pragma("unroll") for (int k = 0; k < 2; ++k) dst[n][k] = *(const LAS bf16x8*)(lds + PG8_SB(b, h) + boff + n * 2048 + k * 1024); } while (0)
#define PG8_MMA(ai, bj, At, Bt) do { __builtin_amdgcn_s_setprio(1); _Pragma("unroll") for (int m = 0; m < 4; ++m) _Pragma("unroll") for (int n = 0; n < 2; ++n) _Pragma("unroll") for (int k = 0; k < 2; ++k) \
        acc[ai][bj][m][n] = __builtin_amdgcn_mfma_f32_16x16x32_bf16(Bt[n][k], At[m][k], acc[ai][bj][m][n], 0, 0, 0); __builtin_amdgcn_s_setprio(0); } while (0)
#define PG8_WAIT_V(n) asm volatile("s_waitcnt vmcnt(" #n ")" ::: "memory")
#define PG8_WAIT_L(n) asm volatile("s_waitcnt lgkmcnt(" #n ")" ::: "memory")
#define PG8_BAR __builtin_amdgcn_s_barrier()
#define PG8_SCHED __builtin_amdgcn_sched_barrier(0)
    Unit cur, nxt; int ui = 0;
    if (!S.next(0, cur)) return;
    f32x4 acc[2][2][4][2];
#pragma unroll
    for (int a = 0; a < 2; ++a)
#pragma unroll
        for (int b = 0; b < 2; ++b)
#pragma unroll
            for (int m = 0; m < 4; ++m)
#pragma unroll
                for (int n = 0; n < 2; ++n) acc[a][b][m][n] = (f32x4){0.f, 0.f, 0.f, 0.f};
    bf16x8 At[4][2], B0[2][2], B1[2][2];
    const char* cA = (const char*)g.A + (size_t)cur.pm * tstepA + (size_t)cur.ks * K * 2; const char* cB = (const char*)g.Bt + (size_t)cur.pn * tstepB + (size_t)cur.ks * K * 2;
    PG8_STAGE(PG8_SB(0, 0), cB, voffB); PG8_STAGE(PG8_SB(0, 1), cB + hstepB, voffB); PG8_STAGE(PG8_SA(0, 0), cA, voffA); PG8_STAGE(PG8_SA(0, 1), cA + hstepA, voffA);
    if (wr == 1) PG8_BAR;
    PG8_WAIT_V(2); PG8_BAR;
    PG8_STAGE(PG8_SB(1, 0), cB + kstep, voffB); PG8_STAGE(PG8_SA(1, 0), cA + kstep, voffA); PG8_STAGE(PG8_SB(1, 1), cB + hstepB + kstep, voffB);
    PG8_WAIT_V(6); PG8_BAR;
    for (;;) {
        const bool has_next = S.next(ui + 1, nxt);
        const char* nA = has_next ? (const char*)g.A + (size_t)nxt.pm * tstepA + (size_t)nxt.ks * K * 2 : cA;
        const char* nB = has_next ? (const char*)g.Bt + (size_t)nxt.pn * tstepB + (size_t)nxt.ks * K * 2 : cB;
        for (int t = 0; t < nt; t += 2) {
            const bool last = (t == nt - 2);
            const char* a1 = cA + (size_t)(t + 1) * kstep;
            const char* a2 = last ? nA : cA + (size_t)(t + 2) * kstep; const char* b2 = last ? nB : cB + (size_t)(t + 2) * kstep;
            const char* a3 = a2 + kstep; const char* b3 = b2 + kstep;
            PG8_LDB(B0, 0, 0); PG8_LDB(B1, 0, 1); PG8_SCHED; PG8_LDA(At, 0, 0); PG8_STAGE(PG8_SA(1, 1), a1 + hstepA, voffA);
            PG8_WAIT_V(8); PG8_WAIT_L(0); PG8_BAR; PG8_MMA(0, 0, At, B0); PG8_MMA(0, 1, At, B1); PG8_BAR; PG8_SCHED;
            PG8_LDA(At, 0, 1); PG8_STAGE(PG8_SB(0, 0), b2, voffB); PG8_STAGE(PG8_SB(0, 1), b2 + hstepB, voffB); PG8_STAGE(PG8_SA(0, 0), a2, voffA);
            PG8_WAIT_V(8); PG8_WAIT_L(0); PG8_BAR; PG8_MMA(1, 0, At, B0); PG8_MMA(1, 1, At, B1); PG8_BAR; PG8_SCHED;
            PG8_LDB(B0, 1, 0); PG8_LDB(B1, 1, 1); PG8_SCHED; PG8_LDA(At, 1, 0); PG8_STAGE(PG8_SA(0, 1), a2 + hstepA, voffA);
            PG8_WAIT_V(8); PG8_WAIT_L(0); PG8_BAR; PG8_MMA(0, 0, At, B0); PG8_MMA(0, 1, At, B1); PG8_BAR; PG8_SCHED;
            PG8_LDA(At, 1, 1); PG8_STAGE(PG8_SB(1, 0), b3, voffB); PG8_STAGE(PG8_SB(1, 1), b3 + hstepB, voffB); PG8_STAGE(PG8_SA(1, 0), a3, voffA);
            PG8_WAIT_V(8); PG8_WAIT_L(0); PG8_BAR; PG8_MMA(1, 0, At, B0); PG8_MMA(1, 1, At, B1); PG8_BAR; PG8_SCHED;
        }
        if constexpr (ALIGN_EPI) { if (wr == 0) PG8_BAR; }
        E(acc, cur, wr, wc, fr, fq);
        if (!has_next) break;
#pragma unroll
        for (int a = 0; a < 2; ++a)
#pragma unroll
            for (int b = 0; b < 2; ++b)
#pragma unroll
                for (int m = 0; m < 4; ++m)
#pragma unroll
                    for (int n = 0; n < 2; ++n) acc[a][b][m][n] = (f32x4){0.f, 0.f, 0.f, 0.f};
        cur = nxt; cA = nA; cB = nB; ++ui;
        if constexpr (ALIGN_EPI) { if (wr == 1) PG8_BAR; }
    }
    PG8_WAIT_V(0);
    if constexpr (!ALIGN_EPI) { if (wr == 0) PG8_BAR; }
    PG8_BAR;
#undef PG8_SA
#undef PG8_SB
#undef PG8_STAGE
#undef PG8_LDA
#undef PG8_LDB
#undef PG8_MMA
#undef PG8_WAIT_V
#undef PG8_WAIT_L
#undef PG8_BAR
#undef PG8_SCHED
}
}

#define XB_TMO      128
#define XB_XCNT(j)  (256  + 64 * (j))
#define XB_XSUB(j)  (1280 + 64 * (j))
#define XB_XGEN(j)  (2304 + 64 * (j))
#define XB_TOP      3328
#define XB_TOPGEN   3392
#define XCD_BAR_WORDS 3456
#define XB_SPIN_CAP (1u << 18)
__device__ __forceinline__ unsigned xb_ld(unsigned* p)              { return __hip_atomic_load(p, __ATOMIC_RELAXED, __HIP_MEMORY_SCOPE_AGENT); }
__device__ __forceinline__ unsigned xb_add(unsigned* p, unsigned v) { return __hip_atomic_fetch_add(p, v, __ATOMIC_RELAXED, __HIP_MEMORY_SCOPE_AGENT); }
__device__ __forceinline__ unsigned xb_xcc_id() { return (unsigned)__builtin_amdgcn_s_getreg((3 << 11) | 20) & 0xFu; }
#define XB_SPIN(cond, bar) do { unsigned _sp = 0; while (cond) { __builtin_amdgcn_s_sleep(1); \
    if ((++_sp & 255u) == 0u) { if (xb_ld(&(bar)[XB_TMO])) break; if (_sp > XB_SPIN_CAP) { atomicAdd(&(bar)[XB_TMO], 1u); break; } } } } while (0)
struct XcdBarrier { unsigned* bar; unsigned x; volatile LAS unsigned* st; };
__device__ __forceinline__ XcdBarrier xcd_barrier_post(unsigned* bar, volatile LAS unsigned* st) {
    XcdBarrier b; b.bar = bar; b.x = xb_xcc_id(); b.st = st;
    if (threadIdx.x == 0) (void)xb_add(&bar[XB_XCNT(b.x)], 1u);
    return b;
}
__device__ __forceinline__ void xcd_barrier_complete(unsigned* bar, unsigned x, unsigned& nloc, unsigned& nx) {
    const unsigned G = gridDim.x * gridDim.y * gridDim.z;
    unsigned sum, cnt, mine, sp = 0u;
    for (;;) {
        sum = 0u; cnt = 0u; mine = 0u;
#pragma unroll
        for (unsigned j = 0; j < 16; ++j) { const unsigned c = xb_ld(&bar[XB_XCNT(j)]); sum += c; cnt += (c > 0u) ? 1u : 0u; mine = (j == x) ? c : mine; }
        if (sum == G) break;
        __builtin_amdgcn_s_sleep(1);
        if ((++sp & 255u) == 0u) { if (xb_ld(&bar[XB_TMO])) break; if (sp > XB_SPIN_CAP) { atomicAdd(&bar[XB_TMO], 1u); break; } }
    }
    nloc = mine > 0u ? mine : 1u; nx = cnt > 0u ? cnt : 1u;
}
__device__ __forceinline__ void xcd_barrier(const XcdBarrier& b) {
    asm volatile("s_waitcnt vmcnt(0)" ::: "memory");
    __syncthreads();
    if (threadIdx.x == 0) {
        unsigned* bar = b.bar;
        __builtin_amdgcn_s_waitcnt(0);
        unsigned nloc = b.st[0], nx = b.st[1];
        if (nloc == 0u) { xcd_barrier_complete(bar, b.x, nloc, nx); b.st[0] = nloc; b.st[1] = nx; }
        const unsigned old = xb_add(&bar[XB_XSUB(b.x)], 1u);
        const unsigned gen = old / nloc;
        if (old + 1u == (gen + 1u) * nloc) {
            __builtin_amdgcn_fence(__ATOMIC_RELEASE, "agent");
            asm volatile("s_waitcnt vmcnt(0)" ::: "memory");
            const unsigned og = xb_add(&bar[XB_TOP], 1u);
            const unsigned tg = og / nx;
            if (og + 1u == (tg + 1u) * nx) xb_add(&bar[XB_TOPGEN], 1u);
            else XB_SPIN(xb_ld(&bar[XB_TOPGEN]) == tg, bar);
            __builtin_amdgcn_fence(__ATOMIC_ACQUIRE, "agent");
            xb_add(&bar[XB_XGEN(b.x)], 1u);
            asm volatile("s_waitcnt vmcnt(0)" ::: "memory");
        } else {
            XB_SPIN(xb_ld(&bar[XB_XGEN(b.x)]) == gen, bar);
            __builtin_amdgcn_fence(__ATOMIC_ACQUIRE, "agent");
            asm volatile("s_waitcnt vmcnt(0)" ::: "memory");
        }
    }
    __syncthreads();
}

__device__ __forceinline__ float wave_sum(float v) {
#pragma unroll
    for (int o = 1; o < 64; o <<= 1) v += __shfl_xor(v, o);
    return v;
}
__device__ __forceinline__ float g16_sum(float v) {
#pragma unroll
    for (int o = 1; o < 16; o <<= 1) v += __shfl_xor(v, o);
    return v;
}
__device__ __forceinline__ float sq4(f32x4 v) { return (v.x * v.x + v.y * v.y) + (v.z * v.z + v.w * v.w); }
__device__ __forceinline__ u32x2 pack4(f32x4 v) { u32x2 w; w.x = cvtpk(v.x, v.y); w.y = cvtpk(v.z, v.w); return w; }

struct XItem { const float* src; bf16_t* dst; int srcN, col0, K, row0, k0; };
__device__ __forceinline__ void xi_load(const XItem& x, f32x4 (&v)[8], int lane) {
    const int kg = lane >> 3, c4 = lane & 7;
    if (x.col0 >= 0) {
        const float* p = x.src + (size_t)(x.k0 + 8 * kg) * x.srcN + x.col0 + 4 * c4;
#pragma unroll
        for (int i = 0; i < 8; ++i) v[i] = *(const f32x4*)(p + (size_t)i * x.srcN);
    } else {
#pragma unroll
        for (int i = 0; i < 8; ++i) v[i] = (f32x4){0.f, 0.f, 0.f, 0.f};
    }
}
__device__ __forceinline__ void xi_store(const XItem& x, const f32x4 (&v)[8], int lane) {
    const int kg = lane >> 3, c4 = lane & 7;
    bf16_t* d = x.dst + (size_t)(x.row0 + 4 * c4) * x.K + x.k0 + 8 * kg;
#pragma unroll
    for (int j = 0; j < 4; ++j) { u32x4 o; o.x = cvtpk(v[0][j], v[1][j]); o.y = cvtpk(v[2][j], v[3][j]); o.z = cvtpk(v[4][j], v[5][j]); o.w = cvtpk(v[6][j], v[7][j]);
        *(GAS u32x4*)(d + (size_t)j * x.K) = o; }
}
__device__ __forceinline__ void rms_row4096(const float* xrow, const float* gain, bf16_t* orow, int lane) {
    const f32x4* xr = (const f32x4*)xrow + lane; const f32x4* gr = (const f32x4*)gain + lane;
    f32x4 v[16]; float s = 0.f;
#pragma unroll
    for (int j = 0; j < 16; ++j) { v[j] = xr[64 * j]; s += sq4(v[j]); }
    const float rstd = rsq(wave_sum(s) * (1.f / 4096.f) + EPS);
    u32x2* o8 = (u32x2*)orow + lane;
#pragma unroll
    for (int j = 0; j < 16; ++j) { const f32x4 gg = gr[64 * j]; o8[64 * j] = pack4(v[j] * rstd * gg); }
}

template <int DQK, int DV> struct ACfg {
    static constexpr int PK = DQK * 2 + 16, PV = DV * 2 + 64;
    static constexpr int KT = 64 * PK, VT = 64 * PV, STAGE = KT + VT;
    static constexpr int KCH = DQK / 8, VCH = DV / 8, NKL = 64 * KCH / 512, NVL = 64 * VCH / 512;
};
#define MFMA32(a, b, c) __builtin_amdgcn_mfma_f32_32x32x16_bf16((a), (b), (c), 0, 0, 0)
__device__ __forceinline__ s16x4 vtr(const LAS unsigned char* p) { return __builtin_bit_cast(s16x4, __builtin_amdgcn_ds_read_tr16_b64_v4i16((LAS s16x4*)p)); }

template <int DQK, int DV, int MODE, bool OBF16>
__device__ __forceinline__ void attn_unit(LAS unsigned char* lds, int tid, int lane,
                                          const bf16_t* Qw, int qpitch, const bf16_t* Kb, int kpitch, const bf16_t* Vb, int vpitch,
                                          void* Ow, int opitch, int q0, int jt0, int jt1, float m_init, float l_init, const LAS float* biasw) {
    using C = ACfg<DQK, DV>;
    const int r = lane & 31, h = lane >> 5;
    bf16x8 qf[DQK / 16];
#pragma unroll
    for (int ks = 0; ks < DQK / 16; ++ks) qf[ks] = *(const bf16x8*)(Qw + (size_t)r * qpitch + ks * 16 + h * 8);
    f32x16 O[DV / 32];
#pragma unroll
    for (int d = 0; d < DV / 32; ++d)
#pragma unroll
        for (int i = 0; i < 16; ++i) O[d][i] = 0.f;
    float m = m_init, l = (h == 0) ? l_init : 0.f;
    u32x4 kst[C::NKL], vst[C::NVL];
    unsigned kgo[C::NKL], vgo[C::NVL];
#pragma unroll
    for (int i = 0; i < C::NKL; ++i) { const int c = tid + 512 * i, row = c / C::KCH, cc = c % C::KCH; kgo[i] = (unsigned)(row * kpitch + cc * 8) * 2u; }
#pragma unroll
    for (int i = 0; i < C::NVL; ++i) { const int c = tid + 512 * i, row = c / C::VCH, cc = c % C::VCH; vgo[i] = (unsigned)(row * vpitch + cc * 8) * 2u; }
#define ATT_LOAD(jt) do { const char* kt_ = (const char*)Kb + (size_t)(jt) * 64 * kpitch * 2; const char* vt_ = (const char*)Vb + (size_t)(jt) * 64 * vpitch * 2; \
        _Pragma("unroll") for (int i = 0; i < C::NKL; ++i) kst[i] = *(const u32x4*)(kt_ + kgo[i]); \
        _Pragma("unroll") for (int i = 0; i < C::NVL; ++i) vst[i] = *(const u32x4*)(vt_ + vgo[i]); } while (0)
#define ATT_STORE(buf) do { \
        _Pragma("unroll") for (int i = 0; i < C::NKL; ++i) { const int c = tid + 512 * i, row = c / C::KCH, cc = c % C::KCH; *(LAS u32x4*)(lds + (buf) * C::STAGE + row * C::PK + cc * 16) = kst[i]; } \
        _Pragma("unroll") for (int i = 0; i < C::NVL; ++i) { const int c = tid + 512 * i, row = c / C::VCH, cc = c % C::VCH; *(LAS u32x4*)(lds + (buf) * C::STAGE + C::KT + row * C::PV + cc * 16) = vst[i]; } } while (0)
    __syncthreads();
    ATT_LOAD(jt0); ATT_STORE(0);
    for (int jt = jt0; jt < jt1; ++jt) {
        const int buf = (jt - jt0) & 1;
        __syncthreads();
        const bool more = (jt + 1 < jt1);
        if (more) ATT_LOAD(jt + 1);
        const bool active = (MODE == 1) ? (jt * 64 <= q0 + 31) : true;
        if (active) {
            const LAS unsigned char* kb_ = lds + buf * C::STAGE; const LAS unsigned char* vb_ = kb_ + C::KT;
            const int qpos = q0 + r;
#pragma unroll 1
            for (int kb = 0; kb < 2; ++kb) {
                if (MODE == 1 && jt * 64 + 32 * kb > q0 + 31) break;
                f32x16 S;
#pragma unroll
                for (int i = 0; i < 16; ++i) S[i] = 0.f;
                const LAS unsigned char* kp = kb_ + (32 * kb + r) * C::PK + h * 16;
#pragma unroll
                for (int ks = 0; ks < DQK / 16; ++ks) { const bf16x8 a0 = *(const LAS bf16x8*)(kp + ks * 32); S = MFMA32(a0, qf[ks], S); }
                const int kbase = jt * 64 + 32 * kb + 4 * h;
                if (MODE == 1) {
                    if (kbase - 4 * h + 31 > q0) {
#pragma unroll
                        for (int i = 0; i < 16; ++i) { const int key = kbase + (i & 3) + 8 * (i >> 2); if (key > qpos) S[i] = NEGBIG; }
                    }
                }
                if (MODE == 2) {
#pragma unroll
                    for (int i = 0; i < 16; ++i) { const int d0 = qpos - (kbase + (i & 3) + 8 * (i >> 2));
                        const float b0 = biasw[d0 & 127];
                        S[i] = ((unsigned)d0 < 128u) ? S[i] + b0 : NEGBIG; }
                }
                float mx = S[0];
#pragma unroll
                for (int i = 1; i < 16; ++i) mx = fmaxf(mx, S[i]);
                mx = fmaxf(mx, __shfl_xor(mx, 32));
                const float mn = fmaxf(m, mx); const float alpha = fast_exp2(m - mn); m = mn;
                float ps = 0.f;
#pragma unroll
                for (int i = 0; i < 16; ++i) { S[i] = fast_exp2(S[i] - mn); ps += S[i]; }
                l = l * alpha + ps;
#pragma unroll
                for (int d = 0; d < DV / 32; ++d)
#pragma unroll
                    for (int i = 0; i < 16; ++i) O[d][i] *= alpha;
                bf16x8 pf[2];
#pragma unroll
                for (int t = 0; t < 2; ++t) { u32x4 w; const int o = 8 * t;
                    w.x = cvtpk(S[o], S[o + 1]); w.y = cvtpk(S[o + 2], S[o + 3]); w.z = cvtpk(S[o + 4], S[o + 5]); w.w = cvtpk(S[o + 6], S[o + 7]);
                    pf[t] = __builtin_bit_cast(bf16x8, w); }
                const LAS unsigned char* vp = vb_ + (32 * kb + 4 * h + ((lane & 15) >> 2)) * C::PV + ((lane >> 4) & 1) * 32 + (lane & 3) * 8;
#pragma unroll
                for (int d = 0; d < DV / 32; ++d)
#pragma unroll
                    for (int t = 0; t < 2; ++t) { const s16x4 lo = vtr(vp + t * 16 * C::PV + d * 64), hi = vtr(vp + t * 16 * C::PV + 8 * C::PV + d * 64);
                        const bf16x8 vf = {lo.x, lo.y, lo.z, lo.w, hi.x, hi.y, hi.z, hi.w};
                        O[d] = MFMA32(vf, pf[t], O[d]); }
            }
        }
        if (more) ATT_STORE(buf ^ 1);
    }
#undef ATT_LOAD
#undef ATT_STORE
    l += __shfl_xor(l, 32);
    const float inv = 1.0f / l;
#pragma unroll
    for (int d = 0; d < DV / 32; ++d)
#pragma unroll
        for (int tq = 0; tq < 4; ++tq) { const int dv = 32 * d + 8 * tq + 4 * h;
            const f32x4 o = (f32x4){O[d][4 * tq], O[d][4 * tq + 1], O[d][4 * tq + 2], O[d][4 * tq + 3]} * inv;
            if (OBF16) *(u32x2*)((bf16_t*)Ow + (size_t)r * opitch + dv) = pack4(o);
            else *(f32x4*)((float*)Ow + (size_t)r * opitch + dv) = o; }
}

constexpr int NPHASE = 19;
struct Args { const float* in[32]; float* out; unsigned char* ws; int ph_lo, ph_hi; };
static_assert(sizeof(Args) == 32 * 8 + 8 + 8 + 8, "Args has no padding");

__global__ void __launch_bounds__(NWAVES * 64, 2) fwd_kernel(Args args) {
    extern __shared__ __attribute__((aligned(16))) unsigned char lds_raw[];
    LAS unsigned char* lds = (LAS unsigned char*)lds_raw;
    volatile LAS unsigned* MISC = (volatile LAS unsigned*)(lds + MISC_OFF);
    const int tid = threadIdx.x, lane = tid & 63, wave = __builtin_amdgcn_readfirstlane(tid >> 6);
    const int G = gridDim.x; const int bx = blockIdx.x; const int vcu = (G % 8 == 0) ? (bx % 8) * (G / 8) + bx / 8 : bx;
    const int gw = vcu * NWAVES + wave, NGW = G * NWAVES;
    unsigned char* ws = args.ws;
    gu32* ctl = (gu32*)(ws + WS_CTL);
    for (int u = tid; u < (LDS_BYTES - RING_BYTES) / 4; u += NWAVES * 64) ((LAS unsigned*)(lds + RING_BYTES))[u] = 0u;
    __syncthreads();
    XcdBarrier bar; bar.bar = (unsigned*)(ctl + CW_BAR); bar.x = 0; bar.st = nullptr;
    if (MK_N_LAUNCHES == 1) bar = xcd_barrier_post((unsigned*)(ctl + CW_BAR), MISC + 8);
    const int lo = args.ph_lo, hi = args.ph_hi;
#ifndef ONLYP
#define ONLYP -1
#endif
#define IN(k) ((ONLYP < 0 || ONLYP == (k)) && lo <= (k) && (k) < hi)
#define SEAM(k) do { if (IN(k) && IN((k) + 1)) xcd_barrier(bar); } while (0)
#ifndef DUPP
#define DUPP -1
#endif
#define REP(k) for (int rep_ = 0; rep_ < ((DUPP == (k)) ? 2 : 1); ++rep_)

    const float* x = args.in[0]; const float* mem = args.in[1]; const float* rel_bias = args.in[2];
    float* out = args.out;
    bf16_t* XN = (bf16_t*)(ws + WS_XN); bf16_t* ACT = (bf16_t*)(ws + WS_ACT);
    float* U = (float*)(ws + WS_U); float* QRAW = (float*)(ws + WS_QRAW); float* KNRAW = (float*)(ws + WS_KNRAW); float* OB = (float*)(ws + WS_O); float* QMP = (float*)(ws + WS_QMP);
    bf16_t* QF = (bf16_t*)(ws + WS_QF); bf16_t* KF = (bf16_t*)(ws + WS_KF); bf16_t* VF = (bf16_t*)(ws + WS_VF);
    bf16_t* QS = (bf16_t*)(ws + WS_QS); bf16_t* KS = (bf16_t*)(ws + WS_KS); bf16_t* VS = (bf16_t*)(ws + WS_VS);
    bf16_t* CQN = (bf16_t*)(ws + WS_CQN); bf16_t* CKVN = (bf16_t*)(ws + WS_CKVN); float* KRB = (float*)(ws + WS_KRB);
    bf16_t* MEMN = (bf16_t*)(ws + WS_MEMN); float* KVM = (float*)(ws + WS_KVM); bf16_t* KM = (bf16_t*)(ws + WS_KM); bf16_t* VM = (bf16_t*)(ws + WS_VM);
    bf16_t* QM = (bf16_t*)(ws + WS_QM); bf16_t* OM = (bf16_t*)(ws + WS_OM);
    float* ROPE = (float*)(ws + WS_ROPE); float* BIAS = (float*)(ws + WS_BIAS);

    REP(0) if (IN(0)) {
        const float* wgate_a = args.in[4]; const float* wup_a = args.in[5]; const float* wdown_a = args.in[6];
        const float* wgate_b = args.in[29]; const float* wup_b = args.in[30]; const float* wdown_b = args.in[31];
        constexpr int I_GU = 64 * 688, I_D = 172 * 128, I_IN = 64 * 128, I_UQ = 14 * 96, I_KN = 8 * 64, I_OUT = 64 * 128, I_MQ = 64 * 16, I_MKV = 64 * 32, I_MO = 8 * 128;
        constexpr int NITEMS = 2 * I_GU + 2 * I_D + I_IN + I_UQ + 2 * I_KN + I_OUT + I_MQ + I_MKV + I_MO;
#define XI_DECODE(X, IT) do { int r = (IT); \
            if (r < 2 * I_GU) { const int which = r >= I_GU; if (which) r -= I_GU; const int nb = r % 688, kb = r / 688, t = nb >> 3, w = nb & 7; \
                X.src = which ? ((w >> 2) ? wup_b : wgate_b) : ((w >> 2) ? wup_a : wgate_a); X.srcN = FF; X.col0 = 128 * t + 32 * (w & 3); X.K = D; X.dst = (bf16_t*)(ws + (which ? WS_WGU_B : WS_WGU_A)); X.row0 = 32 * nb; X.k0 = 64 * kb; break; } \
            r -= 2 * I_GU; \
            if (r < 2 * I_D) { const int which = r >= I_D; if (which) r -= I_D; const int nb = r % 128, kb = r / 128; \
                X.src = which ? wdown_b : wdown_a; X.srcN = D; X.col0 = 32 * nb; X.K = FF; X.dst = (bf16_t*)(ws + (which ? WS_WD_B : WS_WD_A)); X.row0 = 32 * nb; X.k0 = 64 * kb; break; } \
            r -= 2 * I_D; \
            if (r < I_IN) { const int nb = r % 128, kb = r / 128; \
                X.src = args.in[8]; X.srcN = INW; X.col0 = (32 * nb < INW) ? 32 * nb : -1; X.K = D; X.dst = (bf16_t*)(ws + WS_WIN); X.row0 = 32 * nb; X.k0 = 64 * kb; break; } \
            r -= I_IN; \
            if (r < I_UQ) { const int nb = r % 96, kb = r / 96; \
                X.src = args.in[11]; X.srcN = NQ; X.col0 = 32 * nb; X.K = CQ; X.dst = (bf16_t*)(ws + WS_WUQ); X.row0 = 32 * nb; X.k0 = 64 * kb; break; } \
            r -= I_UQ; \
            if (r < 2 * I_KN) { const int which = r >= I_KN; if (which) r -= I_KN; const int nb = r % 64, kb = r / 64; \
                X.src = args.in[12]; X.srcN = 4096; X.col0 = (nb >> 2) * 256 + which * 128 + 32 * (nb & 3); X.K = CKV; X.dst = (bf16_t*)(ws + (which ? WS_WV : WS_WKN)); X.row0 = 32 * nb; X.k0 = 64 * kb; break; } \
            r -= 2 * I_KN; \
            if (r < I_OUT) { const int nb = r % 128, kb = r / 128; \
                X.src = args.in[20]; X.srcN = D; X.col0 = 32 * nb; X.K = D; X.dst = (bf16_t*)(ws + WS_WOUT); X.row0 = 32 * nb; X.k0 = 64 * kb; break; } \
            r -= I_OUT; \
            if (r < I_MQ) { const int nb = r % 16, kb = r / 16; \
                X.src = args.in[23]; X.srcN = 512; X.col0 = 32 * nb; X.K = D; X.dst = (bf16_t*)(ws + WS_WMQ); X.row0 = 32 * nb; X.k0 = 64 * kb; break; } \
            r -= I_MQ; \
            if (r < I_MKV) { const int nb = r % 32, kb = r / 32; \
                X.src = args.in[24]; X.srcN = 1024; X.col0 = 32 * nb; X.K = D; X.dst = (bf16_t*)(ws + WS_WMKV); X.row0 = 32 * nb; X.k0 = 64 * kb; break; } \
            r -= I_MKV; \
            { const int nb = r % 128, kb = r / 128; \
                X.src = args.in[27]; X.srcN = D; X.col0 = 32 * nb; X.K = 512; X.dst = (bf16_t*)(ws + WS_WMO); X.row0 = 32 * nb; X.k0 = 64 * kb; } } while (0)
        { int it = gw; XItem cur, nx; f32x4 v[8], vn[8];
          if (it < NITEMS) { XI_DECODE(cur, it); xi_load(cur, v, lane); }
          while (it < NITEMS) {
              const int itn = it + NGW;
              if (itn < NITEMS) { XI_DECODE(nx, itn); xi_load(nx, vn, lane); }
              xi_store(cur, v, lane);
#pragma unroll
              for (int i = 0; i < 8; ++i) v[i] = vn[i];
              cur = nx; it = itn;
          } }
#undef XI_DECODE
        for (int row = gw; row < M; row += NGW) rms_row4096(x + (size_t)row * D, args.in[3], XN + (size_t)row * D, lane);
        for (int row = gw; row < MROWS; row += NGW) rms_row4096(mem + (size_t)row * D, args.in[22], MEMN + (size_t)row * D, lane);
        for (int i = gw * 64 + lane; i < SEQ * 32; i += NGW * 64) { const int pos = i >> 5, j = i & 31;
            const float inv = exp2f(-(float)j * (13.287712379549449f / 32.f)); const float ang = (float)pos * inv;
            ROPE[2 * i] = cosf(ang); ROPE[2 * i + 1] = sinf(ang); }
        for (int i = gw * 64 + lane; i < SWA_H * 128; i += NGW * 64) { const int hh = i >> 7, d = i & 127;
            int bk = d; if (d >= 16) { bk = 16 + (int)(logf((float)d / 16.f) / 2.0794415416798357f * 16.f); if (bk > 31) bk = 31; }
            BIAS[i] = rel_bias[bk * SWA_H + hh] * LOG2E; }
    }
    SEAM(0);

    if (IN(1)) {
        { pg8::Gemm g{XN, (const bf16_t*)(ws + WS_WGU_A), D, D, D}; pg8::StaticOrder S; S.init(M, 2 * FF, G, bx);
          pg8::EpiSwiGLU E{ACT, FF}; pg8::gemm_phase<pg8::EpiSwiGLU, pg8::StaticOrder, true>(lds, g, S, E);
          if (DUPP == 1) pg8::gemm_phase<pg8::EpiSwiGLU, pg8::StaticOrder, true>(lds, g, S, E); }
        { pg8::Gemm g{MEMN, (const bf16_t*)(ws + WS_WMKV), D, D, D}; pg8::OffsetOrder S; S.init(MROWS / 256, 1024 / 256, 1, G, bx, 192 % G);
          pg8::EpiF32 E{KVM, 1024, 0}; pg8::gemm_phase<pg8::EpiF32, pg8::OffsetOrder, true>(lds, g, S, E); }
    }
    SEAM(1);
    if (IN(2)) {
        pg8::Gemm g{ACT, (const bf16_t*)(ws + WS_WD_A), FF, FF, FF}; pg8::StaticOrder S; S.init(M, D, G, bx);
        pg8::EpiRes E{x, out, D, 0.5f}; pg8::gemm_phase<pg8::EpiRes, pg8::StaticOrder, true>(lds, g, S, E);
        if (DUPP == 2) pg8::gemm_phase<pg8::EpiRes, pg8::StaticOrder, true>(lds, g, S, E);
    }
    SEAM(2);
    REP(3) if (IN(3)) { for (int row = gw; row < M; row += NGW) rms_row4096(out + (size_t)row * D, args.in[7], XN + (size_t)row * D, lane); }
    SEAM(3);
    if (IN(4)) {
        pg8::Gemm g{XN, (const bf16_t*)(ws + WS_WIN), D, D, D}; pg8::StaticOrder S; S.init(M, D, G, bx);
        pg8::EpiF32 E{U, D, 0}; pg8::gemm_phase<pg8::EpiF32, pg8::StaticOrder, true>(lds, g, S, E);
        if (DUPP == 4) pg8::gemm_phase<pg8::EpiF32, pg8::StaticOrder, true>(lds, g, S, E);
    }
    SEAM(4);
    REP(5) if (IN(5)) {
        const float* g_qa = args.in[9]; const float* g_kva = args.in[10]; const float* g_sq = args.in[15]; const float* g_sk = args.in[16];
        for (int row = gw; row < M; row += NGW) {
            const f32x4* ur = (const f32x4*)(U + (size_t)row * D);
            { f32x4 v[4]; float s = 0.f;
#pragma unroll
              for (int j = 0; j < 4; ++j) { const int c = lane + 64 * j; v[j] = (c < 224) ? ur[c] : (f32x4){0.f, 0.f, 0.f, 0.f}; s += sq4(v[j]); }
              const float rstd = rsq(wave_sum(s) * (1.f / CQ) + EPS);
#pragma unroll
              for (int j = 0; j < 4; ++j) { const int c = lane + 64 * j; if (c < 224) *((u32x2*)(CQN + (size_t)row * CQ) + c) = pack4(v[j] * rstd * ((const f32x4*)g_qa)[c]); } }
            { f32x4 v[2]; float s = 0.f;
#pragma unroll
              for (int j = 0; j < 2; ++j) { v[j] = ur[224 + lane + 64 * j]; s += sq4(v[j]); }
              const float rstd = rsq(wave_sum(s) * (1.f / CKV) + EPS);
#pragma unroll
              for (int j = 0; j < 2; ++j) { const int c = lane + 64 * j; *((u32x2*)(CKVN + (size_t)row * CKV) + c) = pack4(v[j] * rstd * ((const f32x4*)g_kva)[c]); } }
            if (lane < 16) *((f32x4*)(KRB + (size_t)row * KRD) + lane) = ur[352 + lane];
            { const f32x4 gq = ((const f32x4*)g_sq)[lane & 15];
#pragma unroll
              for (int j = 0; j < 8; ++j) { const int c = lane + 64 * j; const f32x4 v = ur[368 + c];
                  const float rstd = rsq(g16_sum(sq4(v)) * (1.f / SWA_D) + EPS) * (0.125f * LOG2E);
                  *((u32x2*)(QS + (size_t)row * SWAW) + c) = pack4(v * rstd * gq); } }
            { const f32x4 v = ur[880 + lane]; const float rstd = rsq(g16_sum(sq4(v)) * (1.f / SWA_D) + EPS);
              *((u32x2*)(KS + (size_t)row * SWAKW) + lane) = pack4(v * rstd * ((const f32x4*)g_sk)[lane & 15]); }
            *((u32x2*)(VS + (size_t)row * SWAKW) + lane) = pack4(ur[944 + lane]);
        }
    }
    SEAM(5);
    if (IN(6)) {
        { pg8::Gemm g{CQN, (const bf16_t*)(ws + WS_WUQ), CQ, CQ, CQ}; pg8::StaticOrder S; S.init(M, NQ, G, bx);
          pg8::EpiF32 E{QRAW, NQ, 0}; pg8::gemm_phase<pg8::EpiF32, pg8::StaticOrder, true>(lds, g, S, E); }
        { pg8::Gemm g{CKVN, (const bf16_t*)(ws + WS_WKN), CKV, CKV, CKV}; pg8::StaticOrder S; S.init(M, NKN, G, (bx + G / 2) % G);
          pg8::EpiF32 E{KNRAW, NKN, 0}; pg8::gemm_phase<pg8::EpiF32, pg8::StaticOrder, true>(lds, g, S, E); }
        { pg8::Gemm g{CKVN, (const bf16_t*)(ws + WS_WV), CKV, CKV, CKV}; pg8::StaticOrder S; S.init(M, NV, G, (bx + G / 2) % G);
          pg8::EpiBf16 E{VF, NV}; pg8::gemm_phase<pg8::EpiBf16, pg8::StaticOrder, true>(lds, g, S, E); }
    }
    SEAM(6);
    REP(7) if (IN(7)) {
        const float* g_q = args.in[13]; const float* g_k = args.in[14]; const float* g_mk = args.in[26];
        const int l16 = lane & 15, hg = lane >> 4;
        const float qscale = 0.07216878364870322f * LOG2E;
        for (int row = gw; row < M; row += NGW) {
            const int pos = row & (SEQ - 1);
            const f32x4* rp = (const f32x4*)(ROPE + (size_t)pos * 64);
            f32x4 cs0 = (f32x4){1.f, 0.f, 1.f, 0.f}, cs1 = cs0;
            if (l16 < 8) { cs0 = rp[2 * l16]; cs1 = rp[2 * l16 + 1]; }
#pragma unroll
            for (int it = 0; it < 4; ++it) { const int hh = 4 * it + hg; const f32x4* qr = (const f32x4*)(QRAW + (size_t)row * NQ + hh * MLA_QK);
                f32x4 a0 = qr[2 * l16], a1 = qr[2 * l16 + 1], x1 = (f32x4){0.f, 0.f, 0.f, 0.f}, x2 = x1;
                if (l16 < 8) { x1 = qr[32 + l16]; x2 = qr[40 + l16]; }
                const float rstd = rsq(g16_sum(sq4(a0) + sq4(a1) + sq4(x1) + sq4(x2)) * (1.f / MLA_QK) + EPS) * qscale;
                u32x2* qo = (u32x2*)(QF + (size_t)row * NQ + hh * MLA_QK);
                qo[2 * l16] = pack4(a0 * rstd * ((const f32x4*)g_q)[2 * l16]); qo[2 * l16 + 1] = pack4(a1 * rstd * ((const f32x4*)g_q)[2 * l16 + 1]);
                if (l16 < 8) { x1 = x1 * rstd * ((const f32x4*)g_q)[32 + l16]; x2 = x2 * rstd * ((const f32x4*)g_q)[40 + l16];
                    const f32x4 co = (f32x4){cs0.x, cs0.z, cs1.x, cs1.z}, si = (f32x4){cs0.y, cs0.w, cs1.y, cs1.w};
                    qo[32 + l16] = pack4(x1 * co - x2 * si); qo[40 + l16] = pack4(x2 * co + x1 * si); } }
            { f32x4 r1 = (f32x4){0.f, 0.f, 0.f, 0.f}, r2 = r1;
              if (l16 < 8) { r1 = ((const f32x4*)(KRB + (size_t)row * KRD))[l16]; r2 = ((const f32x4*)(KRB + (size_t)row * KRD))[8 + l16]; }
              const float ssr = g16_sum(sq4(r1) + sq4(r2));
              const f32x4 co = (f32x4){cs0.x, cs0.z, cs1.x, cs1.z}, si = (f32x4){cs0.y, cs0.w, cs1.y, cs1.w};
              f32x4 y1 = r1, y2 = r2;
              if (l16 < 8) { r1 = r1 * ((const f32x4*)g_k)[32 + l16]; r2 = r2 * ((const f32x4*)g_k)[40 + l16]; y1 = r1 * co - r2 * si; y2 = r2 * co + r1 * si; }
#pragma unroll
              for (int it = 0; it < 4; ++it) { const int hh = 4 * it + hg; const f32x4* kr = (const f32x4*)(KNRAW + (size_t)row * NKN + hh * MLA_NOPE);
                  const f32x4 a0 = kr[2 * l16], a1 = kr[2 * l16 + 1];
                  const float rstd = rsq((g16_sum(sq4(a0) + sq4(a1)) + ssr) * (1.f / MLA_QK) + EPS);
                  u32x2* ko = (u32x2*)(KF + (size_t)row * NQ + hh * MLA_QK);
                  ko[2 * l16] = pack4(a0 * rstd * ((const f32x4*)g_k)[2 * l16]); ko[2 * l16 + 1] = pack4(a1 * rstd * ((const f32x4*)g_k)[2 * l16 + 1]);
                  if (l16 < 8) { ko[32 + l16] = pack4(y1 * rstd); ko[40 + l16] = pack4(y2 * rstd); } } }
        }
        for (int row = gw; row < MROWS; row += NGW) {
            const f32x4* kr = (const f32x4*)(KVM + (size_t)row * 1024 + hg * 256);
            const f32x4 a0 = kr[2 * l16], a1 = kr[2 * l16 + 1], v0 = kr[32 + 2 * l16], v1 = kr[32 + 2 * l16 + 1];
            const float rstd = rsq(g16_sum(sq4(a0) + sq4(a1)) * (1.f / MEM_D) + EPS);
            u32x2* ko = (u32x2*)(KM + (size_t)row * 512 + hg * MEM_D); u32x2* vo = (u32x2*)(VM + (size_t)row * 512 + hg * MEM_D);
            ko[2 * l16] = pack4(a0 * rstd * ((const f32x4*)g_mk)[2 * l16]); ko[2 * l16 + 1] = pack4(a1 * rstd * ((const f32x4*)g_mk)[2 * l16 + 1]);
            vo[2 * l16] = pack4(v0); vo[2 * l16 + 1] = pack4(v1);
        }
    }
    SEAM(7);
    REP(8) if (IN(8)) {
        for (int u = bx; u < 256; u += G) { const int b = u >> 7, hh = (u >> 3) & 15, pi = u & 7;
            for (int sub = 0; sub < 2; ++sub) { const int qb = sub ? 15 - pi : pi; const int q0 = qb * 256 + 32 * wave; const size_t row0 = (size_t)b * SEQ + q0;
                attn_unit<MLA_QK, MLA_V, 1, false>(lds, tid, lane, QF + row0 * NQ + hh * MLA_QK, NQ, KF + (size_t)b * SEQ * NQ + hh * MLA_QK, NQ,
                    VF + (size_t)b * SEQ * NV + hh * MLA_V, NV, OB + row0 * D + hh * MLA_V, D, q0, 0, 4 * (qb + 1), NEGBIG, 0.f, nullptr); } }
        LAS float* biasL = (LAS float*)(lds + 98304);
        const float* sinks = args.in[17];
        for (int u = bx; u < 1024; u += G) { const int b = u >> 9, kvh = (u >> 7) & 3, qblk = u & 127; const int q0 = 32 * qblk, head = kvh * 8 + wave; const size_t row0 = (size_t)b * SEQ + q0;
            __syncthreads();
            for (int i = tid; i < 1024; i += 512) biasL[i] = BIAS[kvh * 1024 + i];
            const int jt0 = (q0 < 127) ? 0 : ((q0 - 127) >> 6), jt1 = ((q0 + 31) >> 6) + 1;
            attn_unit<SWA_D, SWA_D, 2, false>(lds, tid, lane, QS + row0 * SWAW + head * SWA_D, SWAW, KS + (size_t)b * SEQ * SWAKW + kvh * SWA_D, SWAKW,
                VS + (size_t)b * SEQ * SWAKW + kvh * SWA_D, SWAKW, OB + row0 * D + NV + head * SWA_D, D, q0, jt0, jt1, sinks[head] * LOG2E, 1.f, biasL + wave * 128); }
    }
    SEAM(8);
    REP(9) if (IN(9)) {
        const float* g_a = args.in[18]; const float* g_b = args.in[19];
        for (int row = gw; row < M; row += NGW) { const f32x4* orow = (const f32x4*)(OB + (size_t)row * D) + lane;
            f32x4 v[16]; float sa = 0.f, sb = 0.f;
#pragma unroll
            for (int j = 0; j < 8; ++j) { v[j] = orow[64 * j]; sa += sq4(v[j]); v[8 + j] = orow[64 * (8 + j)]; sb += sq4(v[8 + j]); }
            const float ra = rsq(wave_sum(sa) * (1.f / NV) + EPS), rb = rsq(wave_sum(sb) * (1.f / SWAW) + EPS);
            u32x2* o8 = (u32x2*)(XN + (size_t)row * D) + lane;
#pragma unroll
            for (int j = 0; j < 8; ++j) { o8[64 * j] = pack4(v[j] * ra * ((const f32x4*)g_a)[lane + 64 * j]); o8[64 * (8 + j)] = pack4(v[8 + j] * rb * ((const f32x4*)g_b)[lane + 64 * j]); } }
    }
    SEAM(9);
    if (IN(10)) {
        pg8::Gemm g{XN, (const bf16_t*)(ws + WS_WOUT), D, D, D}; pg8::StaticOrder S; S.init(M, D, G, bx);
        pg8::EpiRes E{out, out, D, 1.0f}; pg8::gemm_phase<pg8::EpiRes, pg8::StaticOrder, true>(lds, g, S, E);
    }
    SEAM(10);
    REP(11) if (IN(11)) { for (int row = gw; row < M; row += NGW) rms_row4096(out + (size_t)row * D, args.in[21], XN + (size_t)row * D, lane); }
    SEAM(11);
    if (IN(12)) {
        pg8::Gemm g{XN, (const bf16_t*)(ws + WS_WMQ), D, D, 1024}; pg8::OffsetOrder S; S.init(M / 256, 2, 4, G, bx, 0);
        pg8::EpiF32 E{QMP, 512, (size_t)M * 512}; pg8::gemm_phase<pg8::EpiF32, pg8::OffsetOrder, true>(lds, g, S, E);
    }
    SEAM(12);
    REP(13) if (IN(13)) {
        const float* g_mq = args.in[25]; const int l16 = lane & 15, hg = lane >> 4; const float sc = 0.08838834764831845f * LOG2E;
        for (int row = gw; row < M; row += NGW) {
            f32x4 a0 = (f32x4){0.f, 0.f, 0.f, 0.f}, a1 = a0;
#pragma unroll
            for (int ks = 0; ks < 4; ++ks) { const f32x4* p = (const f32x4*)(QMP + ((size_t)ks * M + row) * 512 + hg * MEM_D); a0 += p[2 * l16]; a1 += p[2 * l16 + 1]; }
            const float rstd = rsq(g16_sum(sq4(a0) + sq4(a1)) * (1.f / MEM_D) + EPS) * sc;
            u32x2* qo = (u32x2*)(QM + (size_t)row * 512 + hg * MEM_D);
            qo[2 * l16] = pack4(a0 * rstd * ((const f32x4*)g_mq)[2 * l16]); qo[2 * l16 + 1] = pack4(a1 * rstd * ((const f32x4*)g_mq)[2 * l16 + 1]);
        }
    }
    SEAM(13);
    REP(14) if (IN(14)) {
        for (int u = bx; u < 128; u += G) { const int b = u >> 6, hh = (u >> 4) & 3, qb = u & 15; const int q0 = qb * 256 + 32 * wave; const size_t row0 = (size_t)b * SEQ + q0;
            attn_unit<MEM_D, MEM_D, 0, true>(lds, tid, lane, QM + row0 * 512 + hh * MEM_D, 512, KM + (size_t)b * MEML * 512 + hh * MEM_D, 512,
                VM + (size_t)b * MEML * 512 + hh * MEM_D, 512, OM + row0 * 512 + hh * MEM_D, 512, q0, 0, 4, NEGBIG, 0.f, nullptr); }
    }
    SEAM(14);
    if (IN(15)) {
        pg8::Gemm g{OM, (const bf16_t*)(ws + WS_WMO), 512, 512, 512}; pg8::StaticOrder S; S.init(M, D, G, bx);
        pg8::EpiRes E{out, out, D, 1.0f}; pg8::gemm_phase<pg8::EpiRes, pg8::StaticOrder, true>(lds, g, S, E);
    }
    SEAM(15);
    REP(16) if (IN(16)) { for (int row = gw; row < M; row += NGW) rms_row4096(out + (size_t)row * D, args.in[28], XN + (size_t)row * D, lane); }
    SEAM(16);
    if (IN(17)) {
        pg8::Gemm g{XN, (const bf16_t*)(ws + WS_WGU_B), D, D, D}; pg8::StaticOrder S; S.init(M, 2 * FF, G, bx);
        pg8::EpiSwiGLU E{ACT, FF}; pg8::gemm_phase<pg8::EpiSwiGLU, pg8::StaticOrder, true>(lds, g, S, E);
    }
    SEAM(17);
    if (IN(18)) {
        pg8::Gemm g{ACT, (const bf16_t*)(ws + WS_WD_B), FF, FF, FF}; pg8::StaticOrder S; S.init(M, D, G, bx);
        pg8::EpiRes E{out, out, D, 0.5f}; pg8::gemm_phase<pg8::EpiRes, pg8::StaticOrder, true>(lds, g, S, E);
    }
#undef IN
#undef SEAM
}

extern "C" void kernel_launch(void* const* d_in, const int* in_sizes, int n_in, void* d_out, int out_size, void* d_ws, size_t ws_size, hipStream_t stream) {
    static int grid = 0;
    if (grid == 0) {
        if (n_in != 32 || out_size != M * D || ws_size < WS_END) { fprintf(stderr, "kernel_launch: unexpected problem (n_in %d, out %d, ws %zu); nothing launched\n", n_in, out_size, ws_size); grid = -1; return; }
        int dev = 0, cus = 0, per_cu = 0;
        if (hipGetDevice(&dev) != hipSuccess || hipDeviceGetAttribute(&cus, hipDeviceAttributeMultiprocessorCount, dev) != hipSuccess) { grid = -1; return; }
        if (hipFuncSetAttribute((const void*)fwd_kernel, hipFuncAttributeMaxDynamicSharedMemorySize, LDS_BYTES) != hipSuccess) { fprintf(stderr, "kernel_launch: hipFuncSetAttribute failed\n"); grid = -1; return; }
        if (hipOccupancyMaxActiveBlocksPerMultiprocessor(&per_cu, (const void*)fwd_kernel, NWAVES * 64, LDS_BYTES) != hipSuccess || per_cu < 1)
            fprintf(stderr, "kernel_launch: note: occupancy query reports %d workgroups per CU\n", per_cu);
        (void)hipGetLastError();
        grid = cus;
    }
    if (grid < 0) return;
    if (hipMemsetAsync((char*)d_ws + WS_CTL, 0, CTL_ZERO_BYTES, stream) != hipSuccess) return;
    Args a{};
    for (int i = 0; i < 32; ++i) a.in[i] = (const float*)d_in[i];
    a.out = (float*)d_out; a.ws = (unsigned char*)d_ws;
    if (MK_N_LAUNCHES == 1) {
        a.ph_lo = 0; a.ph_hi = NPHASE;
        hipLaunchKernelGGL(fwd_kernel, dim3(grid), dim3(NWAVES * 64), LDS_BYTES, stream, a);
    } else {
        for (int p = 0; p < NPHASE; ++p) { a.ph_lo = p; a.ph_hi = p + 1; hipLaunchKernelGGL(fwd_kernel, dim3(grid), dim3(NWAVES * 64), LDS_BYTES, stream, a); }
    }
}
```

```cpp
#include <hip/hip_runtime.h>
#include <cstdio>
#include <cstdint>

#ifndef MK_N_LAUNCHES
#define MK_N_LAUNCHES 1
#endif

#define GAS __attribute__((address_space(1)))
#define LAS __attribute__((address_space(3)))
typedef unsigned short bf16_t;
typedef short bf16x8 __attribute__((ext_vector_type(8)));
typedef short s16x4 __attribute__((ext_vector_type(4)));
typedef float f32x4 __attribute__((ext_vector_type(4)));
typedef float f32x16 __attribute__((ext_vector_type(16)));
typedef unsigned u32x4 __attribute__((ext_vector_type(4)));
typedef unsigned u32x2 __attribute__((ext_vector_type(2)));
typedef float f32x2_t __attribute__((ext_vector_type(2)));
typedef __bf16 bf16x2_t __attribute__((ext_vector_type(2)));
typedef GAS unsigned gu32;

#define LDS_WAIT() asm volatile("s_waitcnt lgkmcnt(0)" ::: "memory")
#define VM_WAIT() asm volatile("s_waitcnt vmcnt(0)" ::: "memory")
#define RLX_AGENT __ATOMIC_RELAXED, __HIP_MEMORY_SCOPE_AGENT

__device__ __forceinline__ unsigned cvtpk(float lo, float hi) { f32x2_t v = {lo, hi}; bf16x2_t b = __builtin_convertvector(v, bf16x2_t); return __builtin_bit_cast(unsigned, b); }
__device__ __forceinline__ float fast_exp2(float x) { return __builtin_amdgcn_exp2f(x); }
__device__ __forceinline__ float fast_rcp(float x) { return __builtin_amdgcn_rcpf(x); }
__device__ __forceinline__ float rsq(float x) { return 1.0f / __builtin_sqrtf(x); }

constexpr int SEQ = 4096, NB = 2, M = NB * SEQ, D = 4096, FF = 11008;
constexpr int MEML = 256, MROWS = NB * MEML;
constexpr int CQ = 896, CKV = 512, KRD = 64, INW = 4032;
constexpr int MLA_H = 16, MLA_QK = 192, MLA_NOPE = 128, MLA_V = 128;
constexpr int SWA_H = 32, SWA_KVH = 4, SWA_D = 64;
constexpr int MEM_H = 4, MEM_D = 128;
constexpr int NQ = MLA_H * MLA_QK;
constexpr int NKN = MLA_H * MLA_NOPE;
constexpr int NV = MLA_H * MLA_V;
constexpr int SWAW = SWA_H * SWA_D;
constexpr int SWAKW = SWA_KVH * SWA_D;
constexpr float EPS = 1e-6f;
constexpr float LOG2E = 1.4426950408889634f;
constexpr float NEGBIG = -1e30f;

constexpr size_t MiB = 1u << 20;
constexpr size_t WS_CTL = 0, CTL_ZERO_BYTES = 1 * MiB;
constexpr size_t WS_ROPE = 1 * MiB;
constexpr size_t WS_BIAS = 2 * MiB;
constexpr size_t WS_WGU_A = 4 * MiB;
constexpr size_t WS_WD_A = 176 * MiB;
constexpr size_t WS_WGU_B = 262 * MiB;
constexpr size_t WS_WD_B = 434 * MiB;
constexpr size_t WS_WIN = 520 * MiB;
constexpr size_t WS_WUQ = 552 * MiB;
constexpr size_t WS_WKN = 558 * MiB;
constexpr size_t WS_WV = 560 * MiB;
constexpr size_t WS_WOUT = 562 * MiB;
constexpr size_t WS_WMQ = 594 * MiB;
constexpr size_t WS_WMKV = 598 * MiB;
constexpr size_t WS_WMO = 606 * MiB;
constexpr size_t WS_XN = 610 * MiB;
constexpr size_t WS_ACT = 674 * MiB;
constexpr size_t WS_U = WS_ACT;
constexpr size_t WS_QRAW = WS_ACT;
constexpr size_t WS_KNRAW = WS_ACT + 96 * MiB;
constexpr size_t WS_O = WS_ACT;
constexpr size_t WS_QMP = WS_ACT;
constexpr size_t WS_QF = 846 * MiB;
constexpr size_t WS_KF = 894 * MiB;
constexpr size_t WS_VF = 942 * MiB;
constexpr size_t WS_QS = 974 * MiB;
constexpr size_t WS_KS = 1006 * MiB;
constexpr size_t WS_VS = 1010 * MiB;
constexpr size_t WS_CQN = 1014 * MiB;
constexpr size_t WS_CKVN = 1028 * MiB;
constexpr size_t WS_KRB = 1036 * MiB;
constexpr size_t WS_MEMN = 1038 * MiB;
constexpr size_t WS_KVM = 1042 * MiB;
constexpr size_t WS_KM = 1044 * MiB;
constexpr size_t WS_VM = 1044 * MiB + 512 * 1024;
constexpr size_t WS_QM = 1045 * MiB;
constexpr size_t WS_OM = 1053 * MiB;
constexpr size_t WS_END = 1061 * MiB;
constexpr int CW_TMO = 0;
constexpr int CW_BAR = 4096;

constexpr int RING_BYTES = 131072;
constexpr int MISC_OFF = RING_BYTES + 320;
constexpr int LDS_BYTES = 147456;
constexpr int NWAVES = 8;

namespace pg8 {
constexpr int BM = 256, BK = 64, HALF = 128, HTB = HALF * BK * 2, NXCD = 8, WGM = 8;
__host__ __device__ __forceinline__ int lds_byte(int r, int c) { const int st = (r >> 4) * 2 + (c >> 5), rr = r & 15, cc = c & 31, ob = rr * 64 + cc * 2; return st * 1024 + (ob ^ (((ob >> 9) & 1) << 5)); }
__host__ __device__ __forceinline__ void stage_rc(int b, int& R, int& C) { const int st = b / 1024, sb = b % 1024, swz = sb ^ (((sb >> 9) & 1) << 5); R = (st >> 1) * 16 + swz / 64; C = (st & 1) * 32 + (swz % 64) / 2; }
__host__ __device__ __forceinline__ int perm32(int rho) { const int n = rho >> 4, i = rho & 15; return 8 * (i >> 2) + 4 * n + (i & 3); }

struct Unit { int pm, pn, ks; };
struct Gemm { const bf16_t* A; const bf16_t* Bt; int lda, ldb, K; };

struct StaticOrder {
    int nM, nN, nwg, G, c;
    __device__ void init(int M_, int N_, int G_, int c_) { nM = M_ / BM; nN = N_ / BM; nwg = nM * nN; G = G_; c = c_; }
    __device__ bool next(int i, Unit& u) const {
        const long L = (long)i * G + c; if (L >= nwg) return false;
        int wgid = (int)L; { const int q = nwg / NXCD, r = nwg % NXCD, xcd = wgid % NXCD, off = wgid / NXCD; wgid = (xcd < r ? xcd * (q + 1) : r * (q + 1) + (xcd - r) * q) + off; }
        const int nig = WGM * nN, gid = wgid / nig, fm = gid * WGM, gsz = (nM - fm) < WGM ? (nM - fm) : WGM;
        u.pm = fm + ((wgid % nig) % gsz); u.pn = (wgid % nig) / gsz; u.ks = 0; return true;
    }
};
struct OffsetOrder {
    int n, c0, G, c, nN, nS;
    __device__ void init(int nM_, int nN_, int nS_, int G_, int c_, int c0_) { n = nM_ * nN_ * nS_; nN = nN_; nS = nS_; G = G_; c = c_; c0 = c0_; }
    __device__ bool next(int i, Unit& u) const {
        const int rel = (c - c0 + G) % G; const long L = (long)i * G + rel; if (L >= n) return false;
        const int t = (int)L; u.ks = t % nS; const int q = t / nS; u.pn = q % nN; u.pm = q / nN; return true;
    }
};

struct EpiF32 {
    static constexpr bool PERM = false;
    float* C; int ldc; size_t split_stride;
    __device__ __forceinline__ void operator()(const f32x4 (&acc)[2][2][4][2], const Unit& u, int wr, int wc, int fr, int fq) const {
        const int row0 = u.pm * BM + wr * 64 + fr, col0 = u.pn * BM + wc * 32 + 4 * fq;
        float* Cb = C + (size_t)u.ks * split_stride;
#pragma unroll
        for (int ai = 0; ai < 2; ++ai)
#pragma unroll
            for (int m = 0; m < 4; ++m) { float* rowp = Cb + (size_t)(row0 + ai * HALF + m * 16) * ldc + col0;
#pragma unroll
                for (int bj = 0; bj < 2; ++bj)
#pragma unroll
                    for (int n = 0; n < 2; ++n) *(f32x4*)(rowp + bj * HALF + n * 16) = acc[ai][bj][m][n]; }
    }
};
struct EpiRes {
    static constexpr bool PERM = false;
    const float* base; float* out; int ldc; float alpha;
    __device__ __forceinline__ void operator()(const f32x4 (&acc)[2][2][4][2], const Unit& u, int wr, int wc, int fr, int fq) const {
        const int row0 = u.pm * BM + wr * 64 + fr, col0 = u.pn * BM + wc * 32 + 4 * fq;
#pragma unroll
        for (int ai = 0; ai < 2; ++ai)
#pragma unroll
            for (int m = 0; m < 4; ++m) { const size_t off = (size_t)(row0 + ai * HALF + m * 16) * ldc + col0;
                f32x4 b[2][2];
#pragma unroll
                for (int bj = 0; bj < 2; ++bj)
#pragma unroll
                    for (int n = 0; n < 2; ++n) b[bj][n] = *(const f32x4*)(base + off + bj * HALF + n * 16);
#pragma unroll
                for (int bj = 0; bj < 2; ++bj)
#pragma unroll
                    for (int n = 0; n < 2; ++n) *(f32x4*)(out + off + bj * HALF + n * 16) = b[bj][n] + acc[ai][bj][m][n] * alpha; }
    }
};
struct EpiBf16 {
    static constexpr bool PERM = true;
    bf16_t* O; int ldc;
    __device__ __forceinline__ void operator()(const f32x4 (&acc)[2][2][4][2], const Unit& u, int wr, int wc, int fr, int fq) const {
        const int row0 = u.pm * BM + wr * 64 + fr, col0 = u.pn * BM + wc * 32 + 8 * fq;
#pragma unroll
        for (int ai = 0; ai < 2; ++ai)
#pragma unroll
            for (int m = 0; m < 4; ++m) { bf16_t* rowp = O + (size_t)(row0 + ai * HALF + m * 16) * ldc + col0;
#pragma unroll
                for (int bj = 0; bj < 2; ++bj) { const f32x4 v0 = acc[ai][bj][m][0], v1 = acc[ai][bj][m][1];
                    u32x4 w; w.x = cvtpk(v0[0], v0[1]); w.y = cvtpk(v0[2], v0[3]); w.z = cvtpk(v1[0], v1[1]); w.w = cvtpk(v1[2], v1[3]);
                    *(u32x4*)(rowp + bj * HALF) = w; } }
    }
};
struct EpiSwiGLU {
    static constexpr bool PERM = true;
    bf16_t* O; int ldc;
    __device__ __forceinline__ float sw(float g, float up) const { return g * fast_rcp(1.0f + fast_exp2(-LOG2E * g)) * up; }
    __device__ __forceinline__ void operator()(const f32x4 (&acc)[2][2][4][2], const Unit& u, int wr, int wc, int fr, int fq) const {
        const int row0 = u.pm * BM + wr * 64 + fr, col0 = u.pn * HALF + wc * 32 + 8 * fq;
#pragma unroll
        for (int ai = 0; ai < 2; ++ai)
#pragma unroll
            for (int m = 0; m < 4; ++m) { bf16_t* rowp = O + (size_t)(row0 + ai * HALF + m * 16) * ldc + col0;
                const f32x4 g0 = acc[ai][0][m][0], g1 = acc[ai][0][m][1], u0 = acc[ai][1][m][0], u1 = acc[ai][1][m][1];
                u32x4 w; w.x = cvtpk(sw(g0[0], u0[0]), sw(g0[1], u0[1])); w.y = cvtpk(sw(g0[2], u0[2]), sw(g0[3], u0[3]));
                w.z = cvtpk(sw(g1[0], u1[0]), sw(g1[1], u1[1])); w.w = cvtpk(sw(g1[2], u1[2]), sw(g1[3], u1[3]));
                *(u32x4*)rowp = w; }
    }
};

template <class Epi, class Sched, bool ALIGN_EPI>
__device__ __forceinline__ void gemm_phase(LAS unsigned char* lds, const Gemm g, const Sched& S, const Epi& E) {
    const int tid = threadIdx.x, wid = __builtin_amdgcn_readfirstlane(tid >> 6), lane = tid & 63, wr = wid >> 2, wc = wid & 3, fr = lane & 15, fq = lane >> 4;
    const int K = g.K, nt = K / BK;
    unsigned voffA[2], voffB[2];
#pragma unroll
    for (int i = 0; i < 2; ++i) { int R, C; stage_rc(tid * 16 + i * 8192, R, C); const int Rb = Epi::PERM ? ((R & ~31) + perm32(R & 31)) : R;
        voffA[i] = (unsigned)(R * g.lda + C) * 2u; voffB[i] = (unsigned)(Rb * g.ldb + C) * 2u; }
    const size_t kstep = (size_t)(BK * 2);
    const size_t hstepA = (size_t)HALF * g.lda * 2, hstepB = (size_t)HALF * g.ldb * 2;
    const size_t tstepA = 2 * hstepA, tstepB = 2 * hstepB;
    const unsigned ldsw = (unsigned)wid * 1024u;
    const int aoff = lds_byte(wr * 64 + fr, fq * 8), boff = lds_byte(wc * 32 + fr, fq * 8);
#define PG8_SA(b, h) (((b) * 2 + (h)) * HTB)
#define PG8_SB(b, h) ((4 + (b) * 2 + (h)) * HTB)
#define PG8_STAGE(bufoff, gbase, voff) do { _Pragma("unroll") for (int _i = 0; _i < 2; ++_i) \
        __builtin_amdgcn_global_load_lds((const unsigned*)((const char*)(gbase) + (voff)[_i]), (LAS unsigned*)(lds + (bufoff) + ldsw + _i * 8192), 16, 0, 0); } while (0)
#define PG8_LDA(dst, b, h) do { _Pragma("unroll") for (int m = 0; m < 4; ++m) _Pragma("unroll") for (int k = 0; k < 2; ++k) dst[m][k] = *(const LAS bf16x8*)(lds + PG8_SA(b, h) + aoff + m * 2048 + k * 1024); } while (0)
#define PG8_LDB(dst, b, h) do { _Pragma("unroll") for (int n = 0; n < 2; ++n) _Pragma("unroll") for (int k = 0; k < 2; ++k) dst[n][k] = *(const LAS bf16x8*)(lds + PG8_SB(b, h) + boff + n * 2048 + k * 1024); } while (0)
#define PG8_MMA(ai, bj, At, Bt) do { __builtin_amdgcn_s_setprio(1); _Pragma("unroll") for (int m = 0; m < 4; ++m) _Pragma("unroll") for (int n = 0; n < 2; ++n) _Pragma("unroll") for (int k = 0; k < 2; ++k) \
        acc[ai][bj][m][n] = __builtin_amdgcn_mfma_f32_16x16x32_bf16(Bt[n][k], At[m][k], acc[ai][bj][m][n], 0, 0, 0); __builtin_amdgcn_s_setprio(0); } while (0)
#define PG8_WAIT_V(n) asm volatile("s_waitcnt vmcnt(" #n ")" ::: "memory")
#define PG8_WAIT_L(n) asm volatile("s_waitcnt lgkmcnt(" #n ")" ::: "memory")
#define PG8_BAR __builtin_amdgcn_s_barrier()
#define PG8_SCHED __builtin_amdgcn_sched_barrier(0)
    Unit cur, nxt; int ui = 0;
    if (!S.next(0, cur)) return;
    f32x4 acc[2][2][4][2];
#pragma unroll
    for (int a = 0; a < 2; ++a)
#pragma unroll
        for (int b = 0; b < 2; ++b)
#pragma unroll
            for (int m = 0; m < 4; ++m)
#pragma unroll
                for (int n = 0; n < 2; ++n) acc[a][b][m][n] = (f32x4){0.f, 0.f, 0.f, 0.f};
    bf16x8 At[4][2], B0[2][2], B1[2][2];
    const char* cA = (const char*)g.A + (size_t)cur.pm * tstepA + (size_t)cur.ks * K * 2; const char* cB = (const char*)g.Bt + (size_t)cur.pn * tstepB + (size_t)cur.ks * K * 2;
    PG8_STAGE(PG8_SB(0, 0), cB, voffB); PG8_STAGE(PG8_SB(0, 1), cB + hstepB, voffB); PG8_STAGE(PG8_SA(0, 0), cA, voffA); PG8_STAGE(PG8_SA(0, 1), cA + hstepA, voffA);
    if (wr == 1) PG8_BAR;
    PG8_WAIT_V(2); PG8_BAR;
    PG8_STAGE(PG8_SB(1, 0), cB + kstep, voffB); PG8_STAGE(PG8_SA(1, 0), cA + kstep, voffA); PG8_STAGE(PG8_SB(1, 1), cB + hstepB + kstep, voffB);
    PG8_WAIT_V(6); PG8_BAR;
    for (;;) {
        const bool has_next = S.next(ui + 1, nxt);
        const char* nA = has_next ? (const char*)g.A + (size_t)nxt.pm * tstepA + (size_t)nxt.ks * K * 2 : cA;
        const char* nB = has_next ? (const char*)g.Bt + (size_t)nxt.pn * tstepB + (size_t)nxt.ks * K * 2 : cB;
        for (int t = 0; t < nt; t += 2) {
            const bool last = (t == nt - 2);
            const char* a1 = cA + (size_t)(t + 1) * kstep;
            const char* a2 = last ? nA : cA + (size_t)(t + 2) * kstep; const char* b2 = last ? nB : cB + (size_t)(t + 2) * kstep;
            const char* a3 = a2 + kstep; const char* b3 = b2 + kstep;
            PG8_LDB(B0, 0, 0); PG8_LDB(B1, 0, 1); PG8_SCHED; PG8_LDA(At, 0, 0); PG8_STAGE(PG8_SA(1, 1), a1 + hstepA, voffA);
            PG8_WAIT_V(8); PG8_WAIT_L(0); PG8_BAR; PG8_MMA(0, 0, At, B0); PG8_MMA(0, 1, At, B1); PG8_BAR; PG8_SCHED;
            PG8_LDA(At, 0, 1); PG8_STAGE(PG8_SB(0, 0), b2, voffB); PG8_STAGE(PG8_SB(0, 1), b2 + hstepB, voffB); PG8_STAGE(PG8_SA(0, 0), a2, voffA);
            PG8_WAIT_V(8); PG8_WAIT_L(0); PG8_BAR; PG8_MMA(1, 0, At, B0); PG8_MMA(1, 1, At, B1); PG8_BAR; PG8_SCHED;
            PG8_LDB(B0, 1, 0); PG8_LDB(B1, 1, 1); PG8_SCHED; PG8_LDA(At, 1, 0); PG8_STAGE(PG8_SA(0, 1), a2 + hstepA, voffA);
            PG8_WAIT_V(8); PG8_WAIT_L(0); PG8_BAR; PG8_MMA(0, 0, At, B0); PG8_MMA(0, 1, At, B1); PG8_BAR; PG8_SCHED;
            PG8_LDA(At, 1, 1); PG8_STAGE(PG8_SB(1, 0), b3, voffB); PG8_STAGE(PG8_SB(1, 1), b3 + hstepB, voffB); PG8_STAGE(PG8_SA(1, 0), a3, voffA);
            PG8_WAIT_V(8); PG8_WAIT_L(0); PG8_BAR; PG8_MMA(1, 0, At, B0); PG8_MMA(1, 1, At, B1); PG8_BAR; PG8_SCHED;
        }
        if constexpr (ALIGN_EPI) { if (wr == 0) PG8_BAR; }
        E(acc, cur, wr, wc, fr, fq);
        if (!has_next) break;
#pragma unroll
        for (int a = 0; a < 2; ++a)
#pragma unroll
            for (int b = 0; b < 2; ++b)
#pragma unroll
                for (int m = 0; m < 4; ++m)
#pragma unroll
                    for (int n = 0; n < 2; ++n) acc[a][b][m][n] = (f32x4){0.f, 0.f, 0.f, 0.f};
        cur = nxt; cA = nA; cB = nB; ++ui;
        if constexpr (ALIGN_EPI) { if (wr == 1) PG8_BAR; }
    }
    PG8_WAIT_V(0);
    if constexpr (!ALIGN_EPI) { if (wr == 0) PG8_BAR; }
    PG8_BAR;
#undef PG8_SA
#undef PG8_SB
#undef PG8_STAGE
#undef PG8_LDA
#undef PG8_LDB
#undef PG8_MMA
#undef PG8_WAIT_V
#undef PG8_WAIT_L
#undef PG8_BAR
#undef PG8_SCHED
}
}

#define XB_TMO      128
#define XB_XCNT(j)  (256  + 64 * (j))
#define XB_XSUB(j)  (1280 + 64 * (j))
#define XB_XGEN(j)  (2304 + 64 * (j))
#define XB_TOP      3328
#define XB_TOPGEN   3392
#define XCD_BAR_WORDS 3456
#define XB_SPIN_CAP (1u << 18)
__device__ __forceinline__ unsigned xb_ld(unsigned* p)              { return __hip_atomic_load(p, __ATOMIC_RELAXED, __HIP_MEMORY_SCOPE_AGENT); }
__device__ __forceinline__ unsigned xb_add(unsigned* p, unsigned v) { return __hip_atomic_fetch_add(p, v, __ATOMIC_RELAXED, __HIP_MEMORY_SCOPE_AGENT); }
__device__ __forceinline__ unsigned xb_xcc_id() { return (unsigned)__builtin_amdgcn_s_getreg((3 << 11) | 20) & 0xFu; }
#define XB_SPIN(cond, bar) do { unsigned _sp = 0; while (cond) { __builtin_amdgcn_s_sleep(1); \
    if ((++_sp & 255u) == 0u) { if (xb_ld(&(bar)[XB_TMO])) break; if (_sp > XB_SPIN_CAP) { atomicAdd(&(bar)[XB_TMO], 1u); break; } } } } while (0)
struct XcdBarrier { unsigned* bar; unsigned x; volatile LAS unsigned* st; };
__device__ __forceinline__ XcdBarrier xcd_barrier_post(unsigned* bar, volatile LAS unsigned* st) {
    XcdBarrier b; b.bar = bar; b.x = xb_xcc_id(); b.st = st;
    if (threadIdx.x == 0) (void)xb_add(&bar[XB_XCNT(b.x)], 1u);
    return b;
}
__device__ __forceinline__ void xcd_barrier_complete(unsigned* bar, unsigned x, unsigned& nloc, unsigned& nx) {
    const unsigned G = gridDim.x * gridDim.y * gridDim.z;
    unsigned sum, cnt, mine, sp = 0u;
    for (;;) {
        sum = 0u; cnt = 0u; mine = 0u;
#pragma unroll
        for (unsigned j = 0; j < 16; ++j) { const unsigned c = xb_ld(&bar[XB_XCNT(j)]); sum += c; cnt += (c > 0u) ? 1u : 0u; mine = (j == x) ? c : mine; }
        if (sum == G) break;
        __builtin_amdgcn_s_sleep(1);
        if ((++sp & 255u) == 0u) { if (xb_ld(&bar[XB_TMO])) break; if (sp > XB_SPIN_CAP) { atomicAdd(&bar[XB_TMO], 1u); break; } }
    }
    nloc = mine > 0u ? mine : 1u; nx = cnt > 0u ? cnt : 1u;
}
__device__ __forceinline__ void xcd_barrier(const XcdBarrier& b) {
    asm volatile("s_waitcnt vmcnt(0)" ::: "memory");
    __syncthreads();
    if (threadIdx.x == 0) {
        unsigned* bar = b.bar;
        __builtin_amdgcn_s_waitcnt(0);
        unsigned nloc = b.st[0], nx = b.st[1];
        if (nloc == 0u) { xcd_barrier_complete(bar, b.x, nloc, nx); b.st[0] = nloc; b.st[1] = nx; }
        const unsigned old = xb_add(&bar[XB_XSUB(b.x)], 1u);
        const unsigned gen = old / nloc;
        if (old + 1u == (gen + 1u) * nloc) {
            __builtin_amdgcn_fence(__ATOMIC_RELEASE, "agent");
            asm volatile("s_waitcnt vmcnt(0)" ::: "memory");
            const unsigned og = xb_add(&bar[XB_TOP], 1u);
            const unsigned tg = og / nx;
            if (og + 1u == (tg + 1u) * nx) xb_add(&bar[XB_TOPGEN], 1u);
            else XB_SPIN(xb_ld(&bar[XB_TOPGEN]) == tg, bar);
            __builtin_amdgcn_fence(__ATOMIC_ACQUIRE, "agent");
            xb_add(&bar[XB_XGEN(b.x)], 1u);
            asm volatile("s_waitcnt vmcnt(0)" ::: "memory");
        } else {
            XB_SPIN(xb_ld(&bar[XB_XGEN(b.x)]) == gen, bar);
            __builtin_amdgcn_fence(__ATOMIC_ACQUIRE, "agent");
            asm volatile("s_waitcnt vmcnt(0)" ::: "memory");
        }
    }
    __syncthreads();
}

__device__ __forceinline__ float wave_sum(float v) {
#pragma unroll
    for (int o = 1; o < 64; o <<= 1) v += __shfl_xor(v, o);
    return v;
}
__device__ __forceinline__ float g16_sum(float v) {
#pragma unroll
    for (int o = 1; o < 16; o <<= 1) v += __shfl_xor(v, o);
    return v;
}
__device__ __forceinline__ float sq4(f32x4 v) { return (v.x * v.x + v.y * v.y) + (v.z * v.z + v.w * v.w); }
__device__ __forceinline__ u32x2 pack4(f32x4 v) { u32x2 w; w.x = cvtpk(v.x, v.y); w.y = cvtpk(v.z, v.w); return w; }

struct XItem { const float* src; bf16_t* dst; int srcN, col0, K, row0, k0; };
__device__ __forceinline__ void xi_load(const XItem& x, f32x4 (&v)[8], int lane) {
    const int kg = lane >> 3, c4 = lane & 7;
    if (x.col0 >= 0) {
        const float* p = x.src + (size_t)(x.k0 + 8 * kg) * x.srcN + x.col0 + 4 * c4;
#pragma unroll
        for (int i = 0; i < 8; ++i) v[i] = *(const f32x4*)(p + (size_t)i * x.srcN);
    } else {
#pragma unroll
        for (int i = 0; i < 8; ++i) v[i] = (f32x4){0.f, 0.f, 0.f, 0.f};
    }
}
__device__ __forceinline__ void xi_store(const XItem& x, const f32x4 (&v)[8], int lane) {
    const int kg = lane >> 3, c4 = lane & 7;
    bf16_t* d = x.dst + (size_t)(x.row0 + 4 * c4) * x.K + x.k0 + 8 * kg;
#pragma unroll
    for (int j = 0; j < 4; ++j) { u32x4 o; o.x = cvtpk(v[0][j], v[1][j]); o.y = cvtpk(v[2][j], v[3][j]); o.z = cvtpk(v[4][j], v[5][j]); o.w = cvtpk(v[6][j], v[7][j]);
        *(GAS u32x4*)(d + (size_t)j * x.K) = o; }
}
__device__ __forceinline__ void rms_row4096(const float* xrow, const float* gain, bf16_t* orow, int lane) {
    const f32x4* xr = (const f32x4*)xrow + lane; const f32x4* gr = (const f32x4*)gain + lane;
    f32x4 v[16]; float s = 0.f;
#pragma unroll
    for (int j = 0; j < 16; ++j) { v[j] = xr[64 * j]; s += sq4(v[j]); }
    const float rstd = rsq(wave_sum(s) * (1.f / 4096.f) + EPS);
    u32x2* o8 = (u32x2*)orow + lane;
#pragma unroll
    for (int j = 0; j < 16; ++j) { const f32x4 gg = gr[64 * j]; o8[64 * j] = pack4(v[j] * rstd * gg); }
}

template <int DQK, int DV> struct ACfg {
    static constexpr int PK = DQK * 2 + 16, PV = DV * 2 + 64;
    static constexpr int KT = 64 * PK, VT = 64 * PV, STAGE = KT + VT;
    static constexpr int KCH = DQK / 8, VCH = DV / 8, NKL = 64 * KCH / 512, NVL = 64 * VCH / 512;
};
#define MFMA32(a, b, c) __builtin_amdgcn_mfma_f32_32x32x16_bf16((a), (b), (c), 0, 0, 0)
__device__ __forceinline__ s16x4 vtr(const LAS unsigned char* p) { return __builtin_bit_cast(s16x4, __builtin_amdgcn_ds_read_tr16_b64_v4i16((LAS s16x4*)p)); }

template <int DQK, int DV, int MODE, bool OBF16>
__device__ __forceinline__ void attn_unit(LAS unsigned char* lds, int tid, int lane,
                                          const bf16_t* Qw, int qpitch, const bf16_t* Kb, int kpitch, const bf16_t* Vb, int vpitch,
                                          void* Ow, int opitch, int q0, int jt0, int jt1, float m_init, float l_init, const LAS float* biasw) {
    using C = ACfg<DQK, DV>;
    const int r = lane & 31, h = lane >> 5;
    bf16x8 qf[DQK / 16];
#pragma unroll
    for (int ks = 0; ks < DQK / 16; ++ks) qf[ks] = *(const bf16x8*)(Qw + (size_t)r * qpitch + ks * 16 + h * 8);
    f32x16 O[DV / 32];
#pragma unroll
    for (int d = 0; d < DV / 32; ++d)
#pragma unroll
        for (int i = 0; i < 16; ++i) O[d][i] = 0.f;
    float m = m_init, l = (h == 0) ? l_init : 0.f;
    u32x4 kst[C::NKL], vst[C::NVL];
    unsigned kgo[C::NKL], vgo[C::NVL];
#pragma unroll
    for (int i = 0; i < C::NKL; ++i) { const int c = tid + 512 * i, row = c / C::KCH, cc = c % C::KCH; kgo[i] = (unsigned)(row * kpitch + cc * 8) * 2u; }
#pragma unroll
    for (int i = 0; i < C::NVL; ++i) { const int c = tid + 512 * i, row = c / C::VCH, cc = c % C::VCH; vgo[i] = (unsigned)(row * vpitch + cc * 8) * 2u; }
#define ATT_LOAD(jt) do { const char* kt_ = (const char*)Kb + (size_t)(jt) * 64 * kpitch * 2; const char* vt_ = (const char*)Vb + (size_t)(jt) * 64 * vpitch * 2; \
        _Pragma("unroll") for (int i = 0; i < C::NKL; ++i) kst[i] = *(const u32x4*)(kt_ + kgo[i]); \
        _Pragma("unroll") for (int i = 0; i < C::NVL; ++i) vst[i] = *(const u32x4*)(vt_ + vgo[i]); } while (0)
#define ATT_STORE(buf) do { \
        _Pragma("unroll") for (int i = 0; i < C::NKL; ++i) { const int c = tid + 512 * i, row = c / C::KCH, cc = c % C::KCH; *(LAS u32x4*)(lds + (buf) * C::STAGE + row * C::PK + cc * 16) = kst[i]; } \
        _Pragma("unroll") for (int i = 0; i < C::NVL; ++i) { const int c = tid + 512 * i, row = c / C::VCH, cc = c % C::VCH; *(LAS u32x4*)(lds + (buf) * C::STAGE + C::KT + row * C::PV + cc * 16) = vst[i]; } } while (0)
    __syncthreads();
    ATT_LOAD(jt0); ATT_STORE(0);
    for (int jt = jt0; jt < jt1; ++jt) {
        const int buf = (jt - jt0) & 1;
        __syncthreads();
        const bool more = (jt + 1 < jt1);
        if (more) ATT_LOAD(jt + 1);
        const bool active = (MODE == 1) ? (jt * 64 <= q0 + 31) : true;
        if (active) {
            const LAS unsigned char* kb_ = lds + buf * C::STAGE; const LAS unsigned char* vb_ = kb_ + C::KT;
            const int qpos = q0 + r;
#pragma unroll 1
            for (int kb = 0; kb < 2; ++kb) {
                if (MODE == 1 && jt * 64 + 32 * kb > q0 + 31) break;
                f32x16 S;
#pragma unroll
                for (int i = 0; i < 16; ++i) S[i] = 0.f;
                const LAS unsigned char* kp = kb_ + (32 * kb + r) * C::PK + h * 16;
#pragma unroll
                for (int ks = 0; ks < DQK / 16; ++ks) { const bf16x8 a0 = *(const LAS bf16x8*)(kp + ks * 32); S = MFMA32(a0, qf[ks], S); }
                const int kbase = jt * 64 + 32 * kb + 4 * h;
                if (MODE == 1) {
                    if (kbase - 4 * h + 31 > q0) {
#pragma unroll
                        for (int i = 0; i < 16; ++i) { const int key = kbase + (i & 3) + 8 * (i >> 2); if (key > qpos) S[i] = NEGBIG; }
                    }
                }
                if (MODE == 2) {
#pragma unroll
                    for (int i = 0; i < 16; ++i) { const int d0 = qpos - (kbase + (i & 3) + 8 * (i >> 2));
                        const float b0 = biasw[d0 & 127];
                        S[i] = ((unsigned)d0 < 128u) ? S[i] + b0 : NEGBIG; }
                }
                float mx = S[0];
#pragma unroll
                for (int i = 1; i < 16; ++i) mx = fmaxf(mx, S[i]);
                mx = fmaxf(mx, __shfl_xor(mx, 32));
                const float mn = fmaxf(m, mx); const float alpha = fast_exp2(m - mn); m = mn;
                float ps = 0.f;
#pragma unroll
                for (int i = 0; i < 16; ++i) { S[i] = fast_exp2(S[i] - mn); ps += S[i]; }
                l = l * alpha + ps;
#pragma unroll
                for (int d = 0; d < DV / 32; ++d)
#pragma unroll
                    for (int i = 0; i < 16; ++i) O[d][i] *= alpha;
                bf16x8 pf[2];
#pragma unroll
                for (int t = 0; t < 2; ++t) { u32x4 w; const int o = 8 * t;
                    w.x = cvtpk(S[o], S[o + 1]); w.y = cvtpk(S[o + 2], S[o + 3]); w.z = cvtpk(S[o + 4], S[o + 5]); w.w = cvtpk(S[o + 6], S[o + 7]);
                    pf[t] = __builtin_bit_cast(bf16x8, w); }
                const LAS unsigned char* vp = vb_ + (32 * kb + 4 * h + ((lane & 15) >> 2)) * C::PV + ((lane >> 4) & 1) * 32 + (lane & 3) * 8;
#pragma unroll
                for (int d = 0; d < DV / 32; ++d)
#pragma unroll
                    for (int t = 0; t < 2; ++t) { const s16x4 lo = vtr(vp + t * 16 * C::PV + d * 64), hi = vtr(vp + t * 16 * C::PV + 8 * C::PV + d * 64);
                        const bf16x8 vf = {lo.x, lo.y, lo.z, lo.w, hi.x, hi.y, hi.z, hi.w};
                        O[d] = MFMA32(vf, pf[t], O[d]); }
            }
        }
        if (more) ATT_STORE(buf ^ 1);
    }
#undef ATT_LOAD
#undef ATT_STORE
    l += __shfl_xor(l, 32);
    const float inv = 1.0f / l;
#pragma unroll
    for (int d = 0; d < DV / 32; ++d)
#pragma unroll
        for (int tq = 0; tq < 4; ++tq) { const int dv = 32 * d + 8 * tq + 4 * h;
            const f32x4 o = (f32x4){O[d][4 * tq], O[d][4 * tq + 1], O[d][4 * tq + 2], O[d][4 * tq + 3]} * inv;
            if (OBF16) *(u32x2*)((bf16_t*)Ow + (size_t)r * opitch + dv) = pack4(o);
            else *(f32x4*)((float*)Ow + (size_t)r * opitch + dv) = o; }
}

constexpr int NPHASE = 19;
struct Args { const float* in[32]; float* out; unsigned char* ws; int ph_lo, ph_hi; };
static_assert(sizeof(Args) == 32 * 8 + 8 + 8 + 8, "Args has no padding");

__global__ void __launch_bounds__(NWAVES * 64, 2) fwd_kernel(Args args) {
    extern __shared__ __attribute__((aligned(16))) unsigned char lds_raw[];
    LAS unsigned char* lds = (LAS unsigned char*)lds_raw;
    volatile LAS unsigned* MISC = (volatile LAS unsigned*)(lds + MISC_OFF);
    const int tid = threadIdx.x, lane = tid & 63, wave = __builtin_amdgcn_readfirstlane(tid >> 6);
    const int G = gridDim.x; const int bx = blockIdx.x; const int vcu = (G % 8 == 0) ? (bx % 8) * (G / 8) + bx / 8 : bx;
    const int gw = vcu * NWAVES + wave, NGW = G * NWAVES;
    unsigned char* ws = args.ws;
    gu32* ctl = (gu32*)(ws + WS_CTL);
    for (int u = tid; u < (LDS_BYTES - RING_BYTES) / 4; u += NWAVES * 64) ((LAS unsigned*)(lds + RING_BYTES))[u] = 0u;
    __syncthreads();
    XcdBarrier bar; bar.bar = (unsigned*)(ctl + CW_BAR); bar.x = 0; bar.st = nullptr;
    if (MK_N_LAUNCHES == 1) bar = xcd_barrier_post((unsigned*)(ctl + CW_BAR), MISC + 8);
    const int lo = args.ph_lo, hi = args.ph_hi;
#ifndef ONLYP
#define ONLYP -1
#endif
#define IN(k) ((ONLYP < 0 || ONLYP == (k)) && lo <= (k) && (k) < hi)
#define SEAM(k) do { if (IN(k) && IN((k) + 1)) xcd_barrier(bar); } while (0)
#ifndef DUPP
#define DUPP -1
#endif
#define REP(k) for (int rep_ = 0; rep_ < ((DUPP == (k)) ? 2 : 1); ++rep_)

    const float* x = args.in[0]; const float* mem = args.in[1]; const float* rel_bias = args.in[2];
    float* out = args.out;
    bf16_t* XN = (bf16_t*)(ws + WS_XN); bf16_t* ACT = (bf16_t*)(ws + WS_ACT);
    float* U = (float*)(ws + WS_U); float* QRAW = (float*)(ws + WS_QRAW); float* KNRAW = (float*)(ws + WS_KNRAW); float* OB = (float*)(ws + WS_O); float* QMP = (float*)(ws + WS_QMP);
    bf16_t* QF = (bf16_t*)(ws + WS_QF); bf16_t* KF = (bf16_t*)(ws + WS_KF); bf16_t* VF = (bf16_t*)(ws + WS_VF);
    bf16_t* QS = (bf16_t*)(ws + WS_QS); bf16_t* KS = (bf16_t*)(ws + WS_KS); bf16_t* VS = (bf16_t*)(ws + WS_VS);
    bf16_t* CQN = (bf16_t*)(ws + WS_CQN); bf16_t* CKVN = (bf16_t*)(ws + WS_CKVN); float* KRB = (float*)(ws + WS_KRB);
    bf16_t* MEMN = (bf16_t*)(ws + WS_MEMN); float* KVM = (float*)(ws + WS_KVM); bf16_t* KM = (bf16_t*)(ws + WS_KM); bf16_t* VM = (bf16_t*)(ws + WS_VM);
    bf16_t* QM = (bf16_t*)(ws + WS_QM); bf16_t* OM = (bf16_t*)(ws + WS_OM);
    float* ROPE = (float*)(ws + WS_ROPE); float* BIAS = (float*)(ws + WS_BIAS);

    REP(0) if (IN(0)) {
        const float* wgate_a = args.in[4]; const float* wup_a = args.in[5]; const float* wdown_a = args.in[6];
        const float* wgate_b = args.in[29]; const float* wup_b = args.in[30]; const float* wdown_b = args.in[31];
        constexpr int SC_GU = 86 * 8, SC_D = 16 * 43, SC_IN = 16 * 8, SC_UQ = 12 * 7, SC_KN = 8, SC_OUT = 16 * 8, SC_MQ = 2 * 8, SC_MKV = 4 * 8, SC_MO = 16;
        constexpr int NSC = 2 * SC_GU + 2 * SC_D + SC_IN + SC_UQ + 2 * SC_KN + SC_OUT + SC_MQ + SC_MKV + SC_MO;
#define SC_DECODE(X, KGS, KB0, SCI) do { int r = (SCI); \
            if (r < 2 * SC_GU) { const int which = r >= SC_GU; if (which) r -= SC_GU; const int nbg = r >> 3, kbg = r & 7; const int nb = nbg * 8 + wave; KGS = 8; KB0 = kbg * 8; \
                X.src = which ? ((wave >> 2) ? wup_b : wgate_b) : ((wave >> 2) ? wup_a : wgate_a); X.srcN = FF; X.col0 = 128 * nbg + 32 * (wave & 3); X.K = D; X.dst = (bf16_t*)(ws + (which ? WS_WGU_B : WS_WGU_A)); X.row0 = 32 * nb; break; } \
            r -= 2 * SC_GU; \
            if (r < 2 * SC_D) { const int which = r >= SC_D; if (which) r -= SC_D; const int nbg = r / 43, kbg = r % 43; const int nb = nbg * 8 + wave; KGS = 4; KB0 = kbg * 4; \
                X.src = which ? wdown_b : wdown_a; X.srcN = D; X.col0 = 32 * nb; X.K = FF; X.dst = (bf16_t*)(ws + (which ? WS_WD_B : WS_WD_A)); X.row0 = 32 * nb; break; } \
            r -= 2 * SC_D; \
            if (r < SC_IN) { const int nbg = r >> 3, kbg = r & 7; const int nb = nbg * 8 + wave; KGS = 8; KB0 = kbg * 8; \
                X.src = args.in[8]; X.srcN = INW; X.col0 = (32 * nb < INW) ? 32 * nb : -1; X.K = D; X.dst = (bf16_t*)(ws + WS_WIN); X.row0 = 32 * nb; break; } \
            r -= SC_IN; \
            if (r < SC_UQ) { const int nbg = r / 7, kbg = r % 7; const int nb = nbg * 8 + wave; KGS = 2; KB0 = kbg * 2; \
                X.src = args.in[11]; X.srcN = NQ; X.col0 = 32 * nb; X.K = CQ; X.dst = (bf16_t*)(ws + WS_WUQ); X.row0 = 32 * nb; break; } \
            r -= SC_UQ; \
            if (r < 2 * SC_KN) { const int which = r >= SC_KN; if (which) r -= SC_KN; const int nb = r * 8 + wave; KGS = 8; KB0 = 0; \
                X.src = args.in[12]; X.srcN = 4096; X.col0 = (nb >> 2) * 256 + which * 128 + 32 * (nb & 3); X.K = CKV; X.dst = (bf16_t*)(ws + (which ? WS_WV : WS_WKN)); X.row0 = 32 * nb; break; } \
            r -= 2 * SC_KN; \
            if (r < SC_OUT) { const int nbg = r >> 3, kbg = r & 7; const int nb = nbg * 8 + wave; KGS = 8; KB0 = kbg * 8; \
                X.src = args.in[20]; X.srcN = D; X.col0 = 32 * nb; X.K = D; X.dst = (bf16_t*)(ws + WS_WOUT); X.row0 = 32 * nb; break; } \
            r -= SC_OUT; \
            if (r < SC_MQ) { const int nbg = r >> 3, kbg = r & 7; const int nb = nbg * 8 + wave; KGS = 8; KB0 = kbg * 8; \
                X.src = args.in[23]; X.srcN = 512; X.col0 = 32 * nb; X.K = D; X.dst = (bf16_t*)(ws + WS_WMQ); X.row0 = 32 * nb; break; } \
            r -= SC_MQ; \
            if (r < SC_MKV) { const int nbg = r >> 3, kbg = r & 7; const int nb = nbg * 8 + wave; KGS = 8; KB0 = kbg * 8; \
                X.src = args.in[24]; X.srcN = 1024; X.col0 = 32 * nb; X.K = D; X.dst = (bf16_t*)(ws + WS_WMKV); X.row0 = 32 * nb; break; } \
            r -= SC_MKV; \
            { const int nb = r * 8 + wave; KGS = 8; KB0 = 0; \
                X.src = args.in[27]; X.srcN = D; X.col0 = 32 * nb; X.K = 512; X.dst = (bf16_t*)(ws + WS_WMO); X.row0 = 32 * nb; } } while (0)
        { int sc = bx, j = 0, kgs = 1, kb0 = 0, nkgs = 1, nkb0 = 0; XItem cur, nx; f32x4 v[8], vn[8];
          cur.src = nullptr; cur.dst = nullptr; cur.srcN = 0; cur.col0 = -1; cur.K = 0; cur.row0 = 0; cur.k0 = 0; nx = cur;
          if (sc < NSC) { SC_DECODE(cur, kgs, kb0, sc); cur.k0 = 64 * kb0; xi_load(cur, v, lane); }
          while (sc < NSC) {
              int nsc = sc, nj = j + 1; nx = cur; nkgs = kgs; nkb0 = kb0;
              if (nj == kgs) { nsc = sc + G; nj = 0; if (nsc < NSC) SC_DECODE(nx, nkgs, nkb0, nsc); }
              if (nsc < NSC) { nx.k0 = 64 * (nkb0 + nj); xi_load(nx, vn, lane); }
              xi_store(cur, v, lane);
#pragma unroll
              for (int i = 0; i < 8; ++i) v[i] = vn[i];
              cur = nx; sc = nsc; j = nj; kgs = nkgs; kb0 = nkb0;
          } }
#undef SC_DECODE
        for (int row = gw; row < M; row += NGW) rms_row4096(x + (size_t)row * D, args.in[3], XN + (size_t)row * D, lane);
        for (int row = gw; row < MROWS; row += NGW) rms_row4096(mem + (size_t)row * D, args.in[22], MEMN + (size_t)row * D, lane);
        for (int i = gw * 64 + lane; i < SEQ * 32; i += NGW * 64) { const int pos = i >> 5, j = i & 31;
            const float inv = exp2f(-(float)j * (13.287712379549449f / 32.f)); const float ang = (float)pos * inv;
            ROPE[2 * i] = cosf(ang); ROPE[2 * i + 1] = sinf(ang); }
        for (int i = gw * 64 + lane; i < SWA_H * 128; i += NGW * 64) { const int hh = i >> 7, d = i & 127;
            int bk = d; if (d >= 16) { bk = 16 + (int)(logf((float)d / 16.f) / 2.0794415416798357f * 16.f); if (bk > 31) bk = 31; }
            BIAS[i] = rel_bias[bk * SWA_H + hh] * LOG2E; }
    }
    SEAM(0);

    if (IN(1)) {
        { pg8::Gemm g{XN, (const bf16_t*)(ws + WS_WGU_A), D, D, D}; pg8::StaticOrder S; S.init(M, 2 * FF, G, bx);
          pg8::EpiSwiGLU E{ACT, FF}; pg8::gemm_phase<pg8::EpiSwiGLU, pg8::StaticOrder, true>(lds, g, S, E);
          if (DUPP == 1) pg8::gemm_phase<pg8::EpiSwiGLU, pg8::StaticOrder, true>(lds, g, S, E); }
        { pg8::Gemm g{MEMN, (const bf16_t*)(ws + WS_WMKV), D, D, D}; pg8::OffsetOrder S; S.init(MROWS / 256, 1024 / 256, 1, G, bx, 192 % G);
          pg8::EpiF32 E{KVM, 1024, 0}; pg8::gemm_phase<pg8::EpiF32, pg8::OffsetOrder, true>(lds, g, S, E); }
    }
    SEAM(1);
    if (IN(2)) {
        pg8::Gemm g{ACT, (const bf16_t*)(ws + WS_WD_A), FF, FF, FF}; pg8::StaticOrder S; S.init(M, D, G, bx);
        pg8::EpiRes E{x, out, D, 0.5f}; pg8::gemm_phase<pg8::EpiRes, pg8::StaticOrder, true>(lds, g, S, E);
        if (DUPP == 2) pg8::gemm_phase<pg8::EpiRes, pg8::StaticOrder, true>(lds, g, S, E);
    }
    SEAM(2);
    REP(3) if (IN(3)) { for (int row = gw; row < M; row += NGW) rms_row4096(out + (size_t)row * D, args.in[7], XN + (size_t)row * D, lane); }
    SEAM(3);
    if (IN(4)) {
        pg8::Gemm g{XN, (const bf16_t*)(ws + WS_WIN), D, D, D}; pg8::StaticOrder S; S.init(M, D, G, bx);
        pg8::EpiF32 E{U, D, 0}; pg8::gemm_phase<pg8::EpiF32, pg8::StaticOrder, true>(lds, g, S, E);
        if (DUPP == 4) pg8::gemm_phase<pg8::EpiF32, pg8::StaticOrder, true>(lds, g, S, E);
    }
    SEAM(4);
    REP(5) if (IN(5)) {
        const float* g_qa = args.in[9]; const float* g_kva = args.in[10]; const float* g_sq = args.in[15]; const float* g_sk = args.in[16];
        for (int row = gw; row < M; row += NGW) {
            const f32x4* ur = (const f32x4*)(U + (size_t)row * D);
            { f32x4 v[4]; float s = 0.f;
#pragma unroll
              for (int j = 0; j < 4; ++j) { const int c = lane + 64 * j; v[j] = (c < 224) ? ur[c] : (f32x4){0.f, 0.f, 0.f, 0.f}; s += sq4(v[j]); }
              const float rstd = rsq(wave_sum(s) * (1.f / CQ) + EPS);
#pragma unroll
              for (int j = 0; j < 4; ++j) { const int c = lane + 64 * j; if (c < 224) *((u32x2*)(CQN + (size_t)row * CQ) + c) = pack4(v[j] * rstd * ((const f32x4*)g_qa)[c]); } }
            { f32x4 v[2]; float s = 0.f;
#pragma unroll
              for (int j = 0; j < 2; ++j) { v[j] = ur[224 + lane + 64 * j]; s += sq4(v[j]); }
              const float rstd = rsq(wave_sum(s) * (1.f / CKV) + EPS);
#pragma unroll
              for (int j = 0; j < 2; ++j) { const int c = lane + 64 * j; *((u32x2*)(CKVN + (size_t)row * CKV) + c) = pack4(v[j] * rstd * ((const f32x4*)g_kva)[c]); } }
            if (lane < 16) *((f32x4*)(KRB + (size_t)row * KRD) + lane) = ur[352 + lane];
            { const f32x4 gq = ((const f32x4*)g_sq)[lane & 15];
#pragma unroll
              for (int j = 0; j < 8; ++j) { const int c = lane + 64 * j; const f32x4 v = ur[368 + c];
                  const float rstd = rsq(g16_sum(sq4(v)) * (1.f / SWA_D) + EPS) * (0.125f * LOG2E);
                  *((u32x2*)(QS + (size_t)row * SWAW) + c) = pack4(v * rstd * gq); } }
            { const f32x4 v = ur[880 + lane]; const float rstd = rsq(g16_sum(sq4(v)) * (1.f / SWA_D) + EPS);
              *((u32x2*)(KS + (size_t)row * SWAKW) + lane) = pack4(v * rstd * ((const f32x4*)g_sk)[lane & 15]); }
            *((u32x2*)(VS + (size_t)row * SWAKW) + lane) = pack4(ur[944 + lane]);
        }
    }
    SEAM(5);
    if (IN(6)) {
        { pg8::Gemm g{CQN, (const bf16_t*)(ws + WS_WUQ), CQ, CQ, CQ}; pg8::StaticOrder S; S.init(M, NQ, G, bx);
          pg8::EpiF32 E{QRAW, NQ, 0}; pg8::gemm_phase<pg8::EpiF32, pg8::StaticOrder, true>(lds, g, S, E); }
        { pg8::Gemm g{CKVN, (const bf16_t*)(ws + WS_WKN), CKV, CKV, CKV}; pg8::StaticOrder S; S.init(M, NKN, G, (bx + G / 2) % G);
          pg8::EpiF32 E{KNRAW, NKN, 0}; pg8::gemm_phase<pg8::EpiF32, pg8::StaticOrder, true>(lds, g, S, E); }
        { pg8::Gemm g{CKVN, (const bf16_t*)(ws + WS_WV), CKV, CKV, CKV}; pg8::StaticOrder S; S.init(M, NV, G, (bx + G / 2) % G);
          pg8::EpiBf16 E{VF, NV}; pg8::gemm_phase<pg8::EpiBf16, pg8::StaticOrder, true>(lds, g, S, E); }
    }
    SEAM(6);
    REP(7) if (IN(7)) {
        const float* g_q = args.in[13]; const float* g_k = args.in[14]; const float* g_mk = args.in[26];
        const int l16 = lane & 15, hg = lane >> 4;
        const float qscale = 0.07216878364870322f * LOG2E;
        for (int row = gw; row < M; row += NGW) {
            const int pos = row & (SEQ - 1);
            const f32x4* rp = (const f32x4*)(ROPE + (size_t)pos * 64);
            f32x4 cs0 = (f32x4){1.f, 0.f, 1.f, 0.f}, cs1 = cs0;
            if (l16 < 8) { cs0 = rp[2 * l16]; cs1 = rp[2 * l16 + 1]; }
#pragma unroll
            for (int it = 0; it < 4; ++it) { const int hh = 4 * it + hg; const f32x4* qr = (const f32x4*)(QRAW + (size_t)row * NQ + hh * MLA_QK);
                f32x4 a0 = qr[2 * l16], a1 = qr[2 * l16 + 1], x1 = (f32x4){0.f, 0.f, 0.f, 0.f}, x2 = x1;
                if (l16 < 8) { x1 = qr[32 + l16]; x2 = qr[40 + l16]; }
                const float rstd = rsq(g16_sum(sq4(a0) + sq4(a1) + sq4(x1) + sq4(x2)) * (1.f / MLA_QK) + EPS) * qscale;
                u32x2* qo = (u32x2*)(QF + (size_t)row * NQ + hh * MLA_QK);
                qo[2 * l16] = pack4(a0 * rstd * ((const f32x4*)g_q)[2 * l16]); qo[2 * l16 + 1] = pack4(a1 * rstd * ((const f32x4*)g_q)[2 * l16 + 1]);
                if (l16 < 8) { x1 = x1 * rstd * ((const f32x4*)g_q)[32 + l16]; x2 = x2 * rstd * ((const f32x4*)g_q)[40 + l16];
                    const f32x4 co = (f32x4){cs0.x, cs0.z, cs1.x, cs1.z}, si = (f32x4){cs0.y, cs0.w, cs1.y, cs1.w};
                    qo[32 + l16] = pack4(x1 * co - x2 * si); qo[40 + l16] = pack4(x2 * co + x1 * si); } }
            { f32x4 r1 = (f32x4){0.f, 0.f, 0.f, 0.f}, r2 = r1;
              if (l16 < 8) { r1 = ((const f32x4*)(KRB + (size_t)row * KRD))[l16]; r2 = ((const f32x4*)(KRB + (size_t)row * KRD))[8 + l16]; }
              const float ssr = g16_sum(sq4(r1) + sq4(r2));
              const f32x4 co = (f32x4){cs0.x, cs0.z, cs1.x, cs1.z}, si = (f32x4){cs0.y, cs0.w, cs1.y, cs1.w};
              f32x4 y1 = r1, y2 = r2;
              if (l16 < 8) { r1 = r1 * ((const f32x4*)g_k)[32 + l16]; r2 = r2 * ((const f32x4*)g_k)[40 + l16]; y1 = r1 * co - r2 * si; y2 = r2 * co + r1 * si; }
#pragma unroll
              for (int it = 0; it < 4; ++it) { const int hh = 4 * it + hg; const f32x4* kr = (const f32x4*)(KNRAW + (size_t)row * NKN + hh * MLA_NOPE);
                  const f32x4 a0 = kr[2 * l16], a1 = kr[2 * l16 + 1];
                  const float rstd = rsq((g16_sum(sq4(a0) + sq4(a1)) + ssr) * (1.f / MLA_QK) + EPS);
                  u32x2* ko = (u32x2*)(KF + (size_t)row * NQ + hh * MLA_QK);
                  ko[2 * l16] = pack4(a0 * rstd * ((const f32x4*)g_k)[2 * l16]); ko[2 * l16 + 1] = pack4(a1 * rstd * ((const f32x4*)g_k)[2 * l16 + 1]);
                  if (l16 < 8) { ko[32 + l16] = pack4(y1 * rstd); ko[40 + l16] = pack4(y2 * rstd); } } }
        }
        for (int row = gw; row < MROWS; row += NGW) {
            const f32x4* kr = (const f32x4*)(KVM + (size_t)row * 1024 + hg * 256);
            const f32x4 a0 = kr[2 * l16], a1 = kr[2 * l16 + 1], v0 = kr[32 + 2 * l16], v1 = kr[32 + 2 * l16 + 1];
            const float rstd = rsq(g16_sum(sq4(a0) + sq4(a1)) * (1.f / MEM_D) + EPS);
            u32x2* ko = (u32x2*)(KM + (size_t)row * 512 + hg * MEM_D); u32x2* vo = (u32x2*)(VM + (size_t)row * 512 + hg * MEM_D);
            ko[2 * l16] = pack4(a0 * rstd * ((const f32x4*)g_mk)[2 * l16]); ko[2 * l16 + 1] = pack4(a1 * rstd * ((const f32x4*)g_mk)[2 * l16 + 1]);
            vo[2 * l16] = pack4(v0); vo[2 * l16 + 1] = pack4(v1);
        }
    }
    SEAM(7);
    REP(8) if (IN(8)) {
        for (int u = bx; u < 256; u += G) { const int b = u >> 7, hh = (u >> 3) & 15, pi = u & 7;
            for (int sub = 0; sub < 2; ++sub) { const int qb = sub ? 15 - pi : pi; const int q0 = qb * 256 + 32 * wave; const size_t row0 = (size_t)b * SEQ + q0;
                attn_unit<MLA_QK, MLA_V, 1, false>(lds, tid, lane, QF + row0 * NQ + hh * MLA_QK, NQ, KF + (size_t)b * SEQ * NQ + hh * MLA_QK, NQ,
                    VF + (size_t)b * SEQ * NV + hh * MLA_V, NV, OB + row0 * D + hh * MLA_V, D, q0, 0, 4 * (qb + 1), NEGBIG, 0.f, nullptr); } }
        LAS float* biasL = (LAS float*)(lds + 98304);
        const float* sinks = args.in[17];
        for (int u = bx; u < 1024; u += G) { const int b = u >> 9, kvh = (u >> 7) & 3, qblk = u & 127; const int q0 = 32 * qblk, head = kvh * 8 + wave; const size_t row0 = (size_t)b * SEQ + q0;
            __syncthreads();
            for (int i = tid; i < 1024; i += 512) biasL[i] = BIAS[kvh * 1024 + i];
            const int jt0 = (q0 < 127) ? 0 : ((q0 - 127) >> 6), jt1 = ((q0 + 31) >> 6) + 1;
            attn_unit<SWA_D, SWA_D, 2, false>(lds, tid, lane, QS + row0 * SWAW + head * SWA_D, SWAW, KS + (size_t)b * SEQ * SWAKW + kvh * SWA_D, SWAKW,
                VS + (size_t)b * SEQ * SWAKW + kvh * SWA_D, SWAKW, OB + row0 * D + NV + head * SWA_D, D, q0, jt0, jt1, sinks[head] * LOG2E, 1.f, biasL + wave * 128); }
    }
    SEAM(8);
    REP(9) if (IN(9)) {
        const float* g_a = args.in[18]; const float* g_b = args.in[19];
        for (int row = gw; row < M; row += NGW) { const f32x4* orow = (const f32x4*)(OB + (size_t)row * D) + lane;
            f32x4 v[16]; float sa = 0.f, sb = 0.f;
#pragma unroll
            for (int j = 0; j < 8; ++j) { v[j] = orow[64 * j]; sa += sq4(v[j]); v[8 + j] = orow[64 * (8 + j)]; sb += sq4(v[8 + j]); }
            const float ra = rsq(wave_sum(sa) * (1.f / NV) + EPS), rb = rsq(wave_sum(sb) * (1.f / SWAW) + EPS);
            u32x2* o8 = (u32x2*)(XN + (size_t)row * D) + lane;
#pragma unroll
            for (int j = 0; j < 8; ++j) { o8[64 * j] = pack4(v[j] * ra * ((const f32x4*)g_a)[lane + 64 * j]); o8[64 * (8 + j)] = pack4(v[8 + j] * rb * ((const f32x4*)g_b)[lane + 64 * j]); } }
    }
    SEAM(9);
    if (IN(10)) {
        pg8::Gemm g{XN, (const bf16_t*)(ws + WS_WOUT), D, D, D}; pg8::StaticOrder S; S.init(M, D, G, bx);
        pg8::EpiRes E{out, out, D, 1.0f}; pg8::gemm_phase<pg8::EpiRes, pg8::StaticOrder, true>(lds, g, S, E);
    }
    SEAM(10);
    REP(11) if (IN(11)) { for (int row = gw; row < M; row += NGW) rms_row4096(out + (size_t)row * D, args.in[21], XN + (size_t)row * D, lane); }
    SEAM(11);
    if (IN(12)) {
        pg8::Gemm g{XN, (const bf16_t*)(ws + WS_WMQ), D, D, 1024}; pg8::OffsetOrder S; S.init(M / 256, 2, 4, G, bx, 0);
        pg8::EpiF32 E{QMP, 512, (size_t)M * 512}; pg8::gemm_phase<pg8::EpiF32, pg8::OffsetOrder, true>(lds, g, S, E);
    }
    SEAM(12);
    REP(13) if (IN(13)) {
        const float* g_mq = args.in[25]; const int l16 = lane & 15, hg = lane >> 4; const float sc = 0.08838834764831845f * LOG2E;
        for (int row = gw; row < M; row += NGW) {
            f32x4 a0 = (f32x4){0.f, 0.f, 0.f, 0.f}, a1 = a0;
#pragma unroll
            for (int ks = 0; ks < 4; ++ks) { const f32x4* p = (const f32x4*)(QMP + ((size_t)ks * M + row) * 512 + hg * MEM_D); a0 += p[2 * l16]; a1 += p[2 * l16 + 1]; }
            const float rstd = rsq(g16_sum(sq4(a0) + sq4(a1)) * (1.f / MEM_D) + EPS) * sc;
            u32x2* qo = (u32x2*)(QM + (size_t)row * 512 + hg * MEM_D);
            qo[2 * l16] = pack4(a0 * rstd * ((const f32x4*)g_mq)[2 * l16]); qo[2 * l16 + 1] = pack4(a1 * rstd * ((const f32x4*)g_mq)[2 * l16 + 1]);
        }
    }
    SEAM(13);
    REP(14) if (IN(14)) {
        for (int u = bx; u < 128; u += G) { const int b = u >> 6, hh = (u >> 4) & 3, qb = u & 15; const int q0 = qb * 256 + 32 * wave; const size_t row0 = (size_t)b * SEQ + q0;
            attn_unit<MEM_D, MEM_D, 0, true>(lds, tid, lane, QM + row0 * 512 + hh * MEM_D, 512, KM + (size_t)b * MEML * 512 + hh * MEM_D, 512,
                VM + (size_t)b * MEML * 512 + hh * MEM_D, 512, OM + row0 * 512 + hh * MEM_D, 512, q0, 0, 4, NEGBIG, 0.f, nullptr); }
    }
    SEAM(14);
    if (IN(15)) {
        pg8::Gemm g{OM, (const bf16_t*)(ws + WS_WMO), 512, 512, 512}; pg8::StaticOrder S; S.init(M, D, G, bx);
        pg8::EpiRes E{out, out, D, 1.0f}; pg8::gemm_phase<pg8::EpiRes, pg8::StaticOrder, true>(lds, g, S, E);
    }
    SEAM(15);
    REP(16) if (IN(16)) { for (int row = gw; row < M; row += NGW) rms_row4096(out + (size_t)row * D, args.in[28], XN + (size_t)row * D, lane); }
    SEAM(16);
    if (IN(17)) {
        pg8::Gemm g{XN, (const bf16_t*)(ws + WS_WGU_B), D, D, D}; pg8::StaticOrder S; S.init(M, 2 * FF, G, bx);
        pg8::EpiSwiGLU E{ACT, FF}; pg8::gemm_phase<pg8::EpiSwiGLU, pg8::StaticOrder, true>(lds, g, S, E);
    }
    SEAM(17);
    if (IN(18)) {
        pg8::Gemm g{ACT, (const bf16_t*)(ws + WS_WD_B), FF, FF, FF}; pg8::StaticOrder S; S.init(M, D, G, bx);
        pg8::EpiRes E{out, out, D, 0.5f}; pg8::gemm_phase<pg8::EpiRes, pg8::StaticOrder, true>(lds, g, S, E);
    }
#undef IN
#undef SEAM
}

extern "C" void kernel_launch(void* const* d_in, const int* in_sizes, int n_in, void* d_out, int out_size, void* d_ws, size_t ws_size, hipStream_t stream) {
    static int grid = 0;
    if (grid == 0) {
        if (n_in != 32 || out_size != M * D || ws_size < WS_END) { fprintf(stderr, "kernel_launch: unexpected problem (n_in %d, out %d, ws %zu); nothing launched\n", n_in, out_size, ws_size); grid = -1; return; }
        int dev = 0, cus = 0, per_cu = 0;
        if (hipGetDevice(&dev) != hipSuccess || hipDeviceGetAttribute(&cus, hipDeviceAttributeMultiprocessorCount, dev) != hipSuccess) { grid = -1; return; }
        if (hipFuncSetAttribute((const void*)fwd_kernel, hipFuncAttributeMaxDynamicSharedMemorySize, LDS_BYTES) != hipSuccess) { fprintf(stderr, "kernel_launch: hipFuncSetAttribute failed\n"); grid = -1; return; }
        if (hipOccupancyMaxActiveBlocksPerMultiprocessor(&per_cu, (const void*)fwd_kernel, NWAVES * 64, LDS_BYTES) != hipSuccess || per_cu < 1)
            fprintf(stderr, "kernel_launch: note: occupancy query reports %d workgroups per CU\n", per_cu);
        (void)hipGetLastError();
        grid = cus;
    }
    if (grid < 0) return;
    if (hipMemsetAsync((char*)d_ws + WS_CTL, 0, CTL_ZERO_BYTES, stream) != hipSuccess) return;
    Args a{};
    for (int i = 0; i < 32; ++i) a.in[i] = (const float*)d_in[i];
    a.out = (float*)d_out; a.ws = (unsigned char*)d_ws;
    if (MK_N_LAUNCHES == 1) {
        a.ph_lo = 0; a.ph_hi = NPHASE;
        hipLaunchKernelGGL(fwd_kernel, dim3(grid), dim3(NWAVES * 64), LDS_BYTES, stream, a);
    } else {
        for (int p = 0; p < NPHASE; ++p) { a.ph_lo = p; a.ph_hi = p + 1; hipLaunchKernelGGL(fwd_kernel, dim3(grid), dim3(NWAVES * 64), LDS_BYTES, stream, a); }
    }
}
```

```cpp
#include <hip/hip_runtime.h>
#include <cstdio>
#include <cstdint>

#ifndef MK_N_LAUNCHES
#define MK_N_LAUNCHES 1
#endif

#define GAS __attribute__((address_space(1)))
#define LAS __attribute__((address_space(3)))
typedef unsigned short bf16_t;
typedef short bf16x8 __attribute__((ext_vector_type(8)));
typedef short s16x4 __attribute__((ext_vector_type(4)));
typedef float f32x4 __attribute__((ext_vector_type(4)));
typedef float f32x16 __attribute__((ext_vector_type(16)));
typedef unsigned u32x4 __attribute__((ext_vector_type(4)));
typedef unsigned u32x2 __attribute__((ext_vector_type(2)));
typedef float f32x2_t __attribute__((ext_vector_type(2)));
typedef __bf16 bf16x2_t __attribute__((ext_vector_type(2)));
typedef GAS unsigned gu32;
typedef int i32x4 __attribute__((ext_vector_type(4)));
typedef int i32x8 __attribute__((ext_vector_type(8)));
#ifndef F8_MASK
#define F8_MASK 2
#endif
constexpr bool F8_A = (F8_MASK & 1) != 0, F8_B = (F8_MASK & 2) != 0;
constexpr float F8_SA = 8.f, F8_SW = 1024.f;
__device__ __forceinline__ unsigned pk4_fp8(float a, float b, float c, float d) {
    a = fminf(fmaxf(a, -448.f), 448.f); b = fminf(fmaxf(b, -448.f), 448.f); c = fminf(fmaxf(c, -448.f), 448.f); d = fminf(fmaxf(d, -448.f), 448.f);
    int p = 0; p = __builtin_amdgcn_cvt_pk_fp8_f32(a, b, p, false); p = __builtin_amdgcn_cvt_pk_fp8_f32(c, d, p, true); return (unsigned)p; }

#define LDS_WAIT() asm volatile("s_waitcnt lgkmcnt(0)" ::: "memory")
#define VM_WAIT() asm volatile("s_waitcnt vmcnt(0)" ::: "memory")
#define RLX_AGENT __ATOMIC_RELAXED, __HIP_MEMORY_SCOPE_AGENT

__device__ __forceinline__ unsigned cvtpk(float lo, float hi) { f32x2_t v = {lo, hi}; bf16x2_t b = __builtin_convertvector(v, bf16x2_t); return __builtin_bit_cast(unsigned, b); }
__device__ __forceinline__ f32x4 bf4_to_f32(u32x2 w) { f32x4 r; r.x = __builtin_bit_cast(float, w.x << 16); r.y = __builtin_bit_cast(float, w.x & 0xffff0000u); r.z = __builtin_bit_cast(float, w.y << 16); r.w = __builtin_bit_cast(float, w.y & 0xffff0000u); return r; }
__device__ __forceinline__ float fast_exp2(float x) { return __builtin_amdgcn_exp2f(x); }
__device__ __forceinline__ float fast_rcp(float x) { return __builtin_amdgcn_rcpf(x); }
__device__ __forceinline__ float rsq(float x) { return 1.0f / __builtin_sqrtf(x); }

constexpr int SEQ = 4096, NB = 2, M = NB * SEQ, D = 4096, FF = 11008;
constexpr int MEML = 256, MROWS = NB * MEML;
constexpr int CQ = 896, CKV = 512, KRD = 64, INW = 4032;
constexpr int MLA_H = 16, MLA_QK = 192, MLA_NOPE = 128, MLA_V = 128;
constexpr int SWA_H = 32, SWA_KVH = 4, SWA_D = 64;
constexpr int MEM_H = 4, MEM_D = 128;
constexpr int NQ = MLA_H * MLA_QK;
constexpr int NKN = MLA_H * MLA_NOPE;
constexpr int NV = MLA_H * MLA_V;
constexpr int SWAW = SWA_H * SWA_D;
constexpr int SWAKW = SWA_KVH * SWA_D;
constexpr float EPS = 1e-6f;
constexpr float LOG2E = 1.4426950408889634f;
constexpr float NEGBIG = -1e30f;

constexpr size_t MiB = 1u << 20;
constexpr size_t WS_CTL = 0, CTL_ZERO_BYTES = 1 * MiB;
constexpr size_t WS_ROPE = 1 * MiB;
constexpr size_t WS_BIAS = 2 * MiB;
constexpr size_t WS_WGU_A = 4 * MiB;
constexpr size_t WS_WD_A = 176 * MiB;
constexpr size_t WS_WGU_B = 262 * MiB;
constexpr size_t WS_WD_B = 434 * MiB;
constexpr size_t WS_WIN = 520 * MiB;
constexpr size_t WS_WUQ = 552 * MiB;
constexpr size_t WS_WKN = 558 * MiB;
constexpr size_t WS_WV = 560 * MiB;
constexpr size_t WS_WOUT = 562 * MiB;
constexpr size_t WS_WMQ = 594 * MiB;
constexpr size_t WS_WMKV = 598 * MiB;
constexpr size_t WS_WMO = 606 * MiB;
constexpr size_t WS_XN = 610 * MiB;
constexpr size_t WS_ACT = 674 * MiB;
constexpr size_t WS_U = WS_ACT;
constexpr size_t WS_QRAW = WS_ACT;
constexpr size_t WS_KNRAW = WS_ACT + 96 * MiB;
constexpr size_t WS_O = WS_ACT;
constexpr size_t WS_QMP = WS_ACT;
constexpr size_t WS_QF = 846 * MiB;
constexpr size_t WS_KF = 894 * MiB;
constexpr size_t WS_VF = 942 * MiB;
constexpr size_t WS_QS = 974 * MiB;
constexpr size_t WS_KS = 1006 * MiB;
constexpr size_t WS_VS = 1010 * MiB;
constexpr size_t WS_CQN = 1014 * MiB;
constexpr size_t WS_CKVN = 1028 * MiB;
constexpr size_t WS_KRB = 1036 * MiB;
constexpr size_t WS_MEMN = 1038 * MiB;
constexpr size_t WS_KVM = 1042 * MiB;
constexpr size_t WS_KM = 1044 * MiB;
constexpr size_t WS_VM = 1044 * MiB + 512 * 1024;
constexpr size_t WS_QM = 1045 * MiB;
constexpr size_t WS_OM = 1053 * MiB;
constexpr size_t WS_SS1 = 1061 * MiB;
constexpr size_t WS_SS2 = 1063 * MiB;
constexpr size_t WS_SS3 = 1065 * MiB;
constexpr size_t WS_SSO = 1067 * MiB;
constexpr size_t WS_XN2 = 1069 * MiB;
constexpr size_t WS_HB = 1133 * MiB;
constexpr size_t WS_END = 1197 * MiB;
constexpr int CW_TMO = 0;
constexpr int CW_BAR = 4096;
constexpr int CW_CONV = 12288;

constexpr int RING_BYTES = 131072;
constexpr int MISC_OFF = 163840 - 1024;
constexpr int LDS_BYTES = 163840;
constexpr int TAB_OFF = RING_BYTES;
constexpr int WARM_OFF = RING_BYTES + 16384;
constexpr int NWAVES = 8;

namespace pg8 {
constexpr int BM = 256, BK = 64, HALF = 128, HTB = HALF * BK * 2, NXCD = 8, WGM = 4;
static_assert(WGM == 4, "the row-statistics tables cover WGM * 256 = 1024 rows");
__host__ __device__ __forceinline__ int lds_byte(int r, int c) { const int st = (r >> 4) * 2 + (c >> 5), rr = r & 15, cc = c & 31, ob = rr * 64 + cc * 2; return st * 1024 + (ob ^ (((ob >> 9) & 1) << 5)); }
__host__ __device__ __forceinline__ void stage_rc(int b, int& R, int& C) { const int st = b / 1024, sb = b % 1024, swz = sb ^ (((sb >> 9) & 1) << 5); R = (st >> 1) * 16 + swz / 64; C = (st & 1) * 32 + (swz % 64) / 2; }
__host__ __device__ __forceinline__ int perm32(int rho) { const int n = rho >> 4, i = rho & 15; return 8 * (i >> 2) + 4 * n + (i & 3); }

struct Unit { int pm, pn, ks; };
struct Gemm { const bf16_t* A; const bf16_t* Bt; int lda, ldb, K; };

struct StaticOrder {
    int nM, nN, nwg, G, c;
    __device__ __forceinline__ void init(int M_, int N_, int G_, int c_) { nM = M_ / BM; nN = N_ / BM; nwg = nM * nN; G = G_; c = c_; }
    __device__ __forceinline__ bool next(int i, Unit& u) const {
        const long L = (long)i * G + c; if (L >= nwg) return false;
        int wgid = (int)L; { const int q = nwg / NXCD, r = nwg % NXCD, xcd = wgid % NXCD, off = wgid / NXCD; wgid = (xcd < r ? xcd * (q + 1) : r * (q + 1) + (xcd - r) * q) + off; }
        const int nig = WGM * nN, gid = wgid / nig, fm = gid * WGM, gsz = (nM - fm) < WGM ? (nM - fm) : WGM;
        u.pm = fm + ((wgid % nig) % gsz); u.pn = (wgid % nig) / gsz; u.ks = 0; return true;
    }
};
struct DualOrder { StaticOrder B;
    __device__ __forceinline__ bool next(int i, Unit& u) const { if (!B.next(i >> 1, u)) return false; u.ks = i & 1; return true; } };
struct OffsetOrder {
    int n, c0, G, c, nN, nS;
    __device__ __forceinline__ void init(int nM_, int nN_, int nS_, int G_, int c_, int c0_) { n = nM_ * nN_ * nS_; nN = nN_; nS = nS_; G = G_; c = c_; c0 = c0_; }
    __device__ __forceinline__ bool next(int i, Unit& u) const {
        const int rel = (c - c0 + G) % G; const long L = (long)i * G + rel; if (L >= n) return false;
        const int t = (int)L; u.ks = t % nS; const int q = t / nS; u.pn = q % nN; u.pm = q / nN; return true;
    }
};

struct RowTab { const LAS float* t; int row_base; };
__device__ __forceinline__ float tab_get(const RowTab& T, int row) { return T.t ? T.t[row - T.row_base] : 1.f; }
__device__ __forceinline__ void build_rstd_tab(LAS float* tab, const float* ss, int row_base, int s0, int ns, float inv_n, int tid) {
    for (int r = tid; r < 1024; r += 512) { const f32x4* p = (const f32x4*)(ss + (size_t)(row_base + r) * 64 + s0);
        f32x4 a = p[0];
        for (int i = 1; i < ns / 4; ++i) a += p[i];
        tab[r] = rsq(((a.x + a.y) + (a.z + a.w)) * inv_n + EPS); }
    __syncthreads();
}
template <class T> __device__ __forceinline__ T ldo(const void* base, unsigned off) { return *(const T*)((const char*)base + off); }
template <class T> __device__ __forceinline__ void sto(void* base, unsigned off, T v) { *(T*)((char*)base + off) = v; }
struct EpiF32 {
    static constexpr bool PERM = false, HAS_MID = false;
    float* C; int ldc; size_t split_stride; RowTab pre;
    __device__ __forceinline__ void operator()(const f32x4 (&acc)[2][2][4][2], const Unit& u, int wr, int wc, int fr, int fq) const {
        const int row0 = u.pm * BM + wr * 64 + fr, col0 = u.pn * BM + wc * 32 + 4 * fq;
        float* Cb = C + (size_t)u.ks * split_stride;
#pragma unroll
        for (int ai = 0; ai < 2; ++ai)
#pragma unroll
            for (int m = 0; m < 4; ++m) { const int row = row0 + ai * HALF + m * 16; const float rs = tab_get(pre, row); const unsigned off = (unsigned)(row * ldc + col0) * 4u;
#pragma unroll
                for (int bj = 0; bj < 2; ++bj)
#pragma unroll
                    for (int n = 0; n < 2; ++n) sto<f32x4>(Cb, off + (bj * HALF + n * 16) * 4, acc[ai][bj][m][n] * rs); }
    }
};
struct EpiResOut {
    static constexpr bool PERM = true, HAS_MID = false;
    const bf16_t* hb; float* out; int ldc; float alpha;
    __device__ __forceinline__ void operator()(const f32x4 (&acc)[2][2][4][2], const Unit& u, int wr, int wc, int fr, int fq) const {
        const int row0 = u.pm * BM + wr * 64 + fr, col0 = u.pn * BM + wc * 32 + 8 * fq;
#pragma unroll
        for (int ai = 0; ai < 2; ++ai) {
            u32x4 b[4][2];
#pragma unroll
            for (int m = 0; m < 4; ++m)
#pragma unroll
                for (int bj = 0; bj < 2; ++bj) b[m][bj] = ldo<u32x4>(hb, (unsigned)((row0 + ai * HALF + m * 16) * ldc + col0 + bj * HALF) * 2u);
            asm volatile("" ::: "memory");
#pragma unroll
            for (int m = 0; m < 4; ++m) { const unsigned eo = (unsigned)((row0 + ai * HALF + m * 16) * ldc + col0);
#pragma unroll
                for (int bj = 0; bj < 2; ++bj) { const f32x4 h0 = bf4_to_f32((u32x2){b[m][bj].x, b[m][bj].y}), h1 = bf4_to_f32((u32x2){b[m][bj].z, b[m][bj].w});
                    sto<f32x4>(out, (eo + bj * HALF) * 4u, h0 + acc[ai][bj][m][0] * alpha); sto<f32x4>(out, (eo + bj * HALF + 4) * 4u, h1 + acc[ai][bj][m][1] * alpha); } }
            asm volatile("" ::: "memory");
        }
    }
};
template <bool MID, bool BASE_F32> struct EpiResNorm {
    static constexpr bool PERM = true, HAS_MID = MID;
    const void* base; bf16_t* hb; int ldc; float alpha; RowTab pre, mid_num, mid_den; float* ssout;
    __device__ __forceinline__ bool mid(const Unit& u) const { return MID && u.ks == 0; }
    __device__ __forceinline__ void midscale(f32x4 (&acc)[2][2][4][2], const Unit& u, int wr, int wc, int fr, int fq) const {
        const int row0 = u.pm * BM + wr * 64 + fr;
#pragma unroll
        for (int ai = 0; ai < 2; ++ai)
#pragma unroll
            for (int m = 0; m < 4; ++m) { const int row = row0 + ai * HALF + m * 16; const float f = tab_get(mid_num, row) / tab_get(mid_den, row);
#pragma unroll
                for (int bj = 0; bj < 2; ++bj)
#pragma unroll
                    for (int n = 0; n < 2; ++n) acc[ai][bj][m][n] = acc[ai][bj][m][n] * f; }
    }
    __device__ __forceinline__ void operator()(const f32x4 (&acc)[2][2][4][2], const Unit& u, int wr, int wc, int fr, int fq) const {
        const int row0 = u.pm * BM + wr * 64 + fr, col0 = u.pn * BM + wc * 32 + 8 * fq;
#pragma unroll
        for (int am = 0; am < 4; ++am) { const int ai = am >> 1, m0 = (am & 1) * 2;
            f32x4 b[BASE_F32 ? 2 : 1][2][2]; u32x4 braw[2][2];
#pragma unroll
            for (int mm = 0; mm < 2; ++mm) { const unsigned eo = (unsigned)((row0 + ai * HALF + (m0 + mm) * 16) * ldc + col0);
#pragma unroll
                for (int bj = 0; bj < 2; ++bj) {
                    if (BASE_F32) { b[mm][bj][0] = ldo<f32x4>(base, (eo + bj * HALF) * 4u); b[mm][bj][1] = ldo<f32x4>(base, (eo + bj * HALF + 4) * 4u); }
                    else braw[mm][bj] = ldo<u32x4>(base, (eo + bj * HALF) * 2u); } }
            asm volatile("" ::: "memory");
#pragma unroll
            for (int mm = 0; mm < 2; ++mm) { const int m = m0 + mm; const int row = row0 + ai * HALF + m * 16; const float sc = alpha * tab_get(pre, row); const unsigned eo = (unsigned)(row * ldc + col0);
                float ssq = 0.f;
#pragma unroll
                for (int bj = 0; bj < 2; ++bj) {
                    f32x4 r0, r1;
                    if (BASE_F32) { r0 = b[mm][bj][0]; r1 = b[mm][bj][1]; } else { r0 = bf4_to_f32((u32x2){braw[mm][bj].x, braw[mm][bj].y}); r1 = bf4_to_f32((u32x2){braw[mm][bj].z, braw[mm][bj].w}); }
                    const f32x4 v0 = r0 + acc[ai][bj][m][0] * sc, v1 = r1 + acc[ai][bj][m][1] * sc;
                    u32x4 hw; hw.x = cvtpk(v0[0], v0[1]); hw.y = cvtpk(v0[2], v0[3]); hw.z = cvtpk(v1[0], v1[1]); hw.w = cvtpk(v1[2], v1[3]);
                    sto<u32x4>(hb, (eo + bj * HALF) * 2u, hw);
                    ssq += (v0.x * v0.x + v0.y * v0.y) + (v0.z * v0.z + v0.w * v0.w) + (v1.x * v1.x + v1.y * v1.y) + (v1.z * v1.z + v1.w * v1.w); }
                ssq += __shfl_xor(ssq, 16); ssq += __shfl_xor(ssq, 32);
                if (fq == 0) sto<float>(ssout, (unsigned)(row * 64 + u.pn * 4 + wc) * 4u, ssq); }
            asm volatile("" ::: "memory");
        }
    }
};
struct EpiBf16 {
    static constexpr bool PERM = true, HAS_MID = false;
    bf16_t* O; int ldc; RowTab pre; size_t split_stride; bf16_t* O2 = nullptr; int pn_split = 1 << 30;
    __device__ __forceinline__ void operator()(const f32x4 (&acc)[2][2][4][2], const Unit& u, int wr, int wc, int fr, int fq) const {
        const bool second = u.pn >= pn_split;
        const int row0 = u.pm * BM + wr * 64 + fr, col0 = (second ? u.pn - pn_split : u.pn) * BM + wc * 32 + 8 * fq;
        bf16_t* Ob = second ? O2 : O + (size_t)u.ks * split_stride;
#pragma unroll
        for (int ai = 0; ai < 2; ++ai)
#pragma unroll
            for (int m = 0; m < 4; ++m) { const int row = row0 + ai * HALF + m * 16; const float rs = tab_get(pre, row); const unsigned eo = (unsigned)(row * ldc + col0);
#pragma unroll
                for (int bj = 0; bj < 2; ++bj) { const f32x4 v0 = acc[ai][bj][m][0] * rs, v1 = acc[ai][bj][m][1] * rs;
                    u32x4 w; w.x = cvtpk(v0[0], v0[1]); w.y = cvtpk(v0[2], v0[3]); w.z = cvtpk(v1[0], v1[1]); w.w = cvtpk(v1[2], v1[3]);
                    sto<u32x4>(Ob, (eo + bj * HALF) * 2u, w); } }
    }
};
#ifndef ACT_NT
#define ACT_NT 0
#endif
struct EpiSwiGLU {
    static constexpr bool PERM = true, HAS_MID = false;
    bf16_t* O; int ldc; RowTab pre; bool f8 = false;
    __device__ __forceinline__ float sw(float g, float up) const { return g * fast_rcp(1.0f + fast_exp2(-LOG2E * g)) * up; }
    __device__ __forceinline__ void operator()(const f32x4 (&acc)[2][2][4][2], const Unit& u, int wr, int wc, int fr, int fq) const {
        const int row0 = u.pm * BM + wr * 64 + fr, col0 = u.pn * HALF + wc * 32 + 8 * fq;
#pragma unroll
        for (int ai = 0; ai < 2; ++ai)
#pragma unroll
            for (int m = 0; m < 4; ++m) { const int row = row0 + ai * HALF + m * 16; const float rs = tab_get(pre, row);
                const f32x4 g0 = acc[ai][0][m][0] * rs, g1 = acc[ai][0][m][1] * rs, u0 = acc[ai][1][m][0] * rs, u1 = acc[ai][1][m][1] * rs;
                if (f8) { u32x2 w8; w8.x = pk4_fp8(sw(g0[0], u0[0]) * F8_SA, sw(g0[1], u0[1]) * F8_SA, sw(g0[2], u0[2]) * F8_SA, sw(g0[3], u0[3]) * F8_SA);
                    w8.y = pk4_fp8(sw(g1[0], u1[0]) * F8_SA, sw(g1[1], u1[1]) * F8_SA, sw(g1[2], u1[2]) * F8_SA, sw(g1[3], u1[3]) * F8_SA);
                    sto<u32x2>(O, (unsigned)(row * ldc + col0), w8); continue; }
                u32x4 w; w.x = cvtpk(sw(g0[0], u0[0]), sw(g0[1], u0[1])); w.y = cvtpk(sw(g0[2], u0[2]), sw(g0[3], u0[3]));
                w.z = cvtpk(sw(g1[0], u1[0]), sw(g1[1], u1[1])); w.w = cvtpk(sw(g1[2], u1[2]), sw(g1[3], u1[3]));
                if (ACT_NT) __builtin_nontemporal_store(w, (u32x4*)((char*)O + (unsigned)(row * ldc + col0) * 2u)); else sto<u32x4>(O, (unsigned)(row * ldc + col0) * 2u, w); }
    }
};

struct EpiIn {
    static constexpr bool PERM = true, HAS_MID = false;
    RowTab pre; bf16_t* cqn; bf16_t* ckvn; bf16_t* qs; bf16_t* ks; bf16_t* vs; float* krb; float* sscq; float* ssckv; const float* g_sq; const float* g_sk;
    __device__ __forceinline__ static void st2(bf16_t* dst, unsigned eoff, int bstep, const f32x4 (&v)[2][2], float sc, const f32x4 (&gv)[2][2]) {
#pragma unroll
        for (int bj = 0; bj < 2; ++bj) { const f32x4 x0 = v[bj][0] * sc * gv[bj][0], x1 = v[bj][1] * sc * gv[bj][1];
            u32x4 w; w.x = cvtpk(x0[0], x0[1]); w.y = cvtpk(x0[2], x0[3]); w.z = cvtpk(x1[0], x1[1]); w.w = cvtpk(x1[2], x1[3]);
            sto<u32x4>(dst, (eoff + bj * bstep) * 2u, w); }
    }
    __device__ __forceinline__ void operator()(const f32x4 (&acc)[2][2][4][2], const Unit& u, int wr, int wc, int fr, int fq) const {
        const int row0 = u.pm * BM + wr * 64 + fr, pn = u.pn, c8 = 8 * fq;
        f32x4 gv[2][2];
        if (pn >= 6 && pn <= 14) { const float* gp = (pn == 14) ? g_sk : g_sq;
#pragma unroll
            for (int bj = 0; bj < 2; ++bj)
#pragma unroll
                for (int n = 0; n < 2; ++n) gv[bj][n] = *(const f32x4*)(gp + 32 * bj + c8 + 4 * n); }
        else {
#pragma unroll
            for (int bj = 0; bj < 2; ++bj)
#pragma unroll
                for (int n = 0; n < 2; ++n) gv[bj][n] = (f32x4){1.f, 1.f, 1.f, 1.f}; }
#pragma unroll
        for (int ai = 0; ai < 2; ++ai)
#pragma unroll
            for (int m = 0; m < 4; ++m) { const int row = row0 + ai * HALF + m * 16; const float rs = tab_get(pre, row);
                f32x4 v[2][2]; float ssq = 0.f;
#pragma unroll
                for (int bj = 0; bj < 2; ++bj)
#pragma unroll
                    for (int n = 0; n < 2; ++n) { v[bj][n] = acc[ai][bj][m][n] * rs; ssq += (v[bj][n].x * v[bj][n].x + v[bj][n].y * v[bj][n].y) + (v[bj][n].z * v[bj][n].z + v[bj][n].w * v[bj][n].w); }
                ssq += __shfl_xor(ssq, 16); ssq += __shfl_xor(ssq, 32);
                if (pn < 3) { st2(cqn, (unsigned)(row * CQ + 256 * pn + 32 * wc + c8), HALF, v, 1.f, gv); if (fq == 0) sto<float>(sscq, (unsigned)(row * 64 + 4 * pn + wc) * 4u, ssq); }
                else if (pn == 3) {
                    if (wc < 2) { st2(cqn, (unsigned)(row * CQ + 768 + 64 * wc + c8), 32, v, 1.f, gv); if (fq == 0) sto<float>(sscq, (unsigned)(row * 64 + 12 + wc) * 4u, ssq); }
                    else { if (wc == 2) {
#pragma unroll
                            for (int bj = 0; bj < 2; ++bj)
#pragma unroll
                                for (int n = 0; n < 2; ++n) sto<f32x4>(krb, (unsigned)(row * KRD + 32 * bj + c8 + 4 * n) * 4u, v[bj][n]); }
                        if (fq == 0) sto<float>(sscq, (unsigned)(row * 64 + 12 + wc) * 4u, 0.f); } }
                else if (pn <= 5) { st2(ckvn, (unsigned)(row * CKV + 256 * (pn - 4) + 32 * wc + c8), HALF, v, 1.f, gv); if (fq == 0) sto<float>(ssckv, (unsigned)(row * 64 + 4 * (pn - 4) + wc) * 4u, ssq); }
                else if (pn <= 13) st2(qs, (unsigned)(row * SWAW + (4 * (pn - 6) + wc) * SWA_D + c8), 32, v, rsq(ssq * (1.f / SWA_D) + EPS) * (0.125f * LOG2E), gv);
                else if (pn == 14) st2(ks, (unsigned)(row * SWAKW + wc * SWA_D + c8), 32, v, rsq(ssq * (1.f / SWA_D) + EPS), gv);
                else st2(vs, (unsigned)(row * SWAKW + wc * SWA_D + c8), 32, v, 1.f, gv);
            }
    }
};

template <class Epi, class Sched, bool ALIGN_EPI, bool F8 = false>
__device__ __forceinline__ void gemm_phase(LAS unsigned char* lds, const Gemm g, const Sched& S, const Epi& E) {
    const int tid = threadIdx.x, wid = __builtin_amdgcn_readfirstlane(tid >> 6), lane = tid & 63, wr = wid >> 2, wc = wid & 3, fr = lane & 15, fq = lane >> 4;
    const int K = g.K, nt = K / BK;
    unsigned voffA[2], voffB[2];
#pragma unroll
    for (int i = 0; i < 2; ++i) { int R, C; stage_rc(tid * 16 + i * 8192, R, C); const int Rb = Epi::PERM ? ((R & ~31) + perm32(R & 31)) : R;
        voffA[i] = (unsigned)(R * g.lda + C) * 2u; voffB[i] = (unsigned)(Rb * g.ldb + C) * 2u; }
    const size_t kstep = (size_t)(BK * 2);
    const size_t hstepA = (size_t)HALF * g.lda * 2, hstepB = (size_t)HALF * g.ldb * 2;
    const size_t tstepA = 2 * hstepA, tstepB = 2 * hstepB;
    const unsigned ldsw = (unsigned)wid * 1024u;
    const bool wsel = wid >= 4;
    const unsigned woff = (unsigned)((64 * (wid & 3) + lane) * (wsel ? g.ldb : g.lda)) * 2u;
    const int aoff = lds_byte(wr * 64 + fr, fq * 8), boff = lds_byte(wc * 32 + fr, fq * 8);
#define PG8_SA(b, h) (((b) * 2 + (h)) * HTB)
#define PG8_SB(b, h) ((4 + (b) * 2 + (h)) * HTB)
#ifndef PG8_AUX_B
#define PG8_AUX_B 0
#endif
#define PG8_STAGE(bufoff, gbase, voff) do { _Pragma("unroll") for (int _i = 0; _i < 2; ++_i) \
        __builtin_amdgcn_global_load_lds((const unsigned*)((const char*)(gbase) + (voff)[_i]), (LAS unsigned*)(lds + (bufoff) + ldsw + _i * 8192), 16, 0, 0); } while (0)
#define PG8_STAGEB(bufoff, gbase, voff) do { _Pragma("unroll") for (int _i = 0; _i < 2; ++_i) \
        __builtin_amdgcn_global_load_lds((const unsigned*)((const char*)(gbase) + (voff)[_i]), (LAS unsigned*)(lds + (bufoff) + ldsw + _i * 8192), 16, 0, PG8_AUX_B); } while (0)
#define PG8_LDA(dst, b, h) do { _Pragma("unroll") for (int m = 0; m < 4; ++m) { \
        if constexpr (F8) dst##8[m] = __builtin_shufflevector(*(const LAS i32x4*)(lds + PG8_SA(b, h) + aoff + m * 2048), *(const LAS i32x4*)(lds + PG8_SA(b, h) + aoff + m * 2048 + 1024), 0, 1, 2, 3, 4, 5, 6, 7); \
        else { _Pragma("unroll") for (int k = 0; k < 2; ++k) dst[m][k] = *(const LAS bf16x8*)(lds + PG8_SA(b, h) + aoff + m * 2048 + k * 1024); } } } while (0)
#define PG8_LDB(dst, b, h) do { _Pragma("unroll") for (int n = 0; n < 2; ++n) { \
        if constexpr (F8) dst##8[n] = __builtin_shufflevector(*(const LAS i32x4*)(lds + PG8_SB(b, h) + boff + n * 2048), *(const LAS i32x4*)(lds + PG8_SB(b, h) + boff + n * 2048 + 1024), 0, 1, 2, 3, 4, 5, 6, 7); \
        else { _Pragma("unroll") for (int k = 0; k < 2; ++k) dst[n][k] = *(const LAS bf16x8*)(lds + PG8_SB(b, h) + boff + n * 2048 + k * 1024); } } } while (0)
#define PG8_MMA(ai, bj, At, Bt) do { __builtin_amdgcn_s_setprio(1); _Pragma("unroll") for (int m = 0; m < 4; ++m) _Pragma("unroll") for (int n = 0; n < 2; ++n) { \
        if constexpr (F8) asm volatile("v_mfma_scale_f32_16x16x128_f8f6f4 %0, %1, %2, %0, %3, %3 op_sel_hi:[0,0,0]" : "+v"(acc[ai][bj][m][n]) : "v"(Bt##8[n]), "v"(At##8[m]), "v"(f8one)); \
        else { _Pragma("unroll") for (int k = 0; k < 2; ++k) acc[ai][bj][m][n] = __builtin_amdgcn_mfma_f32_16x16x32_bf16(Bt[n][k], At[m][k], acc[ai][bj][m][n], 0, 0, 0); } } \
        __builtin_amdgcn_s_setprio(0); } while (0)
#define PG8_WAIT_V(n) asm volatile("s_waitcnt vmcnt(" #n ")" ::: "memory")
#ifndef PG8_WARM_ON
#define PG8_WARM_ON 0
#endif
#define PG8_WD 4
#if PG8_WARM_ON
#define PG8_WARM(tw) do { const int tw_ = (tw); const char* wa_ = tw_ < nt ? cA + (size_t)tw_ * kstep : nA + (size_t)(tw_ - nt) * kstep; const char* wb_ = tw_ < nt ? cB + (size_t)tw_ * kstep : nB + (size_t)(tw_ - nt) * kstep; \
        __builtin_amdgcn_global_load_lds((const unsigned*)((wsel ? wb_ : wa_) + woff), (LAS unsigned*)(lds + WARM_OFF + wid * 256), 4, 0, 0); } while (0)
#define PG8_WAIT_SP1 PG8_WAIT_V(9)
#define PG8_WAIT_SP2 PG8_WAIT_V(10)
#else
#define PG8_WARM(tw) do { } while (0)
#define PG8_WAIT_SP1 PG8_WAIT_V(8)
#define PG8_WAIT_SP2 PG8_WAIT_V(8)
#endif
#define PG8_WAIT_L(n) asm volatile("s_waitcnt lgkmcnt(" #n ")" ::: "memory")
#define PG8_BAR __builtin_amdgcn_s_barrier()
#define PG8_SCHED __builtin_amdgcn_sched_barrier(0)
    Unit cur, nxt; int ui = 0;
    if (!S.next(0, cur)) return;
    f32x4 acc[2][2][4][2];
#pragma unroll
    for (int a = 0; a < 2; ++a)
#pragma unroll
        for (int b = 0; b < 2; ++b)
#pragma unroll
            for (int m = 0; m < 4; ++m)
#pragma unroll
                for (int n = 0; n < 2; ++n) acc[a][b][m][n] = (f32x4){0.f, 0.f, 0.f, 0.f};
    const int f8one = 0x7F7F7F7F;
    bf16x8 At[4][2], B0[2][2], B1[2][2]; i32x8 At8[4], B08[2], B18[2];
    const char* cA = (const char*)g.A + (size_t)cur.pm * tstepA + (size_t)cur.ks * K * 2; const char* cB = (const char*)g.Bt + (size_t)cur.pn * tstepB + (size_t)cur.ks * K * 2;
    PG8_STAGEB(PG8_SB(0, 0), cB, voffB); PG8_STAGEB(PG8_SB(0, 1), cB + hstepB, voffB); PG8_STAGE(PG8_SA(0, 0), cA, voffA); PG8_STAGE(PG8_SA(0, 1), cA + hstepA, voffA);
    if (wr == 1) PG8_BAR;
    PG8_WAIT_V(2); PG8_BAR;
    PG8_STAGEB(PG8_SB(1, 0), cB + kstep, voffB); PG8_STAGE(PG8_SA(1, 0), cA + kstep, voffA); PG8_STAGEB(PG8_SB(1, 1), cB + hstepB + kstep, voffB);
    PG8_WAIT_V(6); PG8_BAR;
    { const char* nA = cA; const char* nB = cB; PG8_WARM(PG8_WD - 1 < nt ? PG8_WD - 1 : 0); }
    for (;;) {
        const bool has_next = S.next(ui + 1, nxt);
        const char* nA = has_next ? (const char*)g.A + (size_t)nxt.pm * tstepA + (size_t)nxt.ks * K * 2 : cA;
        const char* nB = has_next ? (const char*)g.Bt + (size_t)nxt.pn * tstepB + (size_t)nxt.ks * K * 2 : cB;
#pragma unroll 1
        for (int t = 0; t < nt; t += 2) {
            const bool last = (t == nt - 2);
            const char* a1 = cA + (size_t)(t + 1) * kstep;
            const char* a2 = last ? nA : cA + (size_t)(t + 2) * kstep; const char* b2 = last ? nB : cB + (size_t)(t + 2) * kstep;
            const char* a3 = a2 + kstep; const char* b3 = b2 + kstep;
            PG8_LDB(B0, 0, 0); PG8_LDB(B1, 0, 1); PG8_SCHED; PG8_LDA(At, 0, 0); PG8_STAGE(PG8_SA(1, 1), a1 + hstepA, voffA);
            PG8_WAIT_SP1; PG8_WAIT_L(0); PG8_BAR; PG8_MMA(0, 0, At, B0); PG8_MMA(0, 1, At, B1); PG8_BAR; PG8_SCHED;
            PG8_LDA(At, 0, 1); PG8_STAGEB(PG8_SB(0, 0), b2, voffB); PG8_STAGEB(PG8_SB(0, 1), b2 + hstepB, voffB); PG8_STAGE(PG8_SA(0, 0), a2, voffA); PG8_WARM(t + PG8_WD);
            PG8_WAIT_SP2; PG8_WAIT_L(0); PG8_BAR; PG8_MMA(1, 0, At, B0); PG8_MMA(1, 1, At, B1); PG8_BAR; PG8_SCHED;
            PG8_LDB(B0, 1, 0); PG8_LDB(B1, 1, 1); PG8_SCHED; PG8_LDA(At, 1, 0); PG8_STAGE(PG8_SA(0, 1), a2 + hstepA, voffA);
            PG8_WAIT_SP1; PG8_WAIT_L(0); PG8_BAR; PG8_MMA(0, 0, At, B0); PG8_MMA(0, 1, At, B1); PG8_BAR; PG8_SCHED;
            PG8_LDA(At, 1, 1); PG8_STAGEB(PG8_SB(1, 0), b3, voffB); PG8_STAGEB(PG8_SB(1, 1), b3 + hstepB, voffB); PG8_STAGE(PG8_SA(1, 0), a3, voffA); PG8_WARM(t + 1 + PG8_WD);
            PG8_WAIT_SP2; PG8_WAIT_L(0); PG8_BAR; PG8_MMA(1, 0, At, B0); PG8_MMA(1, 1, At, B1); PG8_BAR; PG8_SCHED;
        }
        if constexpr (ALIGN_EPI) { if (wr == 0) PG8_BAR; }
        if constexpr (F8) asm volatile("s_nop 15\n\ts_nop 15" ::: "memory");
        bool keep = false;
        if constexpr (Epi::HAS_MID) { if (E.mid(cur)) { E.midscale(acc, cur, wr, wc, fr, fq); keep = true; } }
        if (!keep) E(acc, cur, wr, wc, fr, fq);
        if (!has_next) break;
        if (!keep) {
#pragma unroll
        for (int a = 0; a < 2; ++a)
#pragma unroll
            for (int b = 0; b < 2; ++b)
#pragma unroll
                for (int m = 0; m < 4; ++m)
#pragma unroll
                    for (int n = 0; n < 2; ++n) acc[a][b][m][n] = (f32x4){0.f, 0.f, 0.f, 0.f};
        }
        cur = nxt; cA = nA; cB = nB; ++ui;
        if constexpr (ALIGN_EPI) { if (wr == 1) PG8_BAR; }
    }
    PG8_WAIT_V(0);
    if constexpr (!ALIGN_EPI) { if (wr == 0) PG8_BAR; }
    PG8_BAR;
#undef PG8_SA
#undef PG8_SB
#undef PG8_STAGE
#undef PG8_STAGEB
#undef PG8_LDA
#undef PG8_LDB
#undef PG8_MMA
#undef PG8_WAIT_V
#undef PG8_WARM
#undef PG8_WAIT_SP1
#undef PG8_WAIT_SP2
#undef PG8_WAIT_L
#undef PG8_BAR
#undef PG8_SCHED
}
}

#define XB_TMO      128
#define XB_XCNT(j)  (256  + 64 * (j))
#define XB_XSUB(j)  (1280 + 64 * (j))
#define XB_XGEN(j)  (2304 + 64 * (j))
#define XB_TOP      3328
#define XB_TOPGEN   3392
#define XCD_BAR_WORDS 3456
#define XB_SPIN_CAP (1u << 18)
__device__ __forceinline__ unsigned xb_ld(unsigned* p)              { return __hip_atomic_load(p, __ATOMIC_RELAXED, __HIP_MEMORY_SCOPE_AGENT); }
__device__ __forceinline__ unsigned xb_add(unsigned* p, unsigned v) { return __hip_atomic_fetch_add(p, v, __ATOMIC_RELAXED, __HIP_MEMORY_SCOPE_AGENT); }
__device__ __forceinline__ unsigned xb_xcc_id() { return (unsigned)__builtin_amdgcn_s_getreg((3 << 11) | 20) & 0xFu; }
#define XB_SPIN(cond, bar) do { unsigned _sp = 0; while (cond) { __builtin_amdgcn_s_sleep(1); \
    if ((++_sp & 255u) == 0u) { if (xb_ld(&(bar)[XB_TMO])) break; if (_sp > XB_SPIN_CAP) { atomicAdd(&(bar)[XB_TMO], 1u); break; } } } } while (0)
struct XcdBarrier { unsigned* bar; unsigned x; volatile LAS unsigned* st; };
__device__ __forceinline__ XcdBarrier xcd_barrier_post(unsigned* bar, volatile LAS unsigned* st) {
    XcdBarrier b; b.bar = bar; b.x = xb_xcc_id(); b.st = st;
    if (threadIdx.x == 0) (void)xb_add(&bar[XB_XCNT(b.x)], 1u);
    return b;
}
__device__ __forceinline__ void xcd_barrier_complete(unsigned* bar, unsigned x, unsigned& nloc, unsigned& nx) {
    const unsigned G = gridDim.x * gridDim.y * gridDim.z;
    unsigned sum, cnt, mine, sp = 0u;
    for (;;) {
        sum = 0u; cnt = 0u; mine = 0u;
#pragma unroll
        for (unsigned j = 0; j < 16; ++j) { const unsigned c = xb_ld(&bar[XB_XCNT(j)]); sum += c; cnt += (c > 0u) ? 1u : 0u; mine = (j == x) ? c : mine; }
        if (sum == G) break;
        __builtin_amdgcn_s_sleep(1);
        if ((++sp & 255u) == 0u) { if (xb_ld(&bar[XB_TMO])) break; if (sp > XB_SPIN_CAP) { atomicAdd(&bar[XB_TMO], 1u); break; } }
    }
    nloc = mine > 0u ? mine : 1u; nx = cnt > 0u ? cnt : 1u;
}
__device__ __forceinline__ void xcd_barrier(const XcdBarrier& b) {
    asm volatile("s_waitcnt vmcnt(0)" ::: "memory");
    __syncthreads();
    if (threadIdx.x == 0) {
        unsigned* bar = b.bar;
        __builtin_amdgcn_s_waitcnt(0);
        unsigned nloc = b.st[0], nx = b.st[1];
        if (nloc == 0u) { xcd_barrier_complete(bar, b.x, nloc, nx); b.st[0] = nloc; b.st[1] = nx; }
        const unsigned old = xb_add(&bar[XB_XSUB(b.x)], 1u);
        const unsigned gen = old / nloc;
        if (old + 1u == (gen + 1u) * nloc) {
            __builtin_amdgcn_fence(__ATOMIC_RELEASE, "agent");
            asm volatile("s_waitcnt vmcnt(0)" ::: "memory");
            const unsigned og = xb_add(&bar[XB_TOP], 1u);
            const unsigned tg = og / nx;
            if (og + 1u == (tg + 1u) * nx) xb_add(&bar[XB_TOPGEN], 1u);
            else XB_SPIN(xb_ld(&bar[XB_TOPGEN]) == tg, bar);
            __builtin_amdgcn_fence(__ATOMIC_ACQUIRE, "agent");
            xb_add(&bar[XB_XGEN(b.x)], 1u);
            asm volatile("s_waitcnt vmcnt(0)" ::: "memory");
        } else {
            XB_SPIN(xb_ld(&bar[XB_XGEN(b.x)]) == gen, bar);
            __builtin_amdgcn_fence(__ATOMIC_ACQUIRE, "agent");
            asm volatile("s_waitcnt vmcnt(0)" ::: "memory");
        }
    }
    __syncthreads();
}

__device__ __forceinline__ float wave_sum(float v) {
#pragma unroll
    for (int o = 1; o < 64; o <<= 1) v += __shfl_xor(v, o);
    return v;
}
__device__ __forceinline__ float g16_sum(float v) {
#pragma unroll
    for (int o = 1; o < 16; o <<= 1) v += __shfl_xor(v, o);
    return v;
}
__device__ __forceinline__ float sq4(f32x4 v) { return (v.x * v.x + v.y * v.y) + (v.z * v.z + v.w * v.w); }
__device__ __forceinline__ u32x2 pack4(f32x4 v) { u32x2 w; w.x = cvtpk(v.x, v.y); w.y = cvtpk(v.z, v.w); return w; }

#ifndef XI_NT
#define XI_NT 0
#endif
struct XItem { const float* src; const float* gain; bf16_t* dst; int srcN, col0, K, row0, k0; float f8scale; };
__device__ __forceinline__ void xi_load(const XItem& x, f32x4 (&v)[8], f32x4 (&gk)[2], int lane) {
    const int kg = lane >> 3, c4 = lane & 7;
    if (x.col0 >= 0) {
        const float* p = x.src + (size_t)(x.k0 + 8 * kg) * x.srcN + x.col0 + 4 * c4;
#pragma unroll
        for (int i = 0; i < 8; ++i) v[i] = *(const f32x4*)(p + (size_t)i * x.srcN);
    } else {
#pragma unroll
        for (int i = 0; i < 8; ++i) v[i] = (f32x4){0.f, 0.f, 0.f, 0.f};
    }
    if (x.gain) { gk[0] = *(const f32x4*)(x.gain + x.k0 + 8 * kg); gk[1] = *(const f32x4*)(x.gain + x.k0 + 8 * kg + 4); }
    else { gk[0] = (f32x4){1.f, 1.f, 1.f, 1.f}; gk[1] = gk[0]; }
}
__device__ __forceinline__ void xi_store(const XItem& x, const f32x4 (&v)[8], const f32x4 (&gk)[2], int lane) {
    const int kg = lane >> 3, c4 = lane & 7;
    if (x.f8scale > 0.f) { unsigned char* d8 = (unsigned char*)x.dst + (size_t)(x.row0 + 4 * c4) * x.K + x.k0 + 8 * kg; const float sc = x.f8scale;
#pragma unroll
        for (int j = 0; j < 4; ++j) { u32x2 o; o.x = pk4_fp8(v[0][j] * sc, v[1][j] * sc, v[2][j] * sc, v[3][j] * sc); o.y = pk4_fp8(v[4][j] * sc, v[5][j] * sc, v[6][j] * sc, v[7][j] * sc);
            *(GAS u32x2*)(d8 + (size_t)j * x.K) = o; }
        return; }
    bf16_t* d = x.dst + (size_t)(x.row0 + 4 * c4) * x.K + x.k0 + 8 * kg;
#pragma unroll
    for (int j = 0; j < 4; ++j) { u32x4 o; o.x = cvtpk(v[0][j] * gk[0].x, v[1][j] * gk[0].y); o.y = cvtpk(v[2][j] * gk[0].z, v[3][j] * gk[0].w); o.z = cvtpk(v[4][j] * gk[1].x, v[5][j] * gk[1].y); o.w = cvtpk(v[6][j] * gk[1].z, v[7][j] * gk[1].w);
        *(GAS u32x4*)(d + (size_t)j * x.K) = o; }
}
__device__ __forceinline__ void rms_row4096(const float* xrow, const float* gain, bf16_t* orow, int lane) {
    const f32x4* xr = (const f32x4*)xrow + lane; const f32x4* gr = (const f32x4*)gain + lane;
    f32x4 v[16]; float s = 0.f;
#pragma unroll
    for (int j = 0; j < 16; ++j) { v[j] = xr[64 * j]; s += sq4(v[j]); }
    const float rstd = rsq(wave_sum(s) * (1.f / 4096.f) + EPS);
    u32x2* o8 = (u32x2*)orow + lane;
#pragma unroll
    for (int j = 0; j < 16; ++j) { const f32x4 gg = gr[64 * j]; o8[64 * j] = pack4(v[j] * rstd * gg); }
}

template <int DQK, int DV> struct ACfg {
    static constexpr int PK = DQK * 2 + 16, PV = DV * 2 + 64;
    static constexpr int KT = 64 * PK, VT = 64 * PV, STAGE = KT + VT;
    static constexpr int SK = PK / 16, SV = PV / 16, NQI = SK + SV, NI = (NQI + 7) / 8;
    static constexpr int NSTAGE = 3;
};
#define MFMA32(a, b, c) __builtin_amdgcn_mfma_f32_32x32x16_bf16((a), (b), (c), 0, 0, 0)
__device__ __forceinline__ float xhalf_max(float v) { auto rr = __builtin_amdgcn_permlane32_swap(__builtin_bit_cast(unsigned, v), __builtin_bit_cast(unsigned, v), false, false);
    return fmaxf(__builtin_bit_cast(float, (unsigned)rr[0]), __builtin_bit_cast(float, (unsigned)rr[1])); }
__device__ __forceinline__ float xhalf_sum(float v) { auto rr = __builtin_amdgcn_permlane32_swap(__builtin_bit_cast(unsigned, v), __builtin_bit_cast(unsigned, v), false, false);
    return __builtin_bit_cast(float, (unsigned)rr[0]) + __builtin_bit_cast(float, (unsigned)rr[1]); }
__device__ __forceinline__ void glds16(const void* gsrc, unsigned lds_dst) { unsigned keep;
    asm volatile("s_mov_b32 %0, m0\n\ts_mov_b32 m0, %2\n\ts_nop 0\n\tglobal_load_lds_dwordx4 %1, off\n\ts_mov_b32 m0, %0" : "=&s"(keep) : "v"(gsrc), "s"(lds_dst) : "memory"); }
__device__ __forceinline__ s16x4 vtr(const LAS unsigned char* p) { return __builtin_bit_cast(s16x4, __builtin_amdgcn_ds_read_tr16_b64_v4i16((LAS s16x4*)p)); }

template <int DQK, int DV, int MODE, int OMODE, int SKEW, int QMODE = 0>
__device__ __forceinline__ void attn_unit(LAS unsigned char* lds, int wave, int lane,
                                          const bf16_t* Qw, int qpitch, const bf16_t* Kb, int kpitch, const bf16_t* Vb, int vpitch,
                                          void* Ow, int opitch, int q0, int jt0, int jt1, float m_init, float l_init, const LAS float* biasw, const float* gainw, float* ssw) {
    using C = ACfg<DQK, DV>;
    constexpr float THR = 8.f;
    const int r = lane & 31, h = lane >> 5;
    unsigned goff[C::NI]; int lq[C::NI]; unsigned vmask = 0u;
#pragma unroll
    for (int i = 0; i < C::NI; ++i) { int q = wave + 8 * i; if (q >= C::NQI) q -= 8; lq[i] = q;
        if (q < C::SK) { const int g = q * 64 + lane, row = g / C::SK; int cc = g % C::SK; cc = cc < DQK / 8 ? cc : DQK / 8 - 1; goff[i] = (unsigned)(row * kpitch + cc * 8) * 2u; }
        else { const int g = (q - C::SK) * 64 + lane, row = g / C::SV; int cc = g % C::SV; cc = cc < DV / 8 ? cc : DV / 8 - 1; goff[i] = (unsigned)(row * vpitch + cc * 8) * 2u; vmask |= 1u << i; } }
#define ATT_DMA(jt_, st_) do { const int jc_ = (jt_) < jt1 ? (jt_) : jt1 - 1; \
        const char* kt_ = (const char*)Kb + (size_t)jc_ * 64 * kpitch * 2; const char* vt_ = (const char*)Vb + (size_t)jc_ * 64 * vpitch * 2; \
        _Pragma("unroll") for (int i = 0; i < C::NI; ++i) { const char* b_ = ((vmask >> i) & 1u) ? vt_ : kt_; \
            glds16(b_ + goff[i], ldsbase + (unsigned)((st_) * C::STAGE + lq[i] * 1024)); } } while (0)
    const unsigned ldsbase = (unsigned)(size_t)lds;
    __syncthreads();
    ATT_DMA(jt0, 0); ATT_DMA(jt0 + 1, 1);
    bf16x8 qf[DQK / 16];
#pragma unroll
    for (int ks = 0; ks < DQK / 16; ++ks) qf[ks] = *(const bf16x8*)(Qw + (size_t)r * qpitch + ks * 16 + h * 8);
    if (QMODE == 1) {
        constexpr size_t QPART = (size_t)M * 512;
        f32x4 qa[DQK / 16][2]; float ssq = 0.f;
#pragma unroll
        for (int ks = 0; ks < DQK / 16; ++ks) { u32x4 w = __builtin_bit_cast(u32x4, qf[ks]); f32x4 a0 = bf4_to_f32((u32x2){w.x, w.y}), a1 = bf4_to_f32((u32x2){w.z, w.w});
#pragma unroll
            for (int p = 1; p < 4; ++p) { w = *(const u32x4*)(Qw + p * QPART + (size_t)r * qpitch + ks * 16 + h * 8); a0 += bf4_to_f32((u32x2){w.x, w.y}); a1 += bf4_to_f32((u32x2){w.z, w.w}); }
            qa[ks][0] = a0; qa[ks][1] = a1; ssq += sq4(a0) + sq4(a1); }
        ssq = xhalf_sum(ssq);
        const float rs = rsq(ssq * (1.f / DQK) + EPS) * (rsq((float)DQK) * LOG2E);
#pragma unroll
        for (int ks = 0; ks < DQK / 16; ++ks) { const f32x4 x0 = qa[ks][0] * rs * *(const f32x4*)(gainw + ks * 16 + h * 8), x1 = qa[ks][1] * rs * *(const f32x4*)(gainw + ks * 16 + h * 8 + 4);
            u32x4 w; w.x = cvtpk(x0[0], x0[1]); w.y = cvtpk(x0[2], x0[3]); w.z = cvtpk(x1[0], x1[1]); w.w = cvtpk(x1[2], x1[3]); qf[ks] = __builtin_bit_cast(bf16x8, w); }
    }
#pragma unroll
    for (int ks = 0; ks < DQK / 16; ++ks) asm volatile("" : "+v"(qf[ks]));
    f32x16 O[DV / 32];
#pragma unroll
    for (int d = 0; d < DV / 32; ++d)
#pragma unroll
        for (int i = 0; i < 16; ++i) O[d][i] = 0.f;
    float m = m_init, l = (h == 0) ? l_init : 0.f;
    int st = 0;
    for (int jt = jt0; jt < jt1; ++jt) {
        asm volatile("s_waitcnt vmcnt(%0) lgkmcnt(0)" :: "n"(C::NI) : "memory");
        __builtin_amdgcn_s_barrier();
        asm volatile("" ::: "memory");
        { const int st2 = st + 2 >= 3 ? st - 1 : st + 2; ATT_DMA(jt + 2, st2); }
        if (SKEW > 0 && wave >= 4) __builtin_amdgcn_s_sleep(SKEW);
        const bool active = (MODE == 1) ? (jt * 64 <= q0 + 31) : true;
        if (active) {
            const LAS unsigned char* kb_ = lds + st * C::STAGE; const LAS unsigned char* vb_ = kb_ + C::KT;
            const int qpos = q0 + r;
#pragma unroll 1
            for (int kb = 0; kb < 2; ++kb) {
                if (MODE == 1 && jt * 64 + 32 * kb > q0 + 31) break;
                f32x16 S;
#pragma unroll
                for (int i = 0; i < 16; ++i) S[i] = 0.f;
                const LAS unsigned char* kp = kb_ + (32 * kb + r) * C::PK + h * 16;
                {
                    constexpr int NKS = DQK / 16, KW = NKS < 8 ? NKS : 8;
                    bf16x8 kf[KW];
#pragma unroll
                    for (int ks = 0; ks < KW; ++ks) kf[ks] = *(const LAS bf16x8*)(kp + ks * 32);
                    __builtin_amdgcn_sched_barrier(0);
#pragma unroll
                    for (int ks = 0; ks < NKS; ++ks) { S = MFMA32(kf[ks % KW], qf[ks], S);
                        if (ks + KW < NKS) { kf[ks % KW] = *(const LAS bf16x8*)(kp + (ks + KW) * 32); __builtin_amdgcn_sched_barrier(0); } }
                }
                const int kbase = jt * 64 + 32 * kb + 4 * h;
                if (MODE == 1) {
                    if (kbase - 4 * h + 31 > q0) {
#pragma unroll
                        for (int i = 0; i < 16; ++i) { const int key = kbase + (i & 3) + 8 * (i >> 2); if (key > qpos) S[i] = NEGBIG; }
                    }
                }
                if (MODE == 2) {
                    float bv[16];
#pragma unroll
                    for (int i = 0; i < 16; ++i) bv[i] = biasw[(qpos - (kbase + (i & 3) + 8 * (i >> 2))) & 127];
                    asm volatile("" : "+v"(bv[0]), "+v"(bv[1]), "+v"(bv[2]), "+v"(bv[3]), "+v"(bv[4]), "+v"(bv[5]), "+v"(bv[6]), "+v"(bv[7]),
                                      "+v"(bv[8]), "+v"(bv[9]), "+v"(bv[10]), "+v"(bv[11]), "+v"(bv[12]), "+v"(bv[13]), "+v"(bv[14]), "+v"(bv[15]));
#pragma unroll
                    for (int i = 0; i < 16; ++i) { const int d0 = qpos - (kbase + (i & 3) + 8 * (i >> 2));
                        S[i] = ((unsigned)d0 < 128u) ? S[i] + bv[i] : NEGBIG; }
                }
                float mx = S[0];
#pragma unroll
                for (int i = 1; i < 16; ++i) mx = fmaxf(mx, S[i]);
                mx = xhalf_max(mx);
                if (__any(mx > m + THR)) {
                    const float mn = fmaxf(m, mx); const float alpha = fast_exp2(m - mn); m = mn; l *= alpha;
#pragma unroll
                    for (int d = 0; d < DV / 32; ++d)
#pragma unroll
                        for (int i = 0; i < 16; ++i) O[d][i] *= alpha;
                }
                float ps = 0.f;
#pragma unroll
                for (int i = 0; i < 16; ++i) { S[i] = fast_exp2(S[i] - m); ps += S[i]; }
                l += ps;
                bf16x8 pf[2];
#pragma unroll
                for (int t = 0; t < 2; ++t) { u32x4 w; const int o = 8 * t;
                    w.x = cvtpk(S[o], S[o + 1]); w.y = cvtpk(S[o + 2], S[o + 3]); w.z = cvtpk(S[o + 4], S[o + 5]); w.w = cvtpk(S[o + 6], S[o + 7]);
                    pf[t] = __builtin_bit_cast(bf16x8, w); }
                const LAS unsigned char* vp = vb_ + (32 * kb + 4 * h + ((lane & 15) >> 2)) * C::PV + ((lane >> 4) & 1) * 32 + (lane & 3) * 8;
#pragma unroll
                for (int d = 0; d < DV / 32; ++d)
#pragma unroll
                    for (int t = 0; t < 2; ++t) { const s16x4 lo = vtr(vp + t * 16 * C::PV + d * 64), hi = vtr(vp + t * 16 * C::PV + 8 * C::PV + d * 64);
                        const bf16x8 vf = {lo.x, lo.y, lo.z, lo.w, hi.x, hi.y, hi.z, hi.w};
                        O[d] = MFMA32(vf, pf[t], O[d]); }
            }
        }
        st = st + 1 >= 3 ? 0 : st + 1;
    }
#undef ATT_DMA
    l = xhalf_sum(l);
    const float inv = 1.0f / l;
    float ssq = 0.f;
#pragma unroll
    for (int d = 0; d < DV / 32; ++d)
#pragma unroll
        for (int tq = 0; tq < 4; ++tq) { const int dv = 32 * d + 8 * tq + 4 * h;
            const f32x4 o = (f32x4){O[d][4 * tq], O[d][4 * tq + 1], O[d][4 * tq + 2], O[d][4 * tq + 3]} * inv;
            if (OMODE == 2) { ssq += sq4(o); *(u32x2*)((bf16_t*)Ow + (size_t)r * opitch + dv) = pack4(o); }
            else if (OMODE == 1) *(u32x2*)((bf16_t*)Ow + (size_t)r * opitch + dv) = pack4(o);
            else *(f32x4*)((float*)Ow + (size_t)r * opitch + dv) = o; }
    if (OMODE == 2) { ssq = xhalf_sum(ssq); if (h == 0) ssw[(size_t)r * 64] = ssq; }
}


__device__ __forceinline__ void swa_unit128(LAS unsigned char* lds, int wave, int lane, int tid, const bf16_t* QSb  , const bf16_t* Kb, const bf16_t* Vb,
                                            bf16_t* Ob  , float* ssb  , int q0u,
                                            const float* biasg  , const float* sinks8  , LAS float* biasL) {
    using C = ACfg<SWA_D, SWA_D>;
    constexpr float THR = 8.f;
    const int r = lane & 31, h = lane >> 5;
    const int tbase = q0u / 64 - 2;
    unsigned goff[C::NI]; int lq[C::NI]; unsigned vmask = 0u;
#pragma unroll
    for (int i = 0; i < C::NI; ++i) { int q = wave + 8 * i; if (q >= C::NQI) q -= 8; lq[i] = q;
        if (q < C::SK) { const int g = q * 64 + lane, row = g / C::SK; int cc = g % C::SK; cc = cc < SWA_D / 8 ? cc : SWA_D / 8 - 1; goff[i] = (unsigned)(row * SWAKW + cc * 8) * 2u; }
        else { const int g = (q - C::SK) * 64 + lane, row = g / C::SV; int cc = g % C::SV; cc = cc < SWA_D / 8 ? cc : SWA_D / 8 - 1; goff[i] = (unsigned)(row * SWAKW + cc * 8) * 2u; vmask |= 1u << i; } }
    const unsigned ldsbase = (unsigned)(size_t)lds;
    __syncthreads();
#pragma unroll
    for (int ti = 0; ti < 4; ++ti) { const int jt = tbase + ti;
        if (jt >= 0) { const char* kt_ = (const char*)Kb + (size_t)jt * 64 * SWAKW * 2; const char* vt_ = (const char*)Vb + (size_t)jt * 64 * SWAKW * 2;
#pragma unroll
            for (int i = 0; i < C::NI; ++i) { const char* b_ = ((vmask >> i) & 1u) ? vt_ : kt_; glds16(b_ + goff[i], ldsbase + (unsigned)(ti * C::STAGE + lq[i] * 1024)); } } }
    for (int i = tid; i < 1024; i += 512) biasL[i] = biasg[i];
    const int sblk = wave & 3, hgrp = wave >> 2; const int q0 = q0u + 32 * sblk, qpos = q0 + r;
    bf16x8 qf[4][4];
#pragma unroll
    for (int hi = 0; hi < 4; ++hi)
#pragma unroll
        for (int ks = 0; ks < 4; ++ks) qf[hi][ks] = *(const bf16x8*)(QSb + (size_t)qpos * SWAW + (hgrp * 4 + hi) * SWA_D + ks * 16 + h * 8);
    float sk[4];
#pragma unroll
    for (int hi = 0; hi < 4; ++hi) sk[hi] = sinks8[hgrp * 4 + hi] * LOG2E;
#pragma unroll
    for (int hi = 0; hi < 4; ++hi)
#pragma unroll
        for (int ks = 0; ks < 4; ++ks) asm volatile("" : "+v"(qf[hi][ks]));
    asm volatile("s_waitcnt vmcnt(0) lgkmcnt(0)" ::: "memory");
    __syncthreads();
    const int jt0 = (q0 < 127) ? 0 : ((q0 - 127) >> 6), jt1 = ((q0 + 31) >> 6) + 1;
#pragma unroll 1
    for (int hi = 0; hi < 4; ++hi) {
        const LAS float* biasw = biasL + (hgrp * 4 + hi) * 128;
        bf16x8 q4[4];
#pragma unroll
        for (int ks = 0; ks < 4; ++ks) q4[ks] = (hi == 0) ? qf[0][ks] : (hi == 1) ? qf[1][ks] : (hi == 2) ? qf[2][ks] : qf[3][ks];
        float m = (hi == 0) ? sk[0] : (hi == 1) ? sk[1] : (hi == 2) ? sk[2] : sk[3];
        float l = (h == 0) ? 1.f : 0.f;
        f32x16 O[2];
#pragma unroll
        for (int d = 0; d < 2; ++d)
#pragma unroll
            for (int i = 0; i < 16; ++i) O[d][i] = 0.f;
#pragma unroll 1
        for (int jt = jt0; jt < jt1; ++jt) {
            const LAS unsigned char* kb_ = lds + (jt - tbase) * C::STAGE; const LAS unsigned char* vb_ = kb_ + C::KT;
#pragma unroll 1
            for (int kb = 0; kb < 2; ++kb) {
                f32x16 S;
#pragma unroll
                for (int i = 0; i < 16; ++i) S[i] = 0.f;
                const LAS unsigned char* kp = kb_ + (32 * kb + r) * C::PK + h * 16;
                bf16x8 kf[4];
#pragma unroll
                for (int ks = 0; ks < 4; ++ks) kf[ks] = *(const LAS bf16x8*)(kp + ks * 32);
                const int kbase = jt * 64 + 32 * kb + 4 * h;
                float bv[16];
#pragma unroll
                for (int i = 0; i < 16; ++i) bv[i] = biasw[(qpos - (kbase + (i & 3) + 8 * (i >> 2))) & 127];
#pragma unroll
                for (int ks = 0; ks < 4; ++ks) S = MFMA32(kf[ks], q4[ks], S);
                asm volatile("" : "+v"(bv[0]), "+v"(bv[1]), "+v"(bv[2]), "+v"(bv[3]), "+v"(bv[4]), "+v"(bv[5]), "+v"(bv[6]), "+v"(bv[7]),
                                  "+v"(bv[8]), "+v"(bv[9]), "+v"(bv[10]), "+v"(bv[11]), "+v"(bv[12]), "+v"(bv[13]), "+v"(bv[14]), "+v"(bv[15]));
#pragma unroll
                for (int i = 0; i < 16; ++i) { const int d0 = qpos - (kbase + (i & 3) + 8 * (i >> 2)); S[i] = ((unsigned)d0 < 128u) ? S[i] + bv[i] : NEGBIG; }
                float mx = S[0];
#pragma unroll
                for (int i = 1; i < 16; ++i) mx = fmaxf(mx, S[i]);
                mx = xhalf_max(mx);
                if (__any(mx > m + THR)) { const float mn = fmaxf(m, mx); const float alpha = fast_exp2(m - mn); m = mn; l *= alpha;
#pragma unroll
                    for (int d = 0; d < 2; ++d)
#pragma unroll
                        for (int i = 0; i < 16; ++i) O[d][i] *= alpha; }
                float ps = 0.f;
#pragma unroll
                for (int i = 0; i < 16; ++i) { S[i] = fast_exp2(S[i] - m); ps += S[i]; }
                l += ps;
                bf16x8 pf[2];
#pragma unroll
                for (int t = 0; t < 2; ++t) { u32x4 w; const int o = 8 * t;
                    w.x = cvtpk(S[o], S[o + 1]); w.y = cvtpk(S[o + 2], S[o + 3]); w.z = cvtpk(S[o + 4], S[o + 5]); w.w = cvtpk(S[o + 6], S[o + 7]);
                    pf[t] = __builtin_bit_cast(bf16x8, w); }
                const LAS unsigned char* vp = vb_ + (32 * kb + 4 * h + ((lane & 15) >> 2)) * C::PV + ((lane >> 4) & 1) * 32 + (lane & 3) * 8;
#pragma unroll
                for (int d = 0; d < 2; ++d)
#pragma unroll
                    for (int t = 0; t < 2; ++t) { const s16x4 lo = vtr(vp + t * 16 * C::PV + d * 64), hi2 = vtr(vp + t * 16 * C::PV + 8 * C::PV + d * 64);
                        const bf16x8 vf = {lo.x, lo.y, lo.z, lo.w, hi2.x, hi2.y, hi2.z, hi2.w};
                        O[d] = MFMA32(vf, pf[t], O[d]); }
            }
        }
        l = xhalf_sum(l);
        const float inv = 1.0f / l; float ssq = 0.f;
        bf16_t* Ow = Ob + (size_t)qpos * D + (hgrp * 4 + hi) * SWA_D;
#pragma unroll
        for (int d = 0; d < 2; ++d)
#pragma unroll
            for (int tq = 0; tq < 4; ++tq) { const int dv = 32 * d + 8 * tq + 4 * h;
                const f32x4 o = (f32x4){O[d][4 * tq], O[d][4 * tq + 1], O[d][4 * tq + 2], O[d][4 * tq + 3]} * inv;
                ssq += sq4(o); *(u32x2*)(Ow + dv) = pack4(o); }
        ssq = xhalf_sum(ssq); if (h == 0) ssb[(size_t)qpos * 64 + hgrp * 4 + hi] = ssq;
    }
}

constexpr int NPHASE = 19;
struct Args { const float* in[32]; float* out; unsigned char* ws; int ph_lo, ph_hi; };
static_assert(sizeof(Args) == 32 * 8 + 8 + 8 + 8, "Args has no padding");

__device__ __forceinline__ const float* karg(int k) {
    const __attribute__((address_space(4))) char* kp = (const __attribute__((address_space(4))) char*)__builtin_amdgcn_kernarg_segment_ptr();
    return *(const float* const volatile __attribute__((address_space(4)))*)(kp + 8 * k);
}
constexpr int SC_GU = 86 * 8, SC_D = 16 * 43, SC_IN = 16 * 8, SC_UQ = 12 * 7, SC_KN = 8, SC_OUT = 16 * 8, SC_MQ = 2 * 8, SC_MKV = 4 * 8, SC_MO = 16;
constexpr int SC_A_END = SC_GU + SC_D + SC_IN + SC_UQ + 2 * SC_KN + SC_OUT + SC_MQ + SC_MKV + SC_MO;
constexpr int NSC = SC_A_END + SC_GU + SC_D;
constexpr int SC_LATE = SC_GU + SC_D;
constexpr int NSC_EARLY = NSC - SC_LATE;
__device__ __forceinline__ void sc_decode(XItem& X, int& KGS, int& KB0, int sci, int wave, unsigned char* ws) {
    X.f8scale = 0.f;
    int r = (sci >= SC_A_END) ? sci : (sci < SC_A_END - SC_GU ? sci + SC_GU : sci - (SC_A_END - SC_GU));
    if (r >= SC_A_END) {
        r -= SC_A_END;
        if (r < SC_GU) { const int nbg = r >> 3, kbg = r & 7; const int nb = nbg * 8 + wave; KGS = 8; KB0 = kbg * 8;
            X.src = (wave >> 2) ? karg(30) : karg(29); X.gain = karg(28); X.srcN = FF; X.col0 = 128 * nbg + 32 * (wave & 3); X.K = D; X.dst = (bf16_t*)(ws + WS_WGU_B); X.row0 = 32 * nb; return; }
        r -= SC_GU;
        { const int nbg = r / 43, kbg = r % 43; const int nb = nbg * 8 + wave; KGS = 4; KB0 = kbg * 4;
            X.src = karg(31); X.gain = nullptr; X.f8scale = F8_B ? F8_SW : 0.f; X.srcN = D; X.col0 = 32 * nb; X.K = FF; X.dst = (bf16_t*)(ws + WS_WD_B); X.row0 = 32 * nb; return; }
    }
    if (r < SC_GU) { const int nbg = r >> 3, kbg = r & 7; const int nb = nbg * 8 + wave; KGS = 8; KB0 = kbg * 8;
        X.src = (wave >> 2) ? karg(5) : karg(4); X.gain = karg(3); X.srcN = FF; X.col0 = 128 * nbg + 32 * (wave & 3); X.K = D; X.dst = (bf16_t*)(ws + WS_WGU_A); X.row0 = 32 * nb; return; }
    r -= SC_GU;
    if (r < SC_D) { const int nbg = r / 43, kbg = r % 43; const int nb = nbg * 8 + wave; KGS = 4; KB0 = kbg * 4;
        X.src = karg(6); X.gain = nullptr; X.f8scale = F8_A ? F8_SW : 0.f; X.srcN = D; X.col0 = 32 * nb; X.K = FF; X.dst = (bf16_t*)(ws + WS_WD_A); X.row0 = 32 * nb; return; }
    r -= SC_D;
    if (r < SC_IN) { const int nbg = r >> 3, kbg = r & 7; const int nb = nbg * 8 + wave; KGS = 8; KB0 = kbg * 8;
        const int tile = nb >> 3, bj = (nb >> 2) & 1, wc_ = nb & 3; int c0;
        if (tile < 3) c0 = 32 * nb;
        else if (tile == 3) c0 = (wc_ < 2) ? 768 + 64 * wc_ + 32 * bj : (wc_ == 2 ? 1408 + 32 * bj : -1);
        else if (tile < 6) c0 = 896 + 32 * (nb - 32);
        else if (tile < 14) c0 = 1472 + (4 * (tile - 6) + wc_) * 64 + 32 * bj;
        else if (tile == 14) c0 = 3520 + wc_ * 64 + 32 * bj;
        else c0 = 3776 + wc_ * 64 + 32 * bj;
        X.src = karg(8); X.gain = karg(7); X.srcN = INW; X.col0 = c0; X.K = D; X.dst = (bf16_t*)(ws + WS_WIN); X.row0 = 32 * nb; return; }
    r -= SC_IN;
    if (r < SC_UQ) { const int nbg = r / 7, kbg = r % 7; const int nb = nbg * 8 + wave; KGS = 2; KB0 = kbg * 2;
        X.src = karg(11); X.gain = karg(9); X.srcN = NQ; X.col0 = 32 * nb; X.K = CQ; X.dst = (bf16_t*)(ws + WS_WUQ); X.row0 = 32 * nb; return; }
    r -= SC_UQ;
    if (r < 2 * SC_KN) { const int wv = r >= SC_KN; if (wv) r -= SC_KN; const int nb = r * 8 + wave; KGS = 8; KB0 = 0;
        X.src = karg(12); X.gain = karg(10); X.srcN = 4096; X.col0 = (nb >> 2) * 256 + wv * 128 + 32 * (nb & 3); X.K = CKV; X.dst = (bf16_t*)(ws + (wv ? WS_WV : WS_WKN)); X.row0 = 32 * nb; return; }
    r -= 2 * SC_KN;
    if (r < SC_OUT) { const int nbg = r >> 3, kbg = r & 7; const int nb = nbg * 8 + wave; KGS = 8; KB0 = kbg * 8;
        X.src = karg(20); X.gain = (KB0 * 64 < NV) ? karg(18) : karg(19) - NV; X.srcN = D; X.col0 = 32 * nb; X.K = D; X.dst = (bf16_t*)(ws + WS_WOUT); X.row0 = 32 * nb; return; }
    r -= SC_OUT;
    if (r < SC_MQ) { const int nbg = r >> 3, kbg = r & 7; const int nb = nbg * 8 + wave; KGS = 8; KB0 = kbg * 8;
        X.src = karg(23); X.gain = karg(21); X.srcN = 512; X.col0 = 32 * nb; X.K = D; X.dst = (bf16_t*)(ws + WS_WMQ); X.row0 = 32 * nb; return; }
    r -= SC_MQ;
    if (r < SC_MKV) { const int nbg = r >> 3, kbg = r & 7; const int nb = nbg * 8 + wave; KGS = 8; KB0 = kbg * 8;
        X.src = karg(24); X.gain = nullptr; X.srcN = 1024; X.col0 = 32 * nb; X.K = D; X.dst = (bf16_t*)(ws + WS_WMKV); X.row0 = 32 * nb; return; }
    r -= SC_MKV;
    { const int nb = r * 8 + wave; KGS = 8; KB0 = 0;
        X.src = karg(27); X.gain = nullptr; X.srcN = D; X.col0 = 32 * nb; X.K = 512; X.dst = (bf16_t*)(ws + WS_WMO); X.row0 = 32 * nb; }
}
__device__ __forceinline__ void convert_subchunks(unsigned char* ws, int wave, int lane, int sc0, int sc_end, int stride) {
    int sc = sc0, j = 0, kgs = 1, kb0 = 0, nkgs = 1, nkb0 = 0; XItem cur, nx; f32x4 v[8], vn[8], gk[2], gkn[2];
    cur.src = nullptr; cur.gain = nullptr; cur.dst = nullptr; cur.srcN = 0; cur.col0 = -1; cur.K = 0; cur.row0 = 0; cur.k0 = 0; cur.f8scale = 0.f; nx = cur;
    if (sc < sc_end) { sc_decode(cur, kgs, kb0, sc, wave, ws); cur.k0 = 64 * kb0; xi_load(cur, v, gk, lane); }
    while (sc < sc_end) {
        int nsc = sc, nj = j + 1; nx = cur; nkgs = kgs; nkb0 = kb0;
        if (nj == kgs) { nsc = sc + stride; nj = 0; if (nsc < sc_end) sc_decode(nx, nkgs, nkb0, nsc, wave, ws); }
        if (nsc < sc_end) { nx.k0 = 64 * (nkb0 + nj); xi_load(nx, vn, gkn, lane); }
        xi_store(cur, v, gk, lane);
#pragma unroll
        for (int i = 0; i < 8; ++i) v[i] = vn[i];
        gk[0] = gkn[0]; gk[1] = gkn[1];
        cur = nx; sc = nsc; j = nj; kgs = nkgs; kb0 = nkb0;
    }
}
__device__ __forceinline__ void convert_claimed(unsigned char* ws, int wave, int lane, int tid, gu32* ctr, volatile LAS unsigned* slot, int first, int end, int per_claim = 2, int max_claims = 1 << 30) {
    for (int n = 0; n < max_claims; ++n) {
        __syncthreads();
        if (tid == 0) *slot = (unsigned)first + (unsigned)per_claim * __hip_atomic_fetch_add(ctr, 1u, RLX_AGENT);
        __syncthreads();
        const int sc = (int)__builtin_amdgcn_readfirstlane(*slot);
        if (sc >= end) break;
        convert_subchunks(ws, wave, lane, sc, (sc + per_claim < end) ? sc + per_claim : end, 1);
    }
}
__global__ void __launch_bounds__(NWAVES * 64, 2) fwd_kernel(Args args) {
    extern __shared__ __attribute__((aligned(16))) unsigned char lds_raw[];
    LAS unsigned char* lds = (LAS unsigned char*)lds_raw;
    volatile LAS unsigned* MISC = (volatile LAS unsigned*)(lds + MISC_OFF);
    const int tid = threadIdx.x, lane = tid & 63, wave = __builtin_amdgcn_readfirstlane(tid >> 6);
    const int G = gridDim.x; const int bx = blockIdx.x; const int vcu = (G % 8 == 0) ? (bx % 8) * (G / 8) + bx / 8 : bx;
    const int gw = vcu * NWAVES + wave, NGW = G * NWAVES;
    unsigned char* ws = args.ws;
    gu32* ctl = (gu32*)(ws + WS_CTL);
    for (int u = tid; u < (LDS_BYTES - MISC_OFF) / 4; u += NWAVES * 64) ((LAS unsigned*)(lds + MISC_OFF))[u] = 0u;
    __syncthreads();
    XcdBarrier bar; bar.bar = (unsigned*)(ctl + CW_BAR); bar.x = 0; bar.st = nullptr;
    if (MK_N_LAUNCHES == 1) bar = xcd_barrier_post((unsigned*)(ctl + CW_BAR), MISC + 8);
    const int lo = args.ph_lo, hi = args.ph_hi;
#ifndef ONLYP
#define ONLYP -1
#endif
#define IN(k) ((ONLYP < 0 || ONLYP == (k)) && lo <= (k) && (k) < hi)
#ifndef PROBE_A
#define PROBE_A -1
#define PROBE_B -1
#define PROBE_MULT 0
#endif
#ifndef PROBE_CYC
#define PROBE_CYC 0
#endif
#define STAMP(k) do { if (PROBE_A >= 0 && bx == 0 && tid == 0) { const unsigned long long t_ = PROBE_CYC ? __builtin_amdgcn_s_memtime() : __builtin_amdgcn_s_memrealtime(); MISC[16 + 2 * (k)] = (unsigned)t_; MISC[17 + 2 * (k)] = (unsigned)(t_ >> 32); } } while (0)
#define SEAM(k) do { if (IN(k) && IN((k) + 1)) xcd_barrier(bar); STAMP((k) + 1); } while (0)
#ifndef DUPP
#define DUPP -1
#endif
#define REP(k) for (int rep_ = 0; rep_ < ((DUPP == (k)) ? 2 : 1); ++rep_)

    STAMP(0);
    const float* x = karg(0); const float* mem = karg(1); const float* rel_bias = karg(2);
    float* out = args.out;
    bf16_t* XN = (bf16_t*)(ws + WS_XN); bf16_t* ACT = (bf16_t*)(ws + WS_ACT);
    bf16_t* U = (bf16_t*)(ws + WS_U); bf16_t* QRAW = (bf16_t*)(ws + WS_QRAW); bf16_t* KNRAW = (bf16_t*)(ws + WS_KNRAW); bf16_t* HB = (bf16_t*)(ws + WS_HB); float* OB = (float*)(ws + WS_O); float* QMP = (float*)(ws + WS_QMP);
    bf16_t* QF = (bf16_t*)(ws + WS_QF); bf16_t* KF = (bf16_t*)(ws + WS_KF); bf16_t* VF = (bf16_t*)(ws + WS_VF);
    bf16_t* QS = (bf16_t*)(ws + WS_QS); bf16_t* KS = (bf16_t*)(ws + WS_KS); bf16_t* VS = (bf16_t*)(ws + WS_VS);
    bf16_t* CQN = (bf16_t*)(ws + WS_CQN); bf16_t* CKVN = (bf16_t*)(ws + WS_CKVN); float* KRB = (float*)(ws + WS_KRB);
    bf16_t* MEMN = (bf16_t*)(ws + WS_MEMN); float* KVM = (float*)(ws + WS_KVM); bf16_t* KM = (bf16_t*)(ws + WS_KM); bf16_t* VM = (bf16_t*)(ws + WS_VM);
    bf16_t* QM = (bf16_t*)(ws + WS_QM); bf16_t* OM = (bf16_t*)(ws + WS_OM);
    float* ROPE = (float*)(ws + WS_ROPE); float* BIAS = (float*)(ws + WS_BIAS);
    float* SS0 = (float*)(ws + WS_XN2);
    float* SSCQ = (float*)(ws + WS_XN2 + 2 * MiB); float* SSCKV = (float*)(ws + WS_XN2 + 4 * MiB);
    float* SS1 = (float*)(ws + WS_SS1); float* SS2 = (float*)(ws + WS_SS2); float* SS3 = (float*)(ws + WS_SS3); float* SSO = (float*)(ws + WS_SSO);
    const pg8::RowTab RT_NONE{nullptr, 0};
    LAS float* tabA = (LAS float*)(lds + TAB_OFF); LAS float* tabB = tabA + 1024;

    REP(0) if (IN(0)) {
        convert_subchunks(ws, wave, lane, SC_D + bx, NSC_EARLY, G);
        for (int row = gw; row < M; row += NGW) {
            const f32x4* xr = (const f32x4*)(x + (size_t)row * D) + lane; f32x4 v[16]; float sq = 0.f;
#pragma unroll
            for (int j = 0; j < 16; ++j) { v[j] = xr[64 * j]; sq += sq4(v[j]); }
            sq = wave_sum(sq);
            u32x2* o8 = (u32x2*)(XN + (size_t)row * D) + lane;
#pragma unroll
            for (int j = 0; j < 16; ++j) o8[64 * j] = pack4(v[j]);
            if (lane < 4) SS0[(size_t)row * 64 + lane] = (lane == 0) ? sq : 0.f; }
        for (int row = gw; row < MROWS; row += NGW) rms_row4096(mem + (size_t)row * D, karg(22), MEMN + (size_t)row * D, lane);
        for (int i = gw * 64 + lane; i < SEQ * 32; i += NGW * 64) { const int pos = i >> 5, j = i & 31;
            const float inv = exp2f(-(float)j * (13.287712379549449f / 32.f)); const float ang = (float)pos * inv;
            ROPE[2 * i] = cosf(ang); ROPE[2 * i + 1] = sinf(ang); }
        for (int i = gw * 64 + lane; i < SWA_H * 128; i += NGW * 64) { const int hh = i >> 7, d = i & 127;
            int bk = d; if (d >= 16) { bk = 16 + (int)(logf((float)d / 16.f) / 2.0794415416798357f * 16.f); if (bk > 31) bk = 31; }
            BIAS[i] = rel_bias[bk * SWA_H + hh] * LOG2E; }
    }
    SEAM(0);

    if (IN(1)) {
        { pg8::Gemm g{XN, (const bf16_t*)(ws + WS_WGU_A), D, D, D}; pg8::StaticOrder S; S.init(M, 2 * FF, G, bx);
          pg8::Unit u0; int rb = 0; if (S.next(0, u0)) { rb = (u0.pm >> 2) * 1024; pg8::build_rstd_tab(tabA, SS0, rb, 0, 4, 1.f / D, tid); }
          pg8::EpiSwiGLU E{ACT, FF, pg8::RowTab{tabA, rb}, F8_A}; pg8::gemm_phase<pg8::EpiSwiGLU, pg8::StaticOrder, true>(lds, g, S, E);
          if (DUPP == 1) pg8::gemm_phase<pg8::EpiSwiGLU, pg8::StaticOrder, true>(lds, g, S, E);
          if (DUPP == 101) { pg8::Gemm g2{XN, (const bf16_t*)(ws + WS_WGU_A), 0, 0, D}; pg8::EpiSwiGLU E2{(bf16_t*)(ws + WS_QF), 0, RT_NONE};
              pg8::gemm_phase<pg8::EpiSwiGLU, pg8::StaticOrder, true>(lds, g2, S, E2); } }
        { pg8::Gemm g{MEMN, (const bf16_t*)(ws + WS_WMKV), D, D, D}; pg8::OffsetOrder S; S.init(MROWS / 256, 1024 / 256, 1, G, bx, 192 % G);
          pg8::EpiF32 E{KVM, 1024, 0, RT_NONE}; pg8::gemm_phase<pg8::EpiF32, pg8::OffsetOrder, true>(lds, g, S, E); }
        convert_claimed(ws, wave, lane, tid, ctl + CW_CONV, MISC + 12, 0, SC_D);

    }
    SEAM(1);
    if (IN(2)) {
        constexpr int KU = F8_A ? FF / 2 : FF;
        pg8::Gemm g{ACT, (const bf16_t*)(ws + WS_WD_A), KU, KU, KU}; pg8::StaticOrder S; S.init(M, D, G, bx);
        pg8::EpiResNorm<false, false> E{XN, HB, D, F8_A ? 0.5f / (F8_SA * F8_SW) : 0.5f, RT_NONE, RT_NONE, RT_NONE, SS1}; pg8::gemm_phase<pg8::EpiResNorm<false, false>, pg8::StaticOrder, true, F8_A>(lds, g, S, E);
    }
    SEAM(2);
    if (IN(4)) {
        pg8::Gemm g{HB, (const bf16_t*)(ws + WS_WIN), D, D, D}; pg8::StaticOrder S; S.init(M, D, G, bx);
        pg8::Unit u0; int rb = 0; if (S.next(0, u0)) { rb = (u0.pm >> 2) * 1024; pg8::build_rstd_tab(tabA, SS1, rb, 0, 64, 1.f / D, tid); }
        pg8::EpiIn E{pg8::RowTab{tabA, rb}, CQN, CKVN, QS, KS, VS, KRB, SSCQ, SSCKV, karg(15), karg(16)}; pg8::gemm_phase<pg8::EpiIn, pg8::StaticOrder, true>(lds, g, S, E);
    }
    SEAM(4);
    if (IN(6)) {
        { pg8::Gemm g{CQN, (const bf16_t*)(ws + WS_WUQ), CQ, CQ, CQ}; pg8::StaticOrder S; S.init(M, NQ, G, bx);
          pg8::Unit u0; int rb = 0; if (S.next(0, u0)) { rb = (u0.pm >> 2) * 1024; pg8::build_rstd_tab(tabA, SSCQ, rb, 0, 16, 1.f / CQ, tid); }
          pg8::EpiBf16 E{QRAW, NQ, pg8::RowTab{tabA, rb}, 0}; pg8::gemm_phase<pg8::EpiBf16, pg8::StaticOrder, true>(lds, g, S, E); }
        if (G == 256 && bx >= 128) convert_subchunks(ws, wave, lane, NSC_EARLY + SC_GU + (bx - 128), NSC_EARLY + SC_GU + 128, 128);
        static_assert(WS_WV == WS_WKN + (size_t)NKN * CKV * 2 && NKN == NV, "W_kn and W_v copies are adjacent: one [4096][512] weight");
        { pg8::Gemm g{CKVN, (const bf16_t*)(ws + WS_WKN), CKV, CKV, CKV}; pg8::StaticOrder S; S.init(M, NKN + NV, G, bx);
          pg8::Unit u0; int rbkv = 0; if (S.next(0, u0)) { rbkv = (u0.pm >> 2) * 1024; pg8::build_rstd_tab(tabB, SSCKV, rbkv, 0, 8, 1.f / CKV, tid); }
          pg8::EpiBf16 E{KNRAW, NKN, pg8::RowTab{tabB, rbkv}, 0, VF, NKN / 256}; pg8::gemm_phase<pg8::EpiBf16, pg8::StaticOrder, true>(lds, g, S, E); }
    }
    SEAM(6);
    REP(7) if (IN(7)) {
        const float* g_q = karg(13); const float* g_k = karg(14); const float* g_mk = karg(26);
        const int l16 = lane & 15, hg = lane >> 4;
        const float qscale = 0.07216878364870322f * LOG2E;
        const f32x4 gq0 = ((const f32x4*)g_q)[2 * l16], gq1 = ((const f32x4*)g_q)[2 * l16 + 1], gk0 = ((const f32x4*)g_k)[2 * l16], gk1 = ((const f32x4*)g_k)[2 * l16 + 1];
        f32x4 gqx1 = gq0, gqx2 = gq0, gkx1 = gk0, gkx2 = gk0;
        if (l16 < 8) { gqx1 = ((const f32x4*)g_q)[32 + l16]; gqx2 = ((const f32x4*)g_q)[40 + l16]; gkx1 = ((const f32x4*)g_k)[32 + l16]; gkx2 = ((const f32x4*)g_k)[40 + l16]; }
        const int lx = l16 < 8 ? l16 : 0;
        for (int row = gw; row < M; row += NGW) {
            const int pos = row & (SEQ - 1);
            const f32x4* rp = (const f32x4*)(ROPE + (size_t)pos * 64);
            const f32x4 cs0 = rp[2 * lx], cs1 = rp[2 * lx + 1];
            u32x2 qa0[4], qa1[4], qx1[4], qx2[4], ka0[4], ka1[4];
#pragma unroll
            for (int it = 0; it < 4; ++it) { const int hh = 4 * it + hg; const u32x2* qr = (const u32x2*)(QRAW + (size_t)row * NQ + hh * MLA_QK); const u32x2* kr = (const u32x2*)(KNRAW + (size_t)row * NKN + hh * MLA_NOPE);
                qa0[it] = qr[2 * l16]; qa1[it] = qr[2 * l16 + 1]; qx1[it] = qr[32 + lx]; qx2[it] = qr[40 + lx]; ka0[it] = kr[2 * l16]; ka1[it] = kr[2 * l16 + 1]; }
            f32x4 r1 = ((const f32x4*)(KRB + (size_t)row * KRD))[lx], r2 = ((const f32x4*)(KRB + (size_t)row * KRD))[8 + lx];
            const f32x4 co = (f32x4){cs0.x, cs0.z, cs1.x, cs1.z}, si = (f32x4){cs0.y, cs0.w, cs1.y, cs1.w};
#pragma unroll
            for (int it = 0; it < 4; ++it) { const int hh = 4 * it + hg;
                const f32x4 a0 = bf4_to_f32(qa0[it]), a1 = bf4_to_f32(qa1[it]); f32x4 x1 = (f32x4){0.f, 0.f, 0.f, 0.f}, x2 = x1;
                if (l16 < 8) { x1 = bf4_to_f32(qx1[it]); x2 = bf4_to_f32(qx2[it]); }
                const float rstd = rsq(g16_sum(sq4(a0) + sq4(a1) + sq4(x1) + sq4(x2)) * (1.f / MLA_QK) + EPS) * qscale;
                u32x2* qo = (u32x2*)(QF + (size_t)row * NQ + hh * MLA_QK);
                qo[2 * l16] = pack4(a0 * rstd * gq0); qo[2 * l16 + 1] = pack4(a1 * rstd * gq1);
                if (l16 < 8) { x1 = x1 * rstd * gqx1; x2 = x2 * rstd * gqx2;
                    qo[32 + l16] = pack4(x1 * co - x2 * si); qo[40 + l16] = pack4(x2 * co + x1 * si); } }
            { if (l16 >= 8) { r1 = (f32x4){0.f, 0.f, 0.f, 0.f}; r2 = r1; }
              const float ssr = g16_sum(sq4(r1) + sq4(r2));
              f32x4 y1 = r1, y2 = r2;
              if (l16 < 8) { r1 = r1 * gkx1; r2 = r2 * gkx2; y1 = r1 * co - r2 * si; y2 = r2 * co + r1 * si; }
#pragma unroll
              for (int it = 0; it < 4; ++it) { const int hh = 4 * it + hg;
                  const f32x4 a0 = bf4_to_f32(ka0[it]), a1 = bf4_to_f32(ka1[it]);
                  const float rstd = rsq((g16_sum(sq4(a0) + sq4(a1)) + ssr) * (1.f / MLA_QK) + EPS);
                  u32x2* ko = (u32x2*)(KF + (size_t)row * NQ + hh * MLA_QK);
                  ko[2 * l16] = pack4(a0 * rstd * gk0); ko[2 * l16 + 1] = pack4(a1 * rstd * gk1);
                  if (l16 < 8) { ko[32 + l16] = pack4(y1 * rstd); ko[40 + l16] = pack4(y2 * rstd); } } }
        }
        for (int row = gw; row < MROWS; row += NGW) {
            const f32x4* kr = (const f32x4*)(KVM + (size_t)row * 1024 + hg * 256);
            const f32x4 a0 = kr[2 * l16], a1 = kr[2 * l16 + 1], v0 = kr[32 + 2 * l16], v1 = kr[32 + 2 * l16 + 1];
            const float rstd = rsq(g16_sum(sq4(a0) + sq4(a1)) * (1.f / MEM_D) + EPS);
            u32x2* ko = (u32x2*)(KM + (size_t)row * 512 + hg * MEM_D); u32x2* vo = (u32x2*)(VM + (size_t)row * 512 + hg * MEM_D);
            ko[2 * l16] = pack4(a0 * rstd * ((const f32x4*)g_mk)[2 * l16]); ko[2 * l16 + 1] = pack4(a1 * rstd * ((const f32x4*)g_mk)[2 * l16 + 1]);
            vo[2 * l16] = pack4(v0); vo[2 * l16 + 1] = pack4(v1);
        }
    }
    SEAM(7);
    REP(8) if (IN(8)) {
        for (int u = vcu; u < 256; u += G) { const int b = u >> 7, hh = (u >> 3) & 15, pi = u & 7;
            for (int sub = 0; sub < 2; ++sub) { const int qb = sub ? 15 - pi : pi; const int q0 = qb * 256 + 32 * wave; const size_t row0 = (size_t)b * SEQ + q0;
                attn_unit<MLA_QK, MLA_V, 1, 2, 0>(lds, wave, lane, QF + row0 * NQ + hh * MLA_QK, NQ, KF + (size_t)b * SEQ * NQ + hh * MLA_QK, NQ,
                    VF + (size_t)b * SEQ * NV + hh * MLA_V, NV, XN + row0 * D + hh * MLA_V, D, q0, 0, 4 * (qb + 1), NEGBIG, 0.f, nullptr, karg(18) + hh * MLA_V, SSO + row0 * 64 + hh); } }
        STAMP(4);
        LAS float* biasL = (LAS float*)(lds + 98304);
        const float* sinks = karg(17);
        for (int c = vcu; c < 256; c += G) { const int b = c >> 7, kvh = (c >> 5) & 3;
            swa_unit128(lds, wave, lane, tid, QS + (size_t)b * SEQ * SWAW + kvh * 8 * SWA_D, KS + (size_t)b * SEQ * SWAKW + kvh * SWA_D, VS + (size_t)b * SEQ * SWAKW + kvh * SWA_D,
                        XN + (size_t)b * SEQ * D + NV + kvh * 8 * SWA_D, SSO + (size_t)b * SEQ * 64 + 16 + kvh * 8, 128 * (c & 31), BIAS + kvh * 1024, sinks + kvh * 8, biasL); }
    }
    SEAM(8);
    if (IN(10)) {
        pg8::Gemm g{XN, (const bf16_t*)(ws + WS_WOUT), D, D, D / 2}; pg8::DualOrder S; S.B.init(M, D, G, bx);
        pg8::Unit u0; int rbase = 0; if (S.next(0, u0)) { rbase = (u0.pm >> 2) * 1024; pg8::build_rstd_tab(tabA, SSO, rbase, 0, 16, 1.f / NV, tid); pg8::build_rstd_tab(tabB, SSO, rbase, 16, 32, 1.f / SWAW, tid); }
        const pg8::RowTab ra{tabA, rbase}, rb{tabB, rbase};
        pg8::EpiResNorm<true, false> E{HB, HB, D, 1.0f, rb, ra, rb, SS2}; pg8::gemm_phase<pg8::EpiResNorm<true, false>, pg8::DualOrder, true>(lds, g, S, E);
    }
    SEAM(10);
    if (IN(12)) {
        pg8::Gemm g{HB, (const bf16_t*)(ws + WS_WMQ), D, D, 1024}; pg8::OffsetOrder S; S.init(M / 256, 2, 4, G, bx, 0);
        pg8::Unit u0; int rb = 0; if (S.next(0, u0)) { rb = (u0.pm >> 2) * 1024; pg8::build_rstd_tab(tabA, SS2, rb, 0, 64, 1.f / D, tid); }
        pg8::EpiBf16 E{(bf16_t*)QMP, 512, pg8::RowTab{tabA, rb}, (size_t)M * 512}; pg8::gemm_phase<pg8::EpiBf16, pg8::OffsetOrder, true>(lds, g, S, E);
    }
    SEAM(12);
    REP(14) if (IN(14)) {
        for (int u = bx; u < 128; u += G) { const int b = u >> 6, hh = (u >> 4) & 3, qb = u & 15; const int q0 = qb * 256 + 32 * wave; const size_t row0 = (size_t)b * SEQ + q0;
            attn_unit<MEM_D, MEM_D, 0, 1, 0, 1>(lds, wave, lane, (const bf16_t*)QMP + row0 * 512 + hh * MEM_D, 512, KM + (size_t)b * MEML * 512 + hh * MEM_D, 512,
                VM + (size_t)b * MEML * 512 + hh * MEM_D, 512, OM + row0 * 512 + hh * MEM_D, 512, q0, 0, 4, NEGBIG, 0.f, nullptr, karg(25), nullptr); }
        if (bx >= 128) convert_claimed(ws, wave, lane, tid, ctl + CW_CONV + 128, MISC + 12, NSC_EARLY, NSC_EARLY + SC_GU, 1, 1);
    }
    SEAM(14);
    if (IN(15)) {
        pg8::Gemm g{OM, (const bf16_t*)(ws + WS_WMO), 512, 512, 512}; pg8::StaticOrder S; S.init(M, D, G, bx);
        pg8::EpiResNorm<false, false> E{HB, HB, D, 1.0f, RT_NONE, RT_NONE, RT_NONE, SS3}; pg8::gemm_phase<pg8::EpiResNorm<false, false>, pg8::StaticOrder, true>(lds, g, S, E);
        convert_claimed(ws, wave, lane, tid, ctl + CW_CONV + 128, MISC + 12, NSC_EARLY, NSC_EARLY + SC_GU, 1);
    }
    SEAM(15);
    if (IN(17)) {
        pg8::Gemm g{HB, (const bf16_t*)(ws + WS_WGU_B), D, D, D}; pg8::StaticOrder S; S.init(M, 2 * FF, G, bx);
        pg8::Unit u0; int rb = 0; if (S.next(0, u0)) { rb = (u0.pm >> 2) * 1024; pg8::build_rstd_tab(tabA, SS3, rb, 0, 64, 1.f / D, tid); }
        pg8::EpiSwiGLU E{ACT, FF, pg8::RowTab{tabA, rb}, F8_B}; pg8::gemm_phase<pg8::EpiSwiGLU, pg8::StaticOrder, true>(lds, g, S, E);
        convert_claimed(ws, wave, lane, tid, ctl + CW_CONV + 64, MISC + 12, NSC_EARLY + SC_GU + (G == 256 ? 128 : 0), NSC);
    }
    SEAM(17);
    if (IN(18)) {
        constexpr int KU = F8_B ? FF / 2 : FF;
        pg8::Gemm g{ACT, (const bf16_t*)(ws + WS_WD_B), KU, KU, KU}; pg8::StaticOrder S; S.init(M, D, G, bx);
        pg8::EpiResOut E{HB, out, D, F8_B ? 0.5f / (F8_SA * F8_SW) : 0.5f}; pg8::gemm_phase<pg8::EpiResOut, pg8::StaticOrder, true, F8_B>(lds, g, S, E);
    }
    if (PROBE_A >= 0 && bx == 0 && tid == 0) {
        const unsigned long long te = __builtin_amdgcn_s_memrealtime();
        const unsigned long long ta = ((unsigned long long)MISC[17 + 2 * PROBE_A] << 32) | MISC[16 + 2 * PROBE_A];
        const unsigned long long tb = (PROBE_B >= NPHASE) ? (PROBE_CYC ? __builtin_amdgcn_s_memtime() : te) : (((unsigned long long)MISC[17 + 2 * PROBE_B] << 32) | MISC[16 + 2 * PROBE_B]);
        const unsigned long long wait = PROBE_CYC ? (tb - ta) / 25ull : (tb - ta) * (unsigned long long)PROBE_MULT;
        while (__builtin_amdgcn_s_memrealtime() - te < wait) __builtin_amdgcn_s_sleep(8);
    }
#undef IN
#undef SEAM
}

extern "C" void kernel_launch(void* const* d_in, const int* in_sizes, int n_in, void* d_out, int out_size, void* d_ws, size_t ws_size, hipStream_t stream) {
    static int grid = 0;
    if (grid == 0) {
        if (n_in != 32 || out_size != M * D || ws_size < WS_END) { fprintf(stderr, "kernel_launch: unexpected problem (n_in %d, out %d, ws %zu); nothing launched\n", n_in, out_size, ws_size); grid = -1; return; }
        int dev = 0, cus = 0, per_cu = 0;
        if (hipGetDevice(&dev) != hipSuccess || hipDeviceGetAttribute(&cus, hipDeviceAttributeMultiprocessorCount, dev) != hipSuccess) { grid = -1; return; }
        if (hipFuncSetAttribute((const void*)fwd_kernel, hipFuncAttributeMaxDynamicSharedMemorySize, LDS_BYTES) != hipSuccess) { fprintf(stderr, "kernel_launch: hipFuncSetAttribute failed\n"); grid = -1; return; }
        if (hipOccupancyMaxActiveBlocksPerMultiprocessor(&per_cu, (const void*)fwd_kernel, NWAVES * 64, LDS_BYTES) != hipSuccess || per_cu < 1)
            fprintf(stderr, "kernel_launch: note: occupancy query reports %d workgroups per CU\n", per_cu);
        (void)hipGetLastError();
        grid = cus;
    }
    if (grid < 0) return;
    if (hipMemsetAsync((char*)d_ws + WS_CTL, 0, CTL_ZERO_BYTES, stream) != hipSuccess) return;
    Args a{};
    for (int i = 0; i < 32; ++i) a.in[i] = (const float*)d_in[i];
    a.out = (float*)d_out; a.ws = (unsigned char*)d_ws;
    if (MK_N_LAUNCHES == 1) {
        a.ph_lo = 0; a.ph_hi = NPHASE;
        hipLaunchKernelGGL(fwd_kernel, dim3(grid), dim3(NWAVES * 64), LDS_BYTES, stream, a);
    } else {
        for (int p = 0; p < NPHASE; ++p) { a.ph_lo = p; a.ph_hi = p + 1; hipLaunchKernelGGL(fwd_kernel, dim3(grid), dim3(NWAVES * 64), LDS_BYTES, stream, a); }
    }
}
```

```cpp
#include <hip/hip_runtime.h>
#include <cstdio>
#include <cstdint>

#ifndef MK_N_LAUNCHES
#define MK_N_LAUNCHES 1
#endif

#define GAS __attribute__((address_space(1)))
#define LAS __attribute__((address_space(3)))
typedef unsigned short bf16_t;
typedef short bf16x8 __attribute__((ext_vector_type(8)));
typedef short s16x4 __attribute__((ext_vector_type(4)));
typedef float f32x4 __attribute__((ext_vector_type(4)));
typedef float f32x16 __attribute__((ext_vector_type(16)));
typedef unsigned u32x4 __attribute__((ext_vector_type(4)));
typedef unsigned u32x2 __attribute__((ext_vector_type(2)));
typedef float f32x2_t __attribute__((ext_vector_type(2)));
typedef __bf16 bf16x2_t __attribute__((ext_vector_type(2)));
typedef GAS unsigned gu32;
typedef int i32x4 __attribute__((ext_vector_type(4)));
typedef int i32x8 __attribute__((ext_vector_type(8)));
#ifndef F8_MASK
#define F8_MASK 6
#endif
constexpr bool F8_A = (F8_MASK & 1) != 0, F8_B = (F8_MASK & 2) != 0, F8_GUB = (F8_MASK & 4) != 0;
constexpr float F8_SA = 8.f, F8_SW = 1024.f, F8_SH = 16.f;
__device__ __forceinline__ unsigned pk4_fp8(float a, float b, float c, float d) {
    a = fminf(fmaxf(a, -448.f), 448.f); b = fminf(fmaxf(b, -448.f), 448.f); c = fminf(fmaxf(c, -448.f), 448.f); d = fminf(fmaxf(d, -448.f), 448.f);
    int p = 0; p = __builtin_amdgcn_cvt_pk_fp8_f32(a, b, p, false); p = __builtin_amdgcn_cvt_pk_fp8_f32(c, d, p, true); return (unsigned)p; }

#define LDS_WAIT() asm volatile("s_waitcnt lgkmcnt(0)" ::: "memory")
#define VM_WAIT() asm volatile("s_waitcnt vmcnt(0)" ::: "memory")
#define RLX_AGENT __ATOMIC_RELAXED, __HIP_MEMORY_SCOPE_AGENT

__device__ __forceinline__ unsigned cvtpk(float lo, float hi) { f32x2_t v = {lo, hi}; bf16x2_t b = __builtin_convertvector(v, bf16x2_t); return __builtin_bit_cast(unsigned, b); }
__device__ __forceinline__ f32x4 bf4_to_f32(u32x2 w) { f32x4 r; r.x = __builtin_bit_cast(float, w.x << 16); r.y = __builtin_bit_cast(float, w.x & 0xffff0000u); r.z = __builtin_bit_cast(float, w.y << 16); r.w = __builtin_bit_cast(float, w.y & 0xffff0000u); return r; }
__device__ __forceinline__ float fast_exp2(float x) { return __builtin_amdgcn_exp2f(x); }
__device__ __forceinline__ float fast_rcp(float x) { return __builtin_amdgcn_rcpf(x); }
__device__ __forceinline__ float rsq(float x) { return 1.0f / __builtin_sqrtf(x); }

constexpr int SEQ = 4096, NB = 2, M = NB * SEQ, D = 4096, FF = 11008;
constexpr int MEML = 256, MROWS = NB * MEML;
constexpr int CQ = 896, CKV = 512, KRD = 64, INW = 4032;
constexpr int MLA_H = 16, MLA_QK = 192, MLA_NOPE = 128, MLA_V = 128;
constexpr int SWA_H = 32, SWA_KVH = 4, SWA_D = 64;
constexpr int MEM_H = 4, MEM_D = 128;
constexpr int NQ = MLA_H * MLA_QK;
constexpr int NKN = MLA_H * MLA_NOPE;
constexpr int NV = MLA_H * MLA_V;
constexpr int SWAW = SWA_H * SWA_D;
constexpr int SWAKW = SWA_KVH * SWA_D;
constexpr float EPS = 1e-6f;
constexpr float LOG2E = 1.4426950408889634f;
constexpr float NEGBIG = -1e30f;

constexpr size_t MiB = 1u << 20;
constexpr size_t WS_CTL = 0, CTL_ZERO_BYTES = 1 * MiB;
constexpr size_t WS_ROPE = 1 * MiB;
constexpr size_t WS_BIAS = 2 * MiB;
constexpr size_t WS_WGU_A = 4 * MiB;
constexpr size_t WS_WD_A = 176 * MiB;
constexpr size_t WS_WGU_B = 262 * MiB;
constexpr size_t WS_WD_B = 434 * MiB;
constexpr size_t WS_WIN = 520 * MiB;
constexpr size_t WS_WUQ = 552 * MiB;
constexpr size_t WS_WKN = 558 * MiB;
constexpr size_t WS_WV = 560 * MiB;
constexpr size_t WS_WOUT = 562 * MiB;
constexpr size_t WS_WMQ = 594 * MiB;
constexpr size_t WS_WMKV = 598 * MiB;
constexpr size_t WS_WMO = 606 * MiB;
constexpr size_t WS_XN = 610 * MiB;
constexpr size_t WS_ACT = 674 * MiB;
constexpr size_t WS_U = WS_ACT;
constexpr size_t WS_QRAW = WS_ACT;
constexpr size_t WS_KNRAW = WS_ACT + 96 * MiB;
constexpr size_t WS_O = WS_ACT;
constexpr size_t WS_QMP = WS_ACT;
constexpr size_t WS_QF = 846 * MiB;
constexpr size_t WS_KF = 894 * MiB;
constexpr size_t WS_VF = 942 * MiB;
constexpr size_t WS_QS = 974 * MiB;
constexpr size_t WS_KS = 1006 * MiB;
constexpr size_t WS_VS = 1010 * MiB;
constexpr size_t WS_CQN = 1014 * MiB;
constexpr size_t WS_CKVN = 1028 * MiB;
constexpr size_t WS_KRB = 1036 * MiB;
constexpr size_t WS_MEMN = 1038 * MiB;
constexpr size_t WS_KVM = 1042 * MiB;
constexpr size_t WS_KM = 1044 * MiB;
constexpr size_t WS_VM = 1044 * MiB + 512 * 1024;
constexpr size_t WS_QM = 1045 * MiB;
constexpr size_t WS_OM = 1053 * MiB;
constexpr size_t WS_SS1 = 1061 * MiB;
constexpr size_t WS_SS2 = 1063 * MiB;
constexpr size_t WS_SS3 = 1065 * MiB;
constexpr size_t WS_SSO = 1067 * MiB;
constexpr size_t WS_XN2 = 1069 * MiB;
constexpr size_t WS_HB = 1133 * MiB;
constexpr size_t WS_END = 1197 * MiB;
constexpr int CW_TMO = 0;
constexpr int CW_BAR = 4096;
constexpr int CW_CONV = 12288;

constexpr int RING_BYTES = 131072;
constexpr int MISC_OFF = 163840 - 1024;
constexpr int LDS_BYTES = 163840;
constexpr int TAB_OFF = RING_BYTES;
constexpr int WARM_OFF = RING_BYTES + 16384;
constexpr int NWAVES = 8;

namespace pg8 {
constexpr int BM = 256, BK = 64, HALF = 128, HTB = HALF * BK * 2, NXCD = 8, WGM = 4;
static_assert(WGM == 4, "the row-statistics tables cover WGM * 256 = 1024 rows");
__host__ __device__ __forceinline__ int lds_byte(int r, int c) { const int st = (r >> 4) * 2 + (c >> 5), rr = r & 15, cc = c & 31, ob = rr * 64 + cc * 2; return st * 1024 + (ob ^ (((ob >> 9) & 1) << 5)); }
__host__ __device__ __forceinline__ void stage_rc(int b, int& R, int& C) { const int st = b / 1024, sb = b % 1024, swz = sb ^ (((sb >> 9) & 1) << 5); R = (st >> 1) * 16 + swz / 64; C = (st & 1) * 32 + (swz % 64) / 2; }
__host__ __device__ __forceinline__ int perm32(int rho) { const int n = rho >> 4, i = rho & 15; return 8 * (i >> 2) + 4 * n + (i & 3); }

struct Unit { int pm, pn, ks; };
struct Gemm { const bf16_t* A; const bf16_t* Bt; int lda, ldb, K; };

struct StaticOrder {
    int nM, nN, nwg, G, c;
    __device__ __forceinline__ void init(int M_, int N_, int G_, int c_) { nM = M_ / BM; nN = N_ / BM; nwg = nM * nN; G = G_; c = c_; }
    __device__ __forceinline__ bool next(int i, Unit& u) const {
        const long L = (long)i * G + c; if (L >= nwg) return false;
        int wgid = (int)L; { const int q = nwg / NXCD, r = nwg % NXCD, xcd = wgid % NXCD, off = wgid / NXCD; wgid = (xcd < r ? xcd * (q + 1) : r * (q + 1) + (xcd - r) * q) + off; }
        const int nig = WGM * nN, gid = wgid / nig, fm = gid * WGM, gsz = (nM - fm) < WGM ? (nM - fm) : WGM;
        u.pm = fm + ((wgid % nig) % gsz); u.pn = (wgid % nig) / gsz; u.ks = 0; return true;
    }
};
struct DualOrder { StaticOrder B;
    __device__ __forceinline__ bool next(int i, Unit& u) const { if (!B.next(i >> 1, u)) return false; u.ks = i & 1; return true; } };
struct OffsetOrder {
    int n, c0, G, c, nN, nS;
    __device__ __forceinline__ void init(int nM_, int nN_, int nS_, int G_, int c_, int c0_) { n = nM_ * nN_ * nS_; nN = nN_; nS = nS_; G = G_; c = c_; c0 = c0_; }
    __device__ __forceinline__ bool next(int i, Unit& u) const {
        const int rel = (c - c0 + G) % G; const long L = (long)i * G + rel; if (L >= n) return false;
        const int t = (int)L; u.ks = t % nS; const int q = t / nS; u.pn = q % nN; u.pm = q / nN; return true;
    }
};

struct RowTab { const LAS float* t; int row_base; };
__device__ __forceinline__ float tab_get(const RowTab& T, int row) { return T.t ? T.t[row - T.row_base] : 1.f; }
__device__ __forceinline__ void build_rstd_tab(LAS float* tab, const float* ss, int row_base, int s0, int ns, float inv_n, int tid) {
    for (int r = tid; r < 1024; r += 512) { const f32x4* p = (const f32x4*)(ss + (size_t)(row_base + r) * 64 + s0);
        f32x4 a = p[0];
        for (int i = 1; i < ns / 4; ++i) a += p[i];
        tab[r] = rsq(((a.x + a.y) + (a.z + a.w)) * inv_n + EPS); }
    __syncthreads();
}
template <class T> __device__ __forceinline__ T ldo(const void* base, unsigned off) { return *(const T*)((const char*)base + off); }
template <class T> __device__ __forceinline__ void sto(void* base, unsigned off, T v) { *(T*)((char*)base + off) = v; }
struct EpiF32 {
    static constexpr bool PERM = false, HAS_MID = false;
    float* C; int ldc; size_t split_stride; RowTab pre;
    __device__ __forceinline__ void operator()(const f32x4 (&acc)[2][2][4][2], const Unit& u, int wr, int wc, int fr, int fq) const {
        const int row0 = u.pm * BM + wr * 64 + fr, col0 = u.pn * BM + wc * 32 + 4 * fq;
        float* Cb = C + (size_t)u.ks * split_stride;
#pragma unroll
        for (int ai = 0; ai < 2; ++ai)
#pragma unroll
            for (int m = 0; m < 4; ++m) { const int row = row0 + ai * HALF + m * 16; const float rs = tab_get(pre, row); const unsigned off = (unsigned)(row * ldc + col0) * 4u;
#pragma unroll
                for (int bj = 0; bj < 2; ++bj)
#pragma unroll
                    for (int n = 0; n < 2; ++n) sto<f32x4>(Cb, off + (bj * HALF + n * 16) * 4, acc[ai][bj][m][n] * rs); }
    }
};
struct EpiResOut {
    static constexpr bool PERM = true, HAS_MID = false;
    const bf16_t* hb; float* out; int ldc; float alpha;
    __device__ __forceinline__ void operator()(const f32x4 (&acc)[2][2][4][2], const Unit& u, int wr, int wc, int fr, int fq) const {
        const int row0 = u.pm * BM + wr * 64 + fr, col0 = u.pn * BM + wc * 32 + 8 * fq;
#pragma unroll
        for (int ai = 0; ai < 2; ++ai) {
            u32x4 b[4][2];
#pragma unroll
            for (int m = 0; m < 4; ++m)
#pragma unroll
                for (int bj = 0; bj < 2; ++bj) b[m][bj] = ldo<u32x4>(hb, (unsigned)((row0 + ai * HALF + m * 16) * ldc + col0 + bj * HALF) * 2u);
            asm volatile("" ::: "memory");
#pragma unroll
            for (int m = 0; m < 4; ++m) { const unsigned eo = (unsigned)((row0 + ai * HALF + m * 16) * ldc + col0);
#pragma unroll
                for (int bj = 0; bj < 2; ++bj) { const f32x4 h0 = bf4_to_f32((u32x2){b[m][bj].x, b[m][bj].y}), h1 = bf4_to_f32((u32x2){b[m][bj].z, b[m][bj].w});
                    sto<f32x4>(out, (eo + bj * HALF) * 4u, h0 + acc[ai][bj][m][0] * alpha); sto<f32x4>(out, (eo + bj * HALF + 4) * 4u, h1 + acc[ai][bj][m][1] * alpha); } }
            asm volatile("" ::: "memory");
        }
    }
};
template <bool MID, bool BASE_F32> struct EpiResNorm {
    static constexpr bool PERM = true, HAS_MID = MID;
    const void* base; bf16_t* hb; int ldc; float alpha; RowTab pre, mid_num, mid_den; float* ssout; unsigned char* h8 = nullptr;
    __device__ __forceinline__ bool mid(const Unit& u) const { return MID && u.ks == 0; }
    __device__ __forceinline__ void midscale(f32x4 (&acc)[2][2][4][2], const Unit& u, int wr, int wc, int fr, int fq) const {
        const int row0 = u.pm * BM + wr * 64 + fr;
#pragma unroll
        for (int ai = 0; ai < 2; ++ai)
#pragma unroll
            for (int m = 0; m < 4; ++m) { const int row = row0 + ai * HALF + m * 16; const float f = tab_get(mid_num, row) / tab_get(mid_den, row);
#pragma unroll
                for (int bj = 0; bj < 2; ++bj)
#pragma unroll
                    for (int n = 0; n < 2; ++n) acc[ai][bj][m][n] = acc[ai][bj][m][n] * f; }
    }
    __device__ __forceinline__ void operator()(const f32x4 (&acc)[2][2][4][2], const Unit& u, int wr, int wc, int fr, int fq) const {
        const int row0 = u.pm * BM + wr * 64 + fr, col0 = u.pn * BM + wc * 32 + 8 * fq;
#pragma unroll
        for (int am = 0; am < 4; ++am) { const int ai = am >> 1, m0 = (am & 1) * 2;
            f32x4 b[BASE_F32 ? 2 : 1][2][2]; u32x4 braw[2][2];
#pragma unroll
            for (int mm = 0; mm < 2; ++mm) { const unsigned eo = (unsigned)((row0 + ai * HALF + (m0 + mm) * 16) * ldc + col0);
#pragma unroll
                for (int bj = 0; bj < 2; ++bj) {
                    if (BASE_F32) { b[mm][bj][0] = ldo<f32x4>(base, (eo + bj * HALF) * 4u); b[mm][bj][1] = ldo<f32x4>(base, (eo + bj * HALF + 4) * 4u); }
                    else braw[mm][bj] = ldo<u32x4>(base, (eo + bj * HALF) * 2u); } }
            asm volatile("" ::: "memory");
#pragma unroll
            for (int mm = 0; mm < 2; ++mm) { const int m = m0 + mm; const int row = row0 + ai * HALF + m * 16; const float sc = alpha * tab_get(pre, row); const unsigned eo = (unsigned)(row * ldc + col0);
                float ssq = 0.f;
#pragma unroll
                for (int bj = 0; bj < 2; ++bj) {
                    f32x4 r0, r1;
                    if (BASE_F32) { r0 = b[mm][bj][0]; r1 = b[mm][bj][1]; } else { r0 = bf4_to_f32((u32x2){braw[mm][bj].x, braw[mm][bj].y}); r1 = bf4_to_f32((u32x2){braw[mm][bj].z, braw[mm][bj].w}); }
                    const f32x4 v0 = r0 + acc[ai][bj][m][0] * sc, v1 = r1 + acc[ai][bj][m][1] * sc;
                    u32x4 hw; hw.x = cvtpk(v0[0], v0[1]); hw.y = cvtpk(v0[2], v0[3]); hw.z = cvtpk(v1[0], v1[1]); hw.w = cvtpk(v1[2], v1[3]);
                    sto<u32x4>(hb, (eo + bj * HALF) * 2u, hw);
                    if (h8) { u32x2 w8; w8.x = pk4_fp8(v0[0] * F8_SH, v0[1] * F8_SH, v0[2] * F8_SH, v0[3] * F8_SH); w8.y = pk4_fp8(v1[0] * F8_SH, v1[1] * F8_SH, v1[2] * F8_SH, v1[3] * F8_SH); sto<u32x2>(h8, eo + bj * HALF, w8); }
                    ssq += (v0.x * v0.x + v0.y * v0.y) + (v0.z * v0.z + v0.w * v0.w) + (v1.x * v1.x + v1.y * v1.y) + (v1.z * v1.z + v1.w * v1.w); }
                ssq += __shfl_xor(ssq, 16); ssq += __shfl_xor(ssq, 32);
                if (fq == 0) sto<float>(ssout, (unsigned)(row * 64 + u.pn * 4 + wc) * 4u, ssq); }
            asm volatile("" ::: "memory");
        }
    }
};
struct EpiBf16 {
    static constexpr bool PERM = true, HAS_MID = false;
    bf16_t* O; int ldc; RowTab pre; size_t split_stride; bf16_t* O2 = nullptr; int pn_split = 1 << 30;
    __device__ __forceinline__ void operator()(const f32x4 (&acc)[2][2][4][2], const Unit& u, int wr, int wc, int fr, int fq) const {
        const bool second = u.pn >= pn_split;
        const int row0 = u.pm * BM + wr * 64 + fr, col0 = (second ? u.pn - pn_split : u.pn) * BM + wc * 32 + 8 * fq;
        bf16_t* Ob = second ? O2 : O + (size_t)u.ks * split_stride;
#pragma unroll
        for (int ai = 0; ai < 2; ++ai)
#pragma unroll
            for (int m = 0; m < 4; ++m) { const int row = row0 + ai * HALF + m * 16; const float rs = tab_get(pre, row); const unsigned eo = (unsigned)(row * ldc + col0);
#pragma unroll
                for (int bj = 0; bj < 2; ++bj) { const f32x4 v0 = acc[ai][bj][m][0] * rs, v1 = acc[ai][bj][m][1] * rs;
                    u32x4 w; w.x = cvtpk(v0[0], v0[1]); w.y = cvtpk(v0[2], v0[3]); w.z = cvtpk(v1[0], v1[1]); w.w = cvtpk(v1[2], v1[3]);
                    sto<u32x4>(Ob, (eo + bj * HALF) * 2u, w); } }
    }
};
#ifndef ACT_NT
#define ACT_NT 0
#endif
struct EpiSwiGLU {
    static constexpr bool PERM = true, HAS_MID = false;
    bf16_t* O; int ldc; RowTab pre; bool f8 = false; float osc = 1.f;
    __device__ __forceinline__ float sw(float g, float up) const { return g * fast_rcp(1.0f + fast_exp2(-LOG2E * g)) * up; }
    __device__ __forceinline__ void operator()(const f32x4 (&acc)[2][2][4][2], const Unit& u, int wr, int wc, int fr, int fq) const {
        const int row0 = u.pm * BM + wr * 64 + fr, col0 = u.pn * HALF + wc * 32 + 8 * fq;
#pragma unroll
        for (int ai = 0; ai < 2; ++ai)
#pragma unroll
            for (int m = 0; m < 4; ++m) { const int row = row0 + ai * HALF + m * 16; const float rs = tab_get(pre, row) * osc;
                const f32x4 g0 = acc[ai][0][m][0] * rs, g1 = acc[ai][0][m][1] * rs, u0 = acc[ai][1][m][0] * rs, u1 = acc[ai][1][m][1] * rs;
                if (f8) { u32x2 w8; w8.x = pk4_fp8(sw(g0[0], u0[0]) * F8_SA, sw(g0[1], u0[1]) * F8_SA, sw(g0[2], u0[2]) * F8_SA, sw(g0[3], u0[3]) * F8_SA);
                    w8.y = pk4_fp8(sw(g1[0], u1[0]) * F8_SA, sw(g1[1], u1[1]) * F8_SA, sw(g1[2], u1[2]) * F8_SA, sw(g1[3], u1[3]) * F8_SA);
                    sto<u32x2>(O, (unsigned)(row * ldc + col0), w8); continue; }
                u32x4 w; w.x = cvtpk(sw(g0[0], u0[0]), sw(g0[1], u0[1])); w.y = cvtpk(sw(g0[2], u0[2]), sw(g0[3], u0[3]));
                w.z = cvtpk(sw(g1[0], u1[0]), sw(g1[1], u1[1])); w.w = cvtpk(sw(g1[2], u1[2]), sw(g1[3], u1[3]));
                if (ACT_NT) __builtin_nontemporal_store(w, (u32x4*)((char*)O + (unsigned)(row * ldc + col0) * 2u)); else sto<u32x4>(O, (unsigned)(row * ldc + col0) * 2u, w); }
    }
};

struct EpiIn {
    static constexpr bool PERM = true, HAS_MID = false;
    RowTab pre; bf16_t* cqn; bf16_t* ckvn; bf16_t* qs; bf16_t* ks; bf16_t* vs; float* krb; float* sscq; float* ssckv; const float* g_sq; const float* g_sk;
    __device__ __forceinline__ static void st2(bf16_t* dst, unsigned eoff, int bstep, const f32x4 (&v)[2][2], float sc, const f32x4 (&gv)[2][2]) {
#pragma unroll
        for (int bj = 0; bj < 2; ++bj) { const f32x4 x0 = v[bj][0] * sc * gv[bj][0], x1 = v[bj][1] * sc * gv[bj][1];
            u32x4 w; w.x = cvtpk(x0[0], x0[1]); w.y = cvtpk(x0[2], x0[3]); w.z = cvtpk(x1[0], x1[1]); w.w = cvtpk(x1[2], x1[3]);
            sto<u32x4>(dst, (eoff + bj * bstep) * 2u, w); }
    }
    __device__ __forceinline__ void operator()(const f32x4 (&acc)[2][2][4][2], const Unit& u, int wr, int wc, int fr, int fq) const {
        const int row0 = u.pm * BM + wr * 64 + fr, pn = u.pn, c8 = 8 * fq;
        f32x4 gv[2][2];
        if (pn >= 6 && pn <= 14) { const float* gp = (pn == 14) ? g_sk : g_sq;
#pragma unroll
            for (int bj = 0; bj < 2; ++bj)
#pragma unroll
                for (int n = 0; n < 2; ++n) gv[bj][n] = *(const f32x4*)(gp + 32 * bj + c8 + 4 * n); }
        else {
#pragma unroll
            for (int bj = 0; bj < 2; ++bj)
#pragma unroll
                for (int n = 0; n < 2; ++n) gv[bj][n] = (f32x4){1.f, 1.f, 1.f, 1.f}; }
#pragma unroll
        for (int ai = 0; ai < 2; ++ai)
#pragma unroll
            for (int m = 0; m < 4; ++m) { const int row = row0 + ai * HALF + m * 16; const float rs = tab_get(pre, row);
                f32x4 v[2][2]; float ssq = 0.f;
#pragma unroll
                for (int bj = 0; bj < 2; ++bj)
#pragma unroll
                    for (int n = 0; n < 2; ++n) { v[bj][n] = acc[ai][bj][m][n] * rs; ssq += (v[bj][n].x * v[bj][n].x + v[bj][n].y * v[bj][n].y) + (v[bj][n].z * v[bj][n].z + v[bj][n].w * v[bj][n].w); }
                ssq += __shfl_xor(ssq, 16); ssq += __shfl_xor(ssq, 32);
                if (pn < 3) { st2(cqn, (unsigned)(row * CQ + 256 * pn + 32 * wc + c8), HALF, v, 1.f, gv); if (fq == 0) sto<float>(sscq, (unsigned)(row * 64 + 4 * pn + wc) * 4u, ssq); }
                else if (pn == 3) {
                    if (wc < 2) { st2(cqn, (unsigned)(row * CQ + 768 + 64 * wc + c8), 32, v, 1.f, gv); if (fq == 0) sto<float>(sscq, (unsigned)(row * 64 + 12 + wc) * 4u, ssq); }
                    else { if (wc == 2) {
#pragma unroll
                            for (int bj = 0; bj < 2; ++bj)
#pragma unroll
                                for (int n = 0; n < 2; ++n) sto<f32x4>(krb, (unsigned)(row * KRD + 32 * bj + c8 + 4 * n) * 4u, v[bj][n]); }
                        if (fq == 0) sto<float>(sscq, (unsigned)(row * 64 + 12 + wc) * 4u, 0.f); } }
                else if (pn <= 5) { st2(ckvn, (unsigned)(row * CKV + 256 * (pn - 4) + 32 * wc + c8), HALF, v, 1.f, gv); if (fq == 0) sto<float>(ssckv, (unsigned)(row * 64 + 4 * (pn - 4) + wc) * 4u, ssq); }
                else if (pn <= 13) st2(qs, (unsigned)(row * SWAW + (4 * (pn - 6) + wc) * SWA_D + c8), 32, v, rsq(ssq * (1.f / SWA_D) + EPS) * (0.125f * LOG2E), gv);
                else if (pn == 14) st2(ks, (unsigned)(row * SWAKW + wc * SWA_D + c8), 32, v, rsq(ssq * (1.f / SWA_D) + EPS), gv);
                else st2(vs, (unsigned)(row * SWAKW + wc * SWA_D + c8), 32, v, 1.f, gv);
            }
    }
};

template <class Epi, class Sched, bool ALIGN_EPI, bool F8 = false>
__device__ __forceinline__ void gemm_phase(LAS unsigned char* lds, const Gemm g, const Sched& S, const Epi& E) {
    const int tid = threadIdx.x, wid = __builtin_amdgcn_readfirstlane(tid >> 6), lane = tid & 63, wr = wid >> 2, wc = wid & 3, fr = lane & 15, fq = lane >> 4;
    const int K = g.K, nt = K / BK;
    unsigned voffA[2], voffB[2];
#pragma unroll
    for (int i = 0; i < 2; ++i) { int R, C; stage_rc(tid * 16 + i * 8192, R, C); const int Rb = Epi::PERM ? ((R & ~31) + perm32(R & 31)) : R;
        voffA[i] = (unsigned)(R * g.lda + C) * 2u; voffB[i] = (unsigned)(Rb * g.ldb + C) * 2u; }
    const size_t kstep = (size_t)(BK * 2);
    const size_t hstepA = (size_t)HALF * g.lda * 2, hstepB = (size_t)HALF * g.ldb * 2;
    const size_t tstepA = 2 * hstepA, tstepB = 2 * hstepB;
    const unsigned ldsw = (unsigned)wid * 1024u;
    const bool wsel = wid >= 4;
    const unsigned woff = (unsigned)((64 * (wid & 3) + lane) * (wsel ? g.ldb : g.lda)) * 2u;
    const int aoff = lds_byte(wr * 64 + fr, fq * 8), boff = lds_byte(wc * 32 + fr, fq * 8);
#define PG8_SA(b, h) (((b) * 2 + (h)) * HTB)
#define PG8_SB(b, h) ((4 + (b) * 2 + (h)) * HTB)
#ifndef PG8_AUX_B
#define PG8_AUX_B 0
#endif
#define PG8_STAGE(bufoff, gbase, voff) do { _Pragma("unroll") for (int _i = 0; _i < 2; ++_i) \
        __builtin_amdgcn_global_load_lds((const unsigned*)((const char*)(gbase) + (voff)[_i]), (LAS unsigned*)(lds + (bufoff) + ldsw + _i * 8192), 16, 0, 0); } while (0)
#define PG8_STAGEB(bufoff, gbase, voff) do { _Pragma("unroll") for (int _i = 0; _i < 2; ++_i) \
        __builtin_amdgcn_global_load_lds((const unsigned*)((const char*)(gbase) + (voff)[_i]), (LAS unsigned*)(lds + (bufoff) + ldsw + _i * 8192), 16, 0, PG8_AUX_B); } while (0)
#define PG8_LDA(dst, b, h) do { _Pragma("unroll") for (int m = 0; m < 4; ++m) { \
        if constexpr (F8) dst##8[m] = __builtin_shufflevector(*(const LAS i32x4*)(lds + PG8_SA(b, h) + aoff + m * 2048), *(const LAS i32x4*)(lds + PG8_SA(b, h) + aoff + m * 2048 + 1024), 0, 1, 2, 3, 4, 5, 6, 7); \
        else { _Pragma("unroll") for (int k = 0; k < 2; ++k) dst[m][k] = *(const LAS bf16x8*)(lds + PG8_SA(b, h) + aoff + m * 2048 + k * 1024); } } } while (0)
#define PG8_LDB(dst, b, h) do { _Pragma("unroll") for (int n = 0; n < 2; ++n) { \
        if constexpr (F8) dst##8[n] = __builtin_shufflevector(*(const LAS i32x4*)(lds + PG8_SB(b, h) + boff + n * 2048), *(const LAS i32x4*)(lds + PG8_SB(b, h) + boff + n * 2048 + 1024), 0, 1, 2, 3, 4, 5, 6, 7); \
        else { _Pragma("unroll") for (int k = 0; k < 2; ++k) dst[n][k] = *(const LAS bf16x8*)(lds + PG8_SB(b, h) + boff + n * 2048 + k * 1024); } } } while (0)
#define PG8_MMA(ai, bj, At, Bt) do { __builtin_amdgcn_s_setprio(1); _Pragma("unroll") for (int m = 0; m < 4; ++m) _Pragma("unroll") for (int n = 0; n < 2; ++n) { \
        if constexpr (F8) asm volatile("v_mfma_scale_f32_16x16x128_f8f6f4 %0, %1, %2, %0, %3, %3 op_sel_hi:[0,0,0]" : "+v"(acc[ai][bj][m][n]) : "v"(Bt##8[n]), "v"(At##8[m]), "v"(f8one)); \
        else { _Pragma("unroll") for (int k = 0; k < 2; ++k) acc[ai][bj][m][n] = __builtin_amdgcn_mfma_f32_16x16x32_bf16(Bt[n][k], At[m][k], acc[ai][bj][m][n], 0, 0, 0); } } \
        __builtin_amdgcn_s_setprio(0); } while (0)
#define PG8_WAIT_V(n) asm volatile("s_waitcnt vmcnt(" #n ")" ::: "memory")
#ifndef PG8_WARM_ON
#define PG8_WARM_ON 0
#endif
#define PG8_WD 4
#if PG8_WARM_ON
#define PG8_WARM(tw) do { const int tw_ = (tw); const char* wa_ = tw_ < nt ? cA + (size_t)tw_ * kstep : nA + (size_t)(tw_ - nt) * kstep; const char* wb_ = tw_ < nt ? cB + (size_t)tw_ * kstep : nB + (size_t)(tw_ - nt) * kstep; \
        __builtin_amdgcn_global_load_lds((const unsigned*)((wsel ? wb_ : wa_) + woff), (LAS unsigned*)(lds + WARM_OFF + wid * 256), 4, 0, 0); } while (0)
#define PG8_WAIT_SP1 PG8_WAIT_V(9)
#define PG8_WAIT_SP2 PG8_WAIT_V(10)
#else
#define PG8_WARM(tw) do { } while (0)
#define PG8_WAIT_SP1 PG8_WAIT_V(8)
#define PG8_WAIT_SP2 PG8_WAIT_V(8)
#endif
#define PG8_WAIT_L(n) asm volatile("s_waitcnt lgkmcnt(" #n ")" ::: "memory")
#define PG8_BAR __builtin_amdgcn_s_barrier()
#define PG8_SCHED __builtin_amdgcn_sched_barrier(0)
    Unit cur, nxt; int ui = 0;
    if (!S.next(0, cur)) return;
    f32x4 acc[2][2][4][2];
#pragma unroll
    for (int a = 0; a < 2; ++a)
#pragma unroll
        for (int b = 0; b < 2; ++b)
#pragma unroll
            for (int m = 0; m < 4; ++m)
#pragma unroll
                for (int n = 0; n < 2; ++n) acc[a][b][m][n] = (f32x4){0.f, 0.f, 0.f, 0.f};
    const int f8one = 0x7F7F7F7F;
    bf16x8 At[4][2], B0[2][2], B1[2][2]; i32x8 At8[4], B08[2], B18[2];
    const char* cA = (const char*)g.A + (size_t)cur.pm * tstepA + (size_t)cur.ks * K * 2; const char* cB = (const char*)g.Bt + (size_t)cur.pn * tstepB + (size_t)cur.ks * K * 2;
    PG8_STAGEB(PG8_SB(0, 0), cB, voffB); PG8_STAGEB(PG8_SB(0, 1), cB + hstepB, voffB); PG8_STAGE(PG8_SA(0, 0), cA, voffA); PG8_STAGE(PG8_SA(0, 1), cA + hstepA, voffA);
    if (wr == 1) PG8_BAR;
    PG8_WAIT_V(2); PG8_BAR;
    PG8_STAGEB(PG8_SB(1, 0), cB + kstep, voffB); PG8_STAGE(PG8_SA(1, 0), cA + kstep, voffA); PG8_STAGEB(PG8_SB(1, 1), cB + hstepB + kstep, voffB);
    PG8_WAIT_V(6); PG8_BAR;
    { const char* nA = cA; const char* nB = cB; PG8_WARM(PG8_WD - 1 < nt ? PG8_WD - 1 : 0); }
    for (;;) {
        const bool has_next = S.next(ui + 1, nxt);
        const char* nA = has_next ? (const char*)g.A + (size_t)nxt.pm * tstepA + (size_t)nxt.ks * K * 2 : cA;
        const char* nB = has_next ? (const char*)g.Bt + (size_t)nxt.pn * tstepB + (size_t)nxt.ks * K * 2 : cB;
#pragma unroll 1
        for (int t = 0; t < nt; t += 2) {
            const bool last = (t == nt - 2);
            const char* a1 = cA + (size_t)(t + 1) * kstep;
            const char* a2 = last ? nA : cA + (size_t)(t + 2) * kstep; const char* b2 = last ? nB : cB + (size_t)(t + 2) * kstep;
            const char* a3 = a2 + kstep; const char* b3 = b2 + kstep;
            PG8_LDB(B0, 0, 0); PG8_LDB(B1, 0, 1); PG8_SCHED; PG8_LDA(At, 0, 0); PG8_STAGE(PG8_SA(1, 1), a1 + hstepA, voffA);
            PG8_WAIT_SP1; PG8_WAIT_L(0); PG8_BAR; PG8_MMA(0, 0, At, B0); PG8_MMA(0, 1, At, B1); PG8_BAR; PG8_SCHED;
            PG8_LDA(At, 0, 1); PG8_STAGEB(PG8_SB(0, 0), b2, voffB); PG8_STAGEB(PG8_SB(0, 1), b2 + hstepB, voffB); PG8_STAGE(PG8_SA(0, 0), a2, voffA); PG8_WARM(t + PG8_WD);
            PG8_WAIT_SP2; PG8_WAIT_L(0); PG8_BAR; PG8_MMA(1, 0, At, B0); PG8_MMA(1, 1, At, B1); PG8_BAR; PG8_SCHED;
            PG8_LDB(B0, 1, 0); PG8_LDB(B1, 1, 1); PG8_SCHED; PG8_LDA(At, 1, 0); PG8_STAGE(PG8_SA(0, 1), a2 + hstepA, voffA);
            PG8_WAIT_SP1; PG8_WAIT_L(0); PG8_BAR; PG8_MMA(0, 0, At, B0); PG8_MMA(0, 1, At, B1); PG8_BAR; PG8_SCHED;
            PG8_LDA(At, 1, 1); PG8_STAGEB(PG8_SB(1, 0), b3, voffB); PG8_STAGEB(PG8_SB(1, 1), b3 + hstepB, voffB); PG8_STAGE(PG8_SA(1, 0), a3, voffA); PG8_WARM(t + 1 + PG8_WD);
            PG8_WAIT_SP2; PG8_WAIT_L(0); PG8_BAR; PG8_MMA(1, 0, At, B0); PG8_MMA(1, 1, At, B1); PG8_BAR; PG8_SCHED;
        }
        if constexpr (ALIGN_EPI) { if (wr == 0) PG8_BAR; }
        if constexpr (F8) asm volatile("s_nop 15\n\ts_nop 15" ::: "memory");
        bool keep = false;
        if constexpr (Epi::HAS_MID) { if (E.mid(cur)) { E.midscale(acc, cur, wr, wc, fr, fq); keep = true; } }
        if (!keep) E(acc, cur, wr, wc, fr, fq);
        if (!has_next) break;
        if (!keep) {
#pragma unroll
        for (int a = 0; a < 2; ++a)
#pragma unroll
            for (int b = 0; b < 2; ++b)
#pragma unroll
                for (int m = 0; m < 4; ++m)
#pragma unroll
                    for (int n = 0; n < 2; ++n) acc[a][b][m][n] = (f32x4){0.f, 0.f, 0.f, 0.f};
        }
        cur = nxt; cA = nA; cB = nB; ++ui;
        if constexpr (ALIGN_EPI) { if (wr == 1) PG8_BAR; }
    }
    PG8_WAIT_V(0);
    if constexpr (!ALIGN_EPI) { if (wr == 0) PG8_BAR; }
    PG8_BAR;
#undef PG8_SA
#undef PG8_SB
#undef PG8_STAGE
#undef PG8_STAGEB
#undef PG8_LDA
#undef PG8_LDB
#undef PG8_MMA
#undef PG8_WAIT_V
#undef PG8_WARM
#undef PG8_WAIT_SP1
#undef PG8_WAIT_SP2
#undef PG8_WAIT_L
#undef PG8_BAR
#undef PG8_SCHED
}
}

#define XB_TMO      128
#define XB_XCNT(j)  (256  + 64 * (j))
#define XB_XSUB(j)  (1280 + 64 * (j))
#define XB_XGEN(j)  (2304 + 64 * (j))
#define XB_TOP      3328
#define XB_TOPGEN   3392
#define XCD_BAR_WORDS 3456
#define XB_SPIN_CAP (1u << 18)
__device__ __forceinline__ unsigned xb_ld(unsigned* p)              { return __hip_atomic_load(p, __ATOMIC_RELAXED, __HIP_MEMORY_SCOPE_AGENT); }
__device__ __forceinline__ unsigned xb_add(unsigned* p, unsigned v) { return __hip_atomic_fetch_add(p, v, __ATOMIC_RELAXED, __HIP_MEMORY_SCOPE_AGENT); }
__device__ __forceinline__ unsigned xb_xcc_id() { return (unsigned)__builtin_amdgcn_s_getreg((3 << 11) | 20) & 0xFu; }
#define XB_SPIN(cond, bar) do { unsigned _sp = 0; while (cond) { __builtin_amdgcn_s_sleep(1); \
    if ((++_sp & 255u) == 0u) { if (xb_ld(&(bar)[XB_TMO])) break; if (_sp > XB_SPIN_CAP) { atomicAdd(&(bar)[XB_TMO], 1u); break; } } } } while (0)
struct XcdBarrier { unsigned* bar; unsigned x; volatile LAS unsigned* st; };
__device__ __forceinline__ XcdBarrier xcd_barrier_post(unsigned* bar, volatile LAS unsigned* st) {
    XcdBarrier b; b.bar = bar; b.x = xb_xcc_id(); b.st = st;
    if (threadIdx.x == 0) (void)xb_add(&bar[XB_XCNT(b.x)], 1u);
    return b;
}
__device__ __forceinline__ void xcd_barrier_complete(unsigned* bar, unsigned x, unsigned& nloc, unsigned& nx) {
    const unsigned G = gridDim.x * gridDim.y * gridDim.z;
    unsigned sum, cnt, mine, sp = 0u;
    for (;;) {
        sum = 0u; cnt = 0u; mine = 0u;
#pragma unroll
        for (unsigned j = 0; j < 16; ++j) { const unsigned c = xb_ld(&bar[XB_XCNT(j)]); sum += c; cnt += (c > 0u) ? 1u : 0u; mine = (j == x) ? c : mine; }
        if (sum == G) break;
        __builtin_amdgcn_s_sleep(1);
        if ((++sp & 255u) == 0u) { if (xb_ld(&bar[XB_TMO])) break; if (sp > XB_SPIN_CAP) { atomicAdd(&bar[XB_TMO], 1u); break; } }
    }
    nloc = mine > 0u ? mine : 1u; nx = cnt > 0u ? cnt : 1u;
}
__device__ __forceinline__ void xcd_barrier(const XcdBarrier& b) {
    asm volatile("s_waitcnt vmcnt(0)" ::: "memory");
    __syncthreads();
    if (threadIdx.x == 0) {
        unsigned* bar = b.bar;
        __builtin_amdgcn_s_waitcnt(0);
        unsigned nloc = b.st[0], nx = b.st[1];
        if (nloc == 0u) { xcd_barrier_complete(bar, b.x, nloc, nx); b.st[0] = nloc; b.st[1] = nx; }
        const unsigned old = xb_add(&bar[XB_XSUB(b.x)], 1u);
        const unsigned gen = old / nloc;
        if (old + 1u == (gen + 1u) * nloc) {
            __builtin_amdgcn_fence(__ATOMIC_RELEASE, "agent");
            asm volatile("s_waitcnt vmcnt(0)" ::: "memory");
            const unsigned og = xb_add(&bar[XB_TOP], 1u);
            const unsigned tg = og / nx;
            if (og + 1u == (tg + 1u) * nx) xb_add(&bar[XB_TOPGEN], 1u);
            else XB_SPIN(xb_ld(&bar[XB_TOPGEN]) == tg, bar);
            __builtin_amdgcn_fence(__ATOMIC_ACQUIRE, "agent");
            xb_add(&bar[XB_XGEN(b.x)], 1u);
            asm volatile("s_waitcnt vmcnt(0)" ::: "memory");
        } else {
            XB_SPIN(xb_ld(&bar[XB_XGEN(b.x)]) == gen, bar);
            __builtin_amdgcn_fence(__ATOMIC_ACQUIRE, "agent");
            asm volatile("s_waitcnt vmcnt(0)" ::: "memory");
        }
    }
    __syncthreads();
}

__device__ __forceinline__ float wave_sum(float v) {
#pragma unroll
    for (int o = 1; o < 64; o <<= 1) v += __shfl_xor(v, o);
    return v;
}
__device__ __forceinline__ float g16_sum(float v) {
#pragma unroll
    for (int o = 1; o < 16; o <<= 1) v += __shfl_xor(v, o);
    return v;
}
__device__ __forceinline__ float sq4(f32x4 v) { return (v.x * v.x + v.y * v.y) + (v.z * v.z + v.w * v.w); }
__device__ __forceinline__ u32x2 pack4(f32x4 v) { u32x2 w; w.x = cvtpk(v.x, v.y); w.y = cvtpk(v.z, v.w); return w; }

#ifndef XI_NT
#define XI_NT 0
#endif
struct XItem { const float* src; const float* gain; bf16_t* dst; int srcN, col0, K, row0, k0; float f8scale; };
__device__ __forceinline__ void xi_load(const XItem& x, f32x4 (&v)[8], f32x4 (&gk)[2], int lane) {
    const int kg = lane >> 3, c4 = lane & 7;
    if (x.col0 >= 0) {
        const float* p = x.src + (size_t)(x.k0 + 8 * kg) * x.srcN + x.col0 + 4 * c4;
#pragma unroll
        for (int i = 0; i < 8; ++i) v[i] = *(const f32x4*)(p + (size_t)i * x.srcN);
    } else {
#pragma unroll
        for (int i = 0; i < 8; ++i) v[i] = (f32x4){0.f, 0.f, 0.f, 0.f};
    }
    if (x.gain) { gk[0] = *(const f32x4*)(x.gain + x.k0 + 8 * kg); gk[1] = *(const f32x4*)(x.gain + x.k0 + 8 * kg + 4); }
    else { gk[0] = (f32x4){1.f, 1.f, 1.f, 1.f}; gk[1] = gk[0]; }
}
__device__ __forceinline__ void xi_store(const XItem& x, const f32x4 (&v)[8], const f32x4 (&gk)[2], int lane) {
    const int kg = lane >> 3, c4 = lane & 7;
    if (x.f8scale > 0.f) { unsigned char* d8 = (unsigned char*)x.dst + (size_t)(x.row0 + 4 * c4) * x.K + x.k0 + 8 * kg; const float sc = x.f8scale;
#pragma unroll
        for (int j = 0; j < 4; ++j) { u32x2 o; o.x = pk4_fp8(v[0][j] * gk[0].x * sc, v[1][j] * gk[0].y * sc, v[2][j] * gk[0].z * sc, v[3][j] * gk[0].w * sc); o.y = pk4_fp8(v[4][j] * gk[1].x * sc, v[5][j] * gk[1].y * sc, v[6][j] * gk[1].z * sc, v[7][j] * gk[1].w * sc);
            *(GAS u32x2*)(d8 + (size_t)j * x.K) = o; }
        return; }
    bf16_t* d = x.dst + (size_t)(x.row0 + 4 * c4) * x.K + x.k0 + 8 * kg;
#pragma unroll
    for (int j = 0; j < 4; ++j) { u32x4 o; o.x = cvtpk(v[0][j] * gk[0].x, v[1][j] * gk[0].y); o.y = cvtpk(v[2][j] * gk[0].z, v[3][j] * gk[0].w); o.z = cvtpk(v[4][j] * gk[1].x, v[5][j] * gk[1].y); o.w = cvtpk(v[6][j] * gk[1].z, v[7][j] * gk[1].w);
        *(GAS u32x4*)(d + (size_t)j * x.K) = o; }
}
__device__ __forceinline__ void rms_row4096(const float* xrow, const float* gain, bf16_t* orow, int lane) {
    const f32x4* xr = (const f32x4*)xrow + lane; const f32x4* gr = (const f32x4*)gain + lane;
    f32x4 v[16]; float s = 0.f;
#pragma unroll
    for (int j = 0; j < 16; ++j) { v[j] = xr[64 * j]; s += sq4(v[j]); }
    const float rstd = rsq(wave_sum(s) * (1.f / 4096.f) + EPS);
    u32x2* o8 = (u32x2*)orow + lane;
#pragma unroll
    for (int j = 0; j < 16; ++j) { const f32x4 gg = gr[64 * j]; o8[64 * j] = pack4(v[j] * rstd * gg); }
}

template <int DQK, int DV> struct ACfg {
    static constexpr int PK = DQK * 2 + 16, PV = DV * 2 + 64;
    static constexpr int KT = 64 * PK, VT = 64 * PV, STAGE = KT + VT;
    static constexpr int SK = PK / 16, SV = PV / 16, NQI = SK + SV, NI = (NQI + 7) / 8;
    static constexpr int NSTAGE = 3;
};
#define MFMA32(a, b, c) __builtin_amdgcn_mfma_f32_32x32x16_bf16((a), (b), (c), 0, 0, 0)
__device__ __forceinline__ float xhalf_max(float v) { auto rr = __builtin_amdgcn_permlane32_swap(__builtin_bit_cast(unsigned, v), __builtin_bit_cast(unsigned, v), false, false);
    return fmaxf(__builtin_bit_cast(float, (unsigned)rr[0]), __builtin_bit_cast(float, (unsigned)rr[1])); }
__device__ __forceinline__ float xhalf_sum(float v) { auto rr = __builtin_amdgcn_permlane32_swap(__builtin_bit_cast(unsigned, v), __builtin_bit_cast(unsigned, v), false, false);
    return __builtin_bit_cast(float, (unsigned)rr[0]) + __builtin_bit_cast(float, (unsigned)rr[1]); }
__device__ __forceinline__ void glds16(const void* gsrc, unsigned lds_dst) { unsigned keep;
    asm volatile("s_mov_b32 %0, m0\n\ts_mov_b32 m0, %2\n\ts_nop 0\n\tglobal_load_lds_dwordx4 %1, off\n\ts_mov_b32 m0, %0" : "=&s"(keep) : "v"(gsrc), "s"(lds_dst) : "memory"); }
__device__ __forceinline__ s16x4 vtr(const LAS unsigned char* p) { return __builtin_bit_cast(s16x4, __builtin_amdgcn_ds_read_tr16_b64_v4i16((LAS s16x4*)p)); }

template <int DQK, int DV, int MODE, int OMODE, int SKEW, int QMODE = 0>
__device__ __forceinline__ void attn_unit(LAS unsigned char* lds, int wave, int lane,
                                          const bf16_t* Qw, int qpitch, const bf16_t* Kb, int kpitch, const bf16_t* Vb, int vpitch,
                                          void* Ow, int opitch, int q0, int jt0, int jt1, float m_init, float l_init, const LAS float* biasw, const float* gainw, float* ssw) {
    using C = ACfg<DQK, DV>;
    constexpr float THR = 8.f;
    const int r = lane & 31, h = lane >> 5;
    unsigned goff[C::NI]; int lq[C::NI]; unsigned vmask = 0u;
#pragma unroll
    for (int i = 0; i < C::NI; ++i) { int q = wave + 8 * i; if (q >= C::NQI) q -= 8; lq[i] = q;
        if (q < C::SK) { const int g = q * 64 + lane, row = g / C::SK; int cc = g % C::SK; cc = cc < DQK / 8 ? cc : DQK / 8 - 1; goff[i] = (unsigned)(row * kpitch + cc * 8) * 2u; }
        else { const int g = (q - C::SK) * 64 + lane, row = g / C::SV; int cc = g % C::SV; cc = cc < DV / 8 ? cc : DV / 8 - 1; goff[i] = (unsigned)(row * vpitch + cc * 8) * 2u; vmask |= 1u << i; } }
#define ATT_DMA(jt_, st_) do { const int jc_ = (jt_) < jt1 ? (jt_) : jt1 - 1; \
        const char* kt_ = (const char*)Kb + (size_t)jc_ * 64 * kpitch * 2; const char* vt_ = (const char*)Vb + (size_t)jc_ * 64 * vpitch * 2; \
        _Pragma("unroll") for (int i = 0; i < C::NI; ++i) { const char* b_ = ((vmask >> i) & 1u) ? vt_ : kt_; \
            glds16(b_ + goff[i], ldsbase + (unsigned)((st_) * C::STAGE + lq[i] * 1024)); } } while (0)
    const unsigned ldsbase = (unsigned)(size_t)lds;
    __syncthreads();
    ATT_DMA(jt0, 0); ATT_DMA(jt0 + 1, 1);
    bf16x8 qf[DQK / 16];
#pragma unroll
    for (int ks = 0; ks < DQK / 16; ++ks) qf[ks] = *(const bf16x8*)(Qw + (size_t)r * qpitch + ks * 16 + h * 8);
    if (QMODE == 1) {
        constexpr size_t QPART = (size_t)M * 512;
        f32x4 qa[DQK / 16][2]; float ssq = 0.f;
#pragma unroll
        for (int ks = 0; ks < DQK / 16; ++ks) { u32x4 w = __builtin_bit_cast(u32x4, qf[ks]); f32x4 a0 = bf4_to_f32((u32x2){w.x, w.y}), a1 = bf4_to_f32((u32x2){w.z, w.w});
#pragma unroll
            for (int p = 1; p < 4; ++p) { w = *(const u32x4*)(Qw + p * QPART + (size_t)r * qpitch + ks * 16 + h * 8); a0 += bf4_to_f32((u32x2){w.x, w.y}); a1 += bf4_to_f32((u32x2){w.z, w.w}); }
            qa[ks][0] = a0; qa[ks][1] = a1; ssq += sq4(a0) + sq4(a1); }
        ssq = xhalf_sum(ssq);
        const float rs = rsq(ssq * (1.f / DQK) + EPS) * (rsq((float)DQK) * LOG2E);
#pragma unroll
        for (int ks = 0; ks < DQK / 16; ++ks) { const f32x4 x0 = qa[ks][0] * rs * *(const f32x4*)(gainw + ks * 16 + h * 8), x1 = qa[ks][1] * rs * *(const f32x4*)(gainw + ks * 16 + h * 8 + 4);
            u32x4 w; w.x = cvtpk(x0[0], x0[1]); w.y = cvtpk(x0[2], x0[3]); w.z = cvtpk(x1[0], x1[1]); w.w = cvtpk(x1[2], x1[3]); qf[ks] = __builtin_bit_cast(bf16x8, w); }
    }
#pragma unroll
    for (int ks = 0; ks < DQK / 16; ++ks) asm volatile("" : "+v"(qf[ks]));
    f32x16 O[DV / 32];
#pragma unroll
    for (int d = 0; d < DV / 32; ++d)
#pragma unroll
        for (int i = 0; i < 16; ++i) O[d][i] = 0.f;
    float m = m_init, l = (h == 0) ? l_init : 0.f;
    int st = 0;
    for (int jt = jt0; jt < jt1; ++jt) {
        asm volatile("s_waitcnt vmcnt(%0) lgkmcnt(0)" :: "n"(C::NI) : "memory");
        __builtin_amdgcn_s_barrier();
        asm volatile("" ::: "memory");
        { const int st2 = st + 2 >= 3 ? st - 1 : st + 2; ATT_DMA(jt + 2, st2); }
        if (SKEW > 0 && wave >= 4) __builtin_amdgcn_s_sleep(SKEW);
        const bool active = (MODE == 1) ? (jt * 64 <= q0 + 31) : true;
        if (active) {
            const LAS unsigned char* kb_ = lds + st * C::STAGE; const LAS unsigned char* vb_ = kb_ + C::KT;
            const int qpos = q0 + r;
#pragma unroll 1
            for (int kb = 0; kb < 2; ++kb) {
                if (MODE == 1 && jt * 64 + 32 * kb > q0 + 31) break;
                f32x16 S;
#pragma unroll
                for (int i = 0; i < 16; ++i) S[i] = 0.f;
                const LAS unsigned char* kp = kb_ + (32 * kb + r) * C::PK + h * 16;
                {
                    constexpr int NKS = DQK / 16, KW = NKS < 8 ? NKS : 8;
                    bf16x8 kf[KW];
#pragma unroll
                    for (int ks = 0; ks < KW; ++ks) kf[ks] = *(const LAS bf16x8*)(kp + ks * 32);
                    __builtin_amdgcn_sched_barrier(0);
#pragma unroll
                    for (int ks = 0; ks < NKS; ++ks) { S = MFMA32(kf[ks % KW], qf[ks], S);
                        if (ks + KW < NKS) { kf[ks % KW] = *(const LAS bf16x8*)(kp + (ks + KW) * 32); __builtin_amdgcn_sched_barrier(0); } }
                }
                const int kbase = jt * 64 + 32 * kb + 4 * h;
                if (MODE == 1) {
                    if (kbase - 4 * h + 31 > q0) {
#pragma unroll
                        for (int i = 0; i < 16; ++i) { const int key = kbase + (i & 3) + 8 * (i >> 2); if (key > qpos) S[i] = NEGBIG; }
                    }
                }
                if (MODE == 2) {
                    float bv[16];
#pragma unroll
                    for (int i = 0; i < 16; ++i) bv[i] = biasw[(qpos - (kbase + (i & 3) + 8 * (i >> 2))) & 127];
                    asm volatile("" : "+v"(bv[0]), "+v"(bv[1]), "+v"(bv[2]), "+v"(bv[3]), "+v"(bv[4]), "+v"(bv[5]), "+v"(bv[6]), "+v"(bv[7]),
                                      "+v"(bv[8]), "+v"(bv[9]), "+v"(bv[10]), "+v"(bv[11]), "+v"(bv[12]), "+v"(bv[13]), "+v"(bv[14]), "+v"(bv[15]));
#pragma unroll
                    for (int i = 0; i < 16; ++i) { const int d0 = qpos - (kbase + (i & 3) + 8 * (i >> 2));
                        S[i] = ((unsigned)d0 < 128u) ? S[i] + bv[i] : NEGBIG; }
                }
                float mx = S[0];
#pragma unroll
                for (int i = 1; i < 16; ++i) mx = fmaxf(mx, S[i]);
                mx = xhalf_max(mx);
                if (__any(mx > m + THR)) {
                    const float mn = fmaxf(m, mx); const float alpha = fast_exp2(m - mn); m = mn; l *= alpha;
#pragma unroll
                    for (int d = 0; d < DV / 32; ++d)
#pragma unroll
                        for (int i = 0; i < 16; ++i) O[d][i] *= alpha;
                }
                float ps = 0.f;
#pragma unroll
                for (int i = 0; i < 16; ++i) { S[i] = fast_exp2(S[i] - m); ps += S[i]; }
                l += ps;
                bf16x8 pf[2];
#pragma unroll
                for (int t = 0; t < 2; ++t) { u32x4 w; const int o = 8 * t;
                    w.x = cvtpk(S[o], S[o + 1]); w.y = cvtpk(S[o + 2], S[o + 3]); w.z = cvtpk(S[o + 4], S[o + 5]); w.w = cvtpk(S[o + 6], S[o + 7]);
                    pf[t] = __builtin_bit_cast(bf16x8, w); }
                const LAS unsigned char* vp = vb_ + (32 * kb + 4 * h + ((lane & 15) >> 2)) * C::PV + ((lane >> 4) & 1) * 32 + (lane & 3) * 8;
#pragma unroll
                for (int d = 0; d < DV / 32; ++d)
#pragma unroll
                    for (int t = 0; t < 2; ++t) { const s16x4 lo = vtr(vp + t * 16 * C::PV + d * 64), hi = vtr(vp + t * 16 * C::PV + 8 * C::PV + d * 64);
                        const bf16x8 vf = {lo.x, lo.y, lo.z, lo.w, hi.x, hi.y, hi.z, hi.w};
                        O[d] = MFMA32(vf, pf[t], O[d]); }
            }
        }
        st = st + 1 >= 3 ? 0 : st + 1;
    }
#undef ATT_DMA
    l = xhalf_sum(l);
    const float inv = 1.0f / l;
    float ssq = 0.f;
#pragma unroll
    for (int d = 0; d < DV / 32; ++d)
#pragma unroll
        for (int tq = 0; tq < 4; ++tq) { const int dv = 32 * d + 8 * tq + 4 * h;
            const f32x4 o = (f32x4){O[d][4 * tq], O[d][4 * tq + 1], O[d][4 * tq + 2], O[d][4 * tq + 3]} * inv;
            if (OMODE == 2) { ssq += sq4(o); *(u32x2*)((bf16_t*)Ow + (size_t)r * opitch + dv) = pack4(o); }
            else if (OMODE == 1) *(u32x2*)((bf16_t*)Ow + (size_t)r * opitch + dv) = pack4(o);
            else *(f32x4*)((float*)Ow + (size_t)r * opitch + dv) = o; }
    if (OMODE == 2) { ssq = xhalf_sum(ssq); if (h == 0) ssw[(size_t)r * 64] = ssq; }
}


__device__ __forceinline__ void swa_unit128(LAS unsigned char* lds, int wave, int lane, int tid, const bf16_t* QSb  , const bf16_t* Kb, const bf16_t* Vb,
                                            bf16_t* Ob  , float* ssb  , int q0u,
                                            const float* biasg  , const float* sinks8  , LAS float* biasL) {
    using C = ACfg<SWA_D, SWA_D>;
    constexpr float THR = 8.f;
    const int r = lane & 31, h = lane >> 5;
    const int tbase = q0u / 64 - 2;
    unsigned goff[C::NI]; int lq[C::NI]; unsigned vmask = 0u;
#pragma unroll
    for (int i = 0; i < C::NI; ++i) { int q = wave + 8 * i; if (q >= C::NQI) q -= 8; lq[i] = q;
        if (q < C::SK) { const int g = q * 64 + lane, row = g / C::SK; int cc = g % C::SK; cc = cc < SWA_D / 8 ? cc : SWA_D / 8 - 1; goff[i] = (unsigned)(row * SWAKW + cc * 8) * 2u; }
        else { const int g = (q - C::SK) * 64 + lane, row = g / C::SV; int cc = g % C::SV; cc = cc < SWA_D / 8 ? cc : SWA_D / 8 - 1; goff[i] = (unsigned)(row * SWAKW + cc * 8) * 2u; vmask |= 1u << i; } }
    const unsigned ldsbase = (unsigned)(size_t)lds;
    __syncthreads();
#pragma unroll
    for (int ti = 0; ti < 4; ++ti) { const int jt = tbase + ti;
        if (jt >= 0) { const char* kt_ = (const char*)Kb + (size_t)jt * 64 * SWAKW * 2; const char* vt_ = (const char*)Vb + (size_t)jt * 64 * SWAKW * 2;
#pragma unroll
            for (int i = 0; i < C::NI; ++i) { const char* b_ = ((vmask >> i) & 1u) ? vt_ : kt_; glds16(b_ + goff[i], ldsbase + (unsigned)(ti * C::STAGE + lq[i] * 1024)); } } }
    for (int i = tid; i < 1024; i += 512) biasL[i] = biasg[i];
    const int sblk = wave & 3, hgrp = wave >> 2; const int q0 = q0u + 32 * sblk, qpos = q0 + r;
    bf16x8 qf[4][4];
#pragma unroll
    for (int hi = 0; hi < 4; ++hi)
#pragma unroll
        for (int ks = 0; ks < 4; ++ks) qf[hi][ks] = *(const bf16x8*)(QSb + (size_t)qpos * SWAW + (hgrp * 4 + hi) * SWA_D + ks * 16 + h * 8);
    float sk[4];
#pragma unroll
    for (int hi = 0; hi < 4; ++hi) sk[hi] = sinks8[hgrp * 4 + hi] * LOG2E;
#pragma unroll
    for (int hi = 0; hi < 4; ++hi)
#pragma unroll
        for (int ks = 0; ks < 4; ++ks) asm volatile("" : "+v"(qf[hi][ks]));
    asm volatile("s_waitcnt vmcnt(0) lgkmcnt(0)" ::: "memory");
    __syncthreads();
    const int jt0 = (q0 < 127) ? 0 : ((q0 - 127) >> 6), jt1 = ((q0 + 31) >> 6) + 1;
#pragma unroll 1
    for (int hi = 0; hi < 4; ++hi) {
        const LAS float* biasw = biasL + (hgrp * 4 + hi) * 128;
        bf16x8 q4[4];
#pragma unroll
        for (int ks = 0; ks < 4; ++ks) q4[ks] = (hi == 0) ? qf[0][ks] : (hi == 1) ? qf[1][ks] : (hi == 2) ? qf[2][ks] : qf[3][ks];
        float m = (hi == 0) ? sk[0] : (hi == 1) ? sk[1] : (hi == 2) ? sk[2] : sk[3];
        float l = (h == 0) ? 1.f : 0.f;
        f32x16 O[2];
#pragma unroll
        for (int d = 0; d < 2; ++d)
#pragma unroll
            for (int i = 0; i < 16; ++i) O[d][i] = 0.f;
#pragma unroll 1
        for (int jt = jt0; jt < jt1; ++jt) {
            const LAS unsigned char* kb_ = lds + (jt - tbase) * C::STAGE; const LAS unsigned char* vb_ = kb_ + C::KT;
#pragma unroll 1
            for (int kb = 0; kb < 2; ++kb) {
                f32x16 S;
#pragma unroll
                for (int i = 0; i < 16; ++i) S[i] = 0.f;
                const LAS unsigned char* kp = kb_ + (32 * kb + r) * C::PK + h * 16;
                bf16x8 kf[4];
#pragma unroll
                for (int ks = 0; ks < 4; ++ks) kf[ks] = *(const LAS bf16x8*)(kp + ks * 32);
                const int kbase = jt * 64 + 32 * kb + 4 * h;
                float bv[16];
#pragma unroll
                for (int i = 0; i < 16; ++i) bv[i] = biasw[(qpos - (kbase + (i & 3) + 8 * (i >> 2))) & 127];
#pragma unroll
                for (int ks = 0; ks < 4; ++ks) S = MFMA32(kf[ks], q4[ks], S);
                asm volatile("" : "+v"(bv[0]), "+v"(bv[1]), "+v"(bv[2]), "+v"(bv[3]), "+v"(bv[4]), "+v"(bv[5]), "+v"(bv[6]), "+v"(bv[7]),
                                  "+v"(bv[8]), "+v"(bv[9]), "+v"(bv[10]), "+v"(bv[11]), "+v"(bv[12]), "+v"(bv[13]), "+v"(bv[14]), "+v"(bv[15]));
#pragma unroll
                for (int i = 0; i < 16; ++i) { const int d0 = qpos - (kbase + (i & 3) + 8 * (i >> 2)); S[i] = ((unsigned)d0 < 128u) ? S[i] + bv[i] : NEGBIG; }
                float mx = S[0];
#pragma unroll
                for (int i = 1; i < 16; ++i) mx = fmaxf(mx, S[i]);
                mx = xhalf_max(mx);
                if (__any(mx > m + THR)) { const float mn = fmaxf(m, mx); const float alpha = fast_exp2(m - mn); m = mn; l *= alpha;
#pragma unroll
                    for (int d = 0; d < 2; ++d)
#pragma unroll
                        for (int i = 0; i < 16; ++i) O[d][i] *= alpha; }
                float ps = 0.f;
#pragma unroll
                for (int i = 0; i < 16; ++i) { S[i] = fast_exp2(S[i] - m); ps += S[i]; }
                l += ps;
                bf16x8 pf[2];
#pragma unroll
                for (int t = 0; t < 2; ++t) { u32x4 w; const int o = 8 * t;
                    w.x = cvtpk(S[o], S[o + 1]); w.y = cvtpk(S[o + 2], S[o + 3]); w.z = cvtpk(S[o + 4], S[o + 5]); w.w = cvtpk(S[o + 6], S[o + 7]);
                    pf[t] = __builtin_bit_cast(bf16x8, w); }
                const LAS unsigned char* vp = vb_ + (32 * kb + 4 * h + ((lane & 15) >> 2)) * C::PV + ((lane >> 4) & 1) * 32 + (lane & 3) * 8;
#pragma unroll
                for (int d = 0; d < 2; ++d)
#pragma unroll
                    for (int t = 0; t < 2; ++t) { const s16x4 lo = vtr(vp + t * 16 * C::PV + d * 64), hi2 = vtr(vp + t * 16 * C::PV + 8 * C::PV + d * 64);
                        const bf16x8 vf = {lo.x, lo.y, lo.z, lo.w, hi2.x, hi2.y, hi2.z, hi2.w};
                        O[d] = MFMA32(vf, pf[t], O[d]); }
            }
        }
        l = xhalf_sum(l);
        const float inv = 1.0f / l; float ssq = 0.f;
        bf16_t* Ow = Ob + (size_t)qpos * D + (hgrp * 4 + hi) * SWA_D;
#pragma unroll
        for (int d = 0; d < 2; ++d)
#pragma unroll
            for (int tq = 0; tq < 4; ++tq) { const int dv = 32 * d + 8 * tq + 4 * h;
                const f32x4 o = (f32x4){O[d][4 * tq], O[d][4 * tq + 1], O[d][4 * tq + 2], O[d][4 * tq + 3]} * inv;
                ssq += sq4(o); *(u32x2*)(Ow + dv) = pack4(o); }
        ssq = xhalf_sum(ssq); if (h == 0) ssb[(size_t)qpos * 64 + hgrp * 4 + hi] = ssq;
    }
}

constexpr int NPHASE = 19;
struct Args { const float* in[32]; float* out; unsigned char* ws; int ph_lo, ph_hi; };
static_assert(sizeof(Args) == 32 * 8 + 8 + 8 + 8, "Args has no padding");

__device__ __forceinline__ const float* karg(int k) {
    const __attribute__((address_space(4))) char* kp = (const __attribute__((address_space(4))) char*)__builtin_amdgcn_kernarg_segment_ptr();
    return *(const float* const volatile __attribute__((address_space(4)))*)(kp + 8 * k);
}
constexpr int SC_GU = 86 * 8, SC_D = 16 * 43, SC_IN = 16 * 8, SC_UQ = 12 * 7, SC_KN = 8, SC_OUT = 16 * 8, SC_MQ = 2 * 8, SC_MKV = 4 * 8, SC_MO = 16;
constexpr int SC_A_END = SC_GU + SC_D + SC_IN + SC_UQ + 2 * SC_KN + SC_OUT + SC_MQ + SC_MKV + SC_MO;
constexpr int NSC = SC_A_END + SC_GU + SC_D;
constexpr int SC_LATE = SC_GU + SC_D;
constexpr int NSC_EARLY = NSC - SC_LATE;
__device__ __forceinline__ void sc_decode(XItem& X, int& KGS, int& KB0, int sci, int wave, unsigned char* ws) {
    X.f8scale = 0.f;
    int r = (sci >= SC_A_END) ? sci : (sci < SC_A_END - SC_GU ? sci + SC_GU : sci - (SC_A_END - SC_GU));
    if (r >= SC_A_END) {
        r -= SC_A_END;
        if (r < SC_GU) { const int nbg = r >> 3, kbg = r & 7; const int nb = nbg * 8 + wave; KGS = 8; KB0 = kbg * 8;
            X.src = (wave >> 2) ? karg(30) : karg(29); X.gain = karg(28); X.f8scale = F8_GUB ? F8_SW : 0.f; X.srcN = FF; X.col0 = 128 * nbg + 32 * (wave & 3); X.K = D; X.dst = (bf16_t*)(ws + WS_WGU_B); X.row0 = 32 * nb; return; }
        r -= SC_GU;
        { const int nbg = r / 43, kbg = r % 43; const int nb = nbg * 8 + wave; KGS = 4; KB0 = kbg * 4;
            X.src = karg(31); X.gain = nullptr; X.f8scale = F8_B ? F8_SW : 0.f; X.srcN = D; X.col0 = 32 * nb; X.K = FF; X.dst = (bf16_t*)(ws + WS_WD_B); X.row0 = 32 * nb; return; }
    }
    if (r < SC_GU) { const int nbg = r >> 3, kbg = r & 7; const int nb = nbg * 8 + wave; KGS = 8; KB0 = kbg * 8;
        X.src = (wave >> 2) ? karg(5) : karg(4); X.gain = karg(3); X.srcN = FF; X.col0 = 128 * nbg + 32 * (wave & 3); X.K = D; X.dst = (bf16_t*)(ws + WS_WGU_A); X.row0 = 32 * nb; return; }
    r -= SC_GU;
    if (r < SC_D) { const int nbg = r / 43, kbg = r % 43; const int nb = nbg * 8 + wave; KGS = 4; KB0 = kbg * 4;
        X.src = karg(6); X.gain = nullptr; X.f8scale = F8_A ? F8_SW : 0.f; X.srcN = D; X.col0 = 32 * nb; X.K = FF; X.dst = (bf16_t*)(ws + WS_WD_A); X.row0 = 32 * nb; return; }
    r -= SC_D;
    if (r < SC_IN) { const int nbg = r >> 3, kbg = r & 7; const int nb = nbg * 8 + wave; KGS = 8; KB0 = kbg * 8;
        const int tile = nb >> 3, bj = (nb >> 2) & 1, wc_ = nb & 3; int c0;
        if (tile < 3) c0 = 32 * nb;
        else if (tile == 3) c0 = (wc_ < 2) ? 768 + 64 * wc_ + 32 * bj : (wc_ == 2 ? 1408 + 32 * bj : -1);
        else if (tile < 6) c0 = 896 + 32 * (nb - 32);
        else if (tile < 14) c0 = 1472 + (4 * (tile - 6) + wc_) * 64 + 32 * bj;
        else if (tile == 14) c0 = 3520 + wc_ * 64 + 32 * bj;
        else c0 = 3776 + wc_ * 64 + 32 * bj;
        X.src = karg(8); X.gain = karg(7); X.srcN = INW; X.col0 = c0; X.K = D; X.dst = (bf16_t*)(ws + WS_WIN); X.row0 = 32 * nb; return; }
    r -= SC_IN;
    if (r < SC_UQ) { const int nbg = r / 7, kbg = r % 7; const int nb = nbg * 8 + wave; KGS = 2; KB0 = kbg * 2;
        X.src = karg(11); X.gain = karg(9); X.srcN = NQ; X.col0 = 32 * nb; X.K = CQ; X.dst = (bf16_t*)(ws + WS_WUQ); X.row0 = 32 * nb; return; }
    r -= SC_UQ;
    if (r < 2 * SC_KN) { const int wv = r >= SC_KN; if (wv) r -= SC_KN; const int nb = r * 8 + wave; KGS = 8; KB0 = 0;
        X.src = karg(12); X.gain = karg(10); X.srcN = 4096; X.col0 = (nb >> 2) * 256 + wv * 128 + 32 * (nb & 3); X.K = CKV; X.dst = (bf16_t*)(ws + (wv ? WS_WV : WS_WKN)); X.row0 = 32 * nb; return; }
    r -= 2 * SC_KN;
    if (r < SC_OUT) { const int nbg = r >> 3, kbg = r & 7; const int nb = nbg * 8 + wave; KGS = 8; KB0 = kbg * 8;
        X.src = karg(20); X.gain = (KB0 * 64 < NV) ? karg(18) : karg(19) - NV; X.srcN = D; X.col0 = 32 * nb; X.K = D; X.dst = (bf16_t*)(ws + WS_WOUT); X.row0 = 32 * nb; return; }
    r -= SC_OUT;
    if (r < SC_MQ) { const int nbg = r >> 3, kbg = r & 7; const int nb = nbg * 8 + wave; KGS = 8; KB0 = kbg * 8;
        X.src = karg(23); X.gain = karg(21); X.srcN = 512; X.col0 = 32 * nb; X.K = D; X.dst = (bf16_t*)(ws + WS_WMQ); X.row0 = 32 * nb; return; }
    r -= SC_MQ;
    if (r < SC_MKV) { const int nbg = r >> 3, kbg = r & 7; const int nb = nbg * 8 + wave; KGS = 8; KB0 = kbg * 8;
        X.src = karg(24); X.gain = nullptr; X.srcN = 1024; X.col0 = 32 * nb; X.K = D; X.dst = (bf16_t*)(ws + WS_WMKV); X.row0 = 32 * nb; return; }
    r -= SC_MKV;
    { const int nb = r * 8 + wave; KGS = 8; KB0 = 0;
        X.src = karg(27); X.gain = nullptr; X.srcN = D; X.col0 = 32 * nb; X.K = 512; X.dst = (bf16_t*)(ws + WS_WMO); X.row0 = 32 * nb; }
}
__device__ __forceinline__ void convert_subchunks(unsigned char* ws, int wave, int lane, int sc0, int sc_end, int stride) {
    int sc = sc0, j = 0, kgs = 1, kb0 = 0, nkgs = 1, nkb0 = 0; XItem cur, nx; f32x4 v[8], vn[8], gk[2], gkn[2];
    cur.src = nullptr; cur.gain = nullptr; cur.dst = nullptr; cur.srcN = 0; cur.col0 = -1; cur.K = 0; cur.row0 = 0; cur.k0 = 0; cur.f8scale = 0.f; nx = cur;
    if (sc < sc_end) { sc_decode(cur, kgs, kb0, sc, wave, ws); cur.k0 = 64 * kb0; xi_load(cur, v, gk, lane); }
    while (sc < sc_end) {
        int nsc = sc, nj = j + 1; nx = cur; nkgs = kgs; nkb0 = kb0;
        if (nj == kgs) { nsc = sc + stride; nj = 0; if (nsc < sc_end) sc_decode(nx, nkgs, nkb0, nsc, wave, ws); }
        if (nsc < sc_end) { nx.k0 = 64 * (nkb0 + nj); xi_load(nx, vn, gkn, lane); }
        xi_store(cur, v, gk, lane);
#pragma unroll
        for (int i = 0; i < 8; ++i) v[i] = vn[i];
        gk[0] = gkn[0]; gk[1] = gkn[1];
        cur = nx; sc = nsc; j = nj; kgs = nkgs; kb0 = nkb0;
    }
}
__device__ __forceinline__ void convert_claimed(unsigned char* ws, int wave, int lane, int tid, gu32* ctr, volatile LAS unsigned* slot, int first, int end, int per_claim = 2, int max_claims = 1 << 30) {
    for (int n = 0; n < max_claims; ++n) {
        __syncthreads();
        if (tid == 0) *slot = (unsigned)first + (unsigned)per_claim * __hip_atomic_fetch_add(ctr, 1u, RLX_AGENT);
        __syncthreads();
        const int sc = (int)__builtin_amdgcn_readfirstlane(*slot);
        if (sc >= end) break;
        convert_subchunks(ws, wave, lane, sc, (sc + per_claim < end) ? sc + per_claim : end, 1);
    }
}
__global__ void __launch_bounds__(NWAVES * 64, 2) fwd_kernel(Args args) {
    extern __shared__ __attribute__((aligned(16))) unsigned char lds_raw[];
    LAS unsigned char* lds = (LAS unsigned char*)lds_raw;
    volatile LAS unsigned* MISC = (volatile LAS unsigned*)(lds + MISC_OFF);
    const int tid = threadIdx.x, lane = tid & 63, wave = __builtin_amdgcn_readfirstlane(tid >> 6);
    const int G = gridDim.x; const int bx = blockIdx.x; const int vcu = (G % 8 == 0) ? (bx % 8) * (G / 8) + bx / 8 : bx;
    const int gw = vcu * NWAVES + wave, NGW = G * NWAVES;
    unsigned char* ws = args.ws;
    gu32* ctl = (gu32*)(ws + WS_CTL);
    for (int u = tid; u < (LDS_BYTES - MISC_OFF) / 4; u += NWAVES * 64) ((LAS unsigned*)(lds + MISC_OFF))[u] = 0u;
    __syncthreads();
    XcdBarrier bar; bar.bar = (unsigned*)(ctl + CW_BAR); bar.x = 0; bar.st = nullptr;
    if (MK_N_LAUNCHES == 1) bar = xcd_barrier_post((unsigned*)(ctl + CW_BAR), MISC + 8);
    const int lo = args.ph_lo, hi = args.ph_hi;
#ifndef ONLYP
#define ONLYP -1
#endif
#define IN(k) ((ONLYP < 0 || ONLYP == (k)) && lo <= (k) && (k) < hi)
#ifndef PROBE_A
#define PROBE_A -1
#define PROBE_B -1
#define PROBE_MULT 0
#endif
#ifndef PROBE_CYC
#define PROBE_CYC 0
#endif
#define STAMP(k) do { if (PROBE_A >= 0 && bx == 0 && tid == 0) { const unsigned long long t_ = PROBE_CYC ? __builtin_amdgcn_s_memtime() : __builtin_amdgcn_s_memrealtime(); MISC[16 + 2 * (k)] = (unsigned)t_; MISC[17 + 2 * (k)] = (unsigned)(t_ >> 32); } } while (0)
#define SEAM(k) do { if (IN(k) && IN((k) + 1)) xcd_barrier(bar); STAMP((k) + 1); } while (0)
#ifndef DUPP
#define DUPP -1
#endif
#define REP(k) for (int rep_ = 0; rep_ < ((DUPP == (k)) ? 2 : 1); ++rep_)

    STAMP(0);
    const float* x = karg(0); const float* mem = karg(1); const float* rel_bias = karg(2);
    float* out = args.out;
    bf16_t* XN = (bf16_t*)(ws + WS_XN); bf16_t* ACT = (bf16_t*)(ws + WS_ACT);
    bf16_t* U = (bf16_t*)(ws + WS_U); bf16_t* QRAW = (bf16_t*)(ws + WS_QRAW); bf16_t* KNRAW = (bf16_t*)(ws + WS_KNRAW); bf16_t* HB = (bf16_t*)(ws + WS_HB); float* OB = (float*)(ws + WS_O); float* QMP = (float*)(ws + WS_QMP);
    bf16_t* QF = (bf16_t*)(ws + WS_QF); bf16_t* KF = (bf16_t*)(ws + WS_KF); bf16_t* VF = (bf16_t*)(ws + WS_VF);
    bf16_t* QS = (bf16_t*)(ws + WS_QS); bf16_t* KS = (bf16_t*)(ws + WS_KS); bf16_t* VS = (bf16_t*)(ws + WS_VS);
    bf16_t* CQN = (bf16_t*)(ws + WS_CQN); bf16_t* CKVN = (bf16_t*)(ws + WS_CKVN); float* KRB = (float*)(ws + WS_KRB);
    bf16_t* MEMN = (bf16_t*)(ws + WS_MEMN); float* KVM = (float*)(ws + WS_KVM); bf16_t* KM = (bf16_t*)(ws + WS_KM); bf16_t* VM = (bf16_t*)(ws + WS_VM);
    bf16_t* QM = (bf16_t*)(ws + WS_QM); bf16_t* OM = (bf16_t*)(ws + WS_OM);
    float* ROPE = (float*)(ws + WS_ROPE); float* BIAS = (float*)(ws + WS_BIAS);
    float* SS0 = (float*)(ws + WS_XN2);
    float* SSCQ = (float*)(ws + WS_XN2 + 2 * MiB); float* SSCKV = (float*)(ws + WS_XN2 + 4 * MiB);
    float* SS1 = (float*)(ws + WS_SS1); float* SS2 = (float*)(ws + WS_SS2); float* SS3 = (float*)(ws + WS_SS3); float* SSO = (float*)(ws + WS_SSO);
    const pg8::RowTab RT_NONE{nullptr, 0};
    LAS float* tabA = (LAS float*)(lds + TAB_OFF); LAS float* tabB = tabA + 1024;

    REP(0) if (IN(0)) {
        convert_subchunks(ws, wave, lane, SC_D + bx, NSC_EARLY, G);
        for (int row = gw; row < M; row += NGW) {
            const f32x4* xr = (const f32x4*)(x + (size_t)row * D) + lane; f32x4 v[16]; float sq = 0.f;
#pragma unroll
            for (int j = 0; j < 16; ++j) { v[j] = xr[64 * j]; sq += sq4(v[j]); }
            sq = wave_sum(sq);
            u32x2* o8 = (u32x2*)(XN + (size_t)row * D) + lane;
#pragma unroll
            for (int j = 0; j < 16; ++j) o8[64 * j] = pack4(v[j]);
            if (lane < 4) SS0[(size_t)row * 64 + lane] = (lane == 0) ? sq : 0.f; }
        for (int row = gw; row < MROWS; row += NGW) rms_row4096(mem + (size_t)row * D, karg(22), MEMN + (size_t)row * D, lane);
        for (int i = gw * 64 + lane; i < SEQ * 32; i += NGW * 64) { const int pos = i >> 5, j = i & 31;
            const float inv = exp2f(-(float)j * (13.287712379549449f / 32.f)); const float ang = (float)pos * inv;
            ROPE[2 * i] = cosf(ang); ROPE[2 * i + 1] = sinf(ang); }
        for (int i = gw * 64 + lane; i < SWA_H * 128; i += NGW * 64) { const int hh = i >> 7, d = i & 127;
            int bk = d; if (d >= 16) { bk = 16 + (int)(logf((float)d / 16.f) / 2.0794415416798357f * 16.f); if (bk > 31) bk = 31; }
            BIAS[i] = rel_bias[bk * SWA_H + hh] * LOG2E; }
    }
    SEAM(0);

    if (IN(1)) {
        { pg8::Gemm g{XN, (const bf16_t*)(ws + WS_WGU_A), D, D, D}; pg8::StaticOrder S; S.init(M, 2 * FF, G, bx);
          pg8::Unit u0; int rb = 0; if (S.next(0, u0)) { rb = (u0.pm >> 2) * 1024; pg8::build_rstd_tab(tabA, SS0, rb, 0, 4, 1.f / D, tid); }
          pg8::EpiSwiGLU E{ACT, FF, pg8::RowTab{tabA, rb}, F8_A}; pg8::gemm_phase<pg8::EpiSwiGLU, pg8::StaticOrder, true>(lds, g, S, E);
          if (DUPP == 1) pg8::gemm_phase<pg8::EpiSwiGLU, pg8::StaticOrder, true>(lds, g, S, E);
          if (DUPP == 101) { pg8::Gemm g2{XN, (const bf16_t*)(ws + WS_WGU_A), 0, 0, D}; pg8::EpiSwiGLU E2{(bf16_t*)(ws + WS_QF), 0, RT_NONE};
              pg8::gemm_phase<pg8::EpiSwiGLU, pg8::StaticOrder, true>(lds, g2, S, E2); } }
        { pg8::Gemm g{MEMN, (const bf16_t*)(ws + WS_WMKV), D, D, D}; pg8::OffsetOrder S; S.init(MROWS / 256, 1024 / 256, 1, G, bx, 192 % G);
          pg8::EpiF32 E{KVM, 1024, 0, RT_NONE}; pg8::gemm_phase<pg8::EpiF32, pg8::OffsetOrder, true>(lds, g, S, E); }
        convert_claimed(ws, wave, lane, tid, ctl + CW_CONV, MISC + 12, 0, SC_D);

    }
    SEAM(1);
    if (IN(2)) {
        constexpr int KU = F8_A ? FF / 2 : FF;
        pg8::Gemm g{ACT, (const bf16_t*)(ws + WS_WD_A), KU, KU, KU}; pg8::StaticOrder S; S.init(M, D, G, bx);
        pg8::EpiResNorm<false, false> E{XN, HB, D, F8_A ? 0.5f / (F8_SA * F8_SW) : 0.5f, RT_NONE, RT_NONE, RT_NONE, SS1}; pg8::gemm_phase<pg8::EpiResNorm<false, false>, pg8::StaticOrder, true, F8_A>(lds, g, S, E);
    }
    SEAM(2);
    if (IN(4)) {
        pg8::Gemm g{HB, (const bf16_t*)(ws + WS_WIN), D, D, D}; pg8::StaticOrder S; S.init(M, D, G, bx);
        pg8::Unit u0; int rb = 0; if (S.next(0, u0)) { rb = (u0.pm >> 2) * 1024; pg8::build_rstd_tab(tabA, SS1, rb, 0, 64, 1.f / D, tid); }
        pg8::EpiIn E{pg8::RowTab{tabA, rb}, CQN, CKVN, QS, KS, VS, KRB, SSCQ, SSCKV, karg(15), karg(16)}; pg8::gemm_phase<pg8::EpiIn, pg8::StaticOrder, true>(lds, g, S, E);
    }
    SEAM(4);
    if (IN(6)) {
        { pg8::Gemm g{CQN, (const bf16_t*)(ws + WS_WUQ), CQ, CQ, CQ}; pg8::StaticOrder S; S.init(M, NQ, G, bx);
          pg8::Unit u0; int rb = 0; if (S.next(0, u0)) { rb = (u0.pm >> 2) * 1024; pg8::build_rstd_tab(tabA, SSCQ, rb, 0, 16, 1.f / CQ, tid); }
          pg8::EpiBf16 E{QRAW, NQ, pg8::RowTab{tabA, rb}, 0}; pg8::gemm_phase<pg8::EpiBf16, pg8::StaticOrder, true>(lds, g, S, E); }
        if (G == 256 && bx >= 128) convert_subchunks(ws, wave, lane, NSC_EARLY + SC_GU + (bx - 128), NSC_EARLY + SC_GU + 128, 128);
        static_assert(WS_WV == WS_WKN + (size_t)NKN * CKV * 2 && NKN == NV, "W_kn and W_v copies are adjacent: one [4096][512] weight");
        { pg8::Gemm g{CKVN, (const bf16_t*)(ws + WS_WKN), CKV, CKV, CKV}; pg8::StaticOrder S; S.init(M, NKN + NV, G, bx);
          pg8::Unit u0; int rbkv = 0; if (S.next(0, u0)) { rbkv = (u0.pm >> 2) * 1024; pg8::build_rstd_tab(tabB, SSCKV, rbkv, 0, 8, 1.f / CKV, tid); }
          pg8::EpiBf16 E{KNRAW, NKN, pg8::RowTab{tabB, rbkv}, 0, VF, NKN / 256}; pg8::gemm_phase<pg8::EpiBf16, pg8::StaticOrder, true>(lds, g, S, E); }
    }
    SEAM(6);
    REP(7) if (IN(7)) {
        const float* g_q = karg(13); const float* g_k = karg(14); const float* g_mk = karg(26);
        const int l16 = lane & 15, hg = lane >> 4;
        const float qscale = 0.07216878364870322f * LOG2E;
        const f32x4 gq0 = ((const f32x4*)g_q)[2 * l16], gq1 = ((const f32x4*)g_q)[2 * l16 + 1], gk0 = ((const f32x4*)g_k)[2 * l16], gk1 = ((const f32x4*)g_k)[2 * l16 + 1];
        f32x4 gqx1 = gq0, gqx2 = gq0, gkx1 = gk0, gkx2 = gk0;
        if (l16 < 8) { gqx1 = ((const f32x4*)g_q)[32 + l16]; gqx2 = ((const f32x4*)g_q)[40 + l16]; gkx1 = ((const f32x4*)g_k)[32 + l16]; gkx2 = ((const f32x4*)g_k)[40 + l16]; }
        const int lx = l16 < 8 ? l16 : 0;
        for (int row = gw; row < M; row += NGW) {
            const int pos = row & (SEQ - 1);
            const f32x4* rp = (const f32x4*)(ROPE + (size_t)pos * 64);
            const f32x4 cs0 = rp[2 * lx], cs1 = rp[2 * lx + 1];
            u32x2 qa0[4], qa1[4], qx1[4], qx2[4], ka0[4], ka1[4];
#pragma unroll
            for (int it = 0; it < 4; ++it) { const int hh = 4 * it + hg; const u32x2* qr = (const u32x2*)(QRAW + (size_t)row * NQ + hh * MLA_QK); const u32x2* kr = (const u32x2*)(KNRAW + (size_t)row * NKN + hh * MLA_NOPE);
                qa0[it] = qr[2 * l16]; qa1[it] = qr[2 * l16 + 1]; qx1[it] = qr[32 + lx]; qx2[it] = qr[40 + lx]; ka0[it] = kr[2 * l16]; ka1[it] = kr[2 * l16 + 1]; }
            f32x4 r1 = ((const f32x4*)(KRB + (size_t)row * KRD))[lx], r2 = ((const f32x4*)(KRB + (size_t)row * KRD))[8 + lx];
            const f32x4 co = (f32x4){cs0.x, cs0.z, cs1.x, cs1.z}, si = (f32x4){cs0.y, cs0.w, cs1.y, cs1.w};
#pragma unroll
            for (int it = 0; it < 4; ++it) { const int hh = 4 * it + hg;
                const f32x4 a0 = bf4_to_f32(qa0[it]), a1 = bf4_to_f32(qa1[it]); f32x4 x1 = (f32x4){0.f, 0.f, 0.f, 0.f}, x2 = x1;
                if (l16 < 8) { x1 = bf4_to_f32(qx1[it]); x2 = bf4_to_f32(qx2[it]); }
                const float rstd = rsq(g16_sum(sq4(a0) + sq4(a1) + sq4(x1) + sq4(x2)) * (1.f / MLA_QK) + EPS) * qscale;
                u32x2* qo = (u32x2*)(QF + (size_t)row * NQ + hh * MLA_QK);
                qo[2 * l16] = pack4(a0 * rstd * gq0); qo[2 * l16 + 1] = pack4(a1 * rstd * gq1);
                if (l16 < 8) { x1 = x1 * rstd * gqx1; x2 = x2 * rstd * gqx2;
                    qo[32 + l16] = pack4(x1 * co - x2 * si); qo[40 + l16] = pack4(x2 * co + x1 * si); } }
            { if (l16 >= 8) { r1 = (f32x4){0.f, 0.f, 0.f, 0.f}; r2 = r1; }
              const float ssr = g16_sum(sq4(r1) + sq4(r2));
              f32x4 y1 = r1, y2 = r2;
              if (l16 < 8) { r1 = r1 * gkx1; r2 = r2 * gkx2; y1 = r1 * co - r2 * si; y2 = r2 * co + r1 * si; }
#pragma unroll
              for (int it = 0; it < 4; ++it) { const int hh = 4 * it + hg;
                  const f32x4 a0 = bf4_to_f32(ka0[it]), a1 = bf4_to_f32(ka1[it]);
                  const float rstd = rsq((g16_sum(sq4(a0) + sq4(a1)) + ssr) * (1.f / MLA_QK) + EPS);
                  u32x2* ko = (u32x2*)(KF + (size_t)row * NQ + hh * MLA_QK);
                  ko[2 * l16] = pack4(a0 * rstd * gk0); ko[2 * l16 + 1] = pack4(a1 * rstd * gk1);
                  if (l16 < 8) { ko[32 + l16] = pack4(y1 * rstd); ko[40 + l16] = pack4(y2 * rstd); } } }
        }
        for (int row = gw; row < MROWS; row += NGW) {
            const f32x4* kr = (const f32x4*)(KVM + (size_t)row * 1024 + hg * 256);
            const f32x4 a0 = kr[2 * l16], a1 = kr[2 * l16 + 1], v0 = kr[32 + 2 * l16], v1 = kr[32 + 2 * l16 + 1];
            const float rstd = rsq(g16_sum(sq4(a0) + sq4(a1)) * (1.f / MEM_D) + EPS);
            u32x2* ko = (u32x2*)(KM + (size_t)row * 512 + hg * MEM_D); u32x2* vo = (u32x2*)(VM + (size_t)row * 512 + hg * MEM_D);
            ko[2 * l16] = pack4(a0 * rstd * ((const f32x4*)g_mk)[2 * l16]); ko[2 * l16 + 1] = pack4(a1 * rstd * ((const f32x4*)g_mk)[2 * l16 + 1]);
            vo[2 * l16] = pack4(v0); vo[2 * l16 + 1] = pack4(v1);
        }
    }
    SEAM(7);
    REP(8) if (IN(8)) {
        for (int u = vcu; u < 256; u += G) { const int b = u >> 7, hh = (u >> 3) & 15, pi = u & 7;
            for (int sub = 0; sub < 2; ++sub) { const int qb = sub ? 15 - pi : pi; const int q0 = qb * 256 + 32 * wave; const size_t row0 = (size_t)b * SEQ + q0;
                attn_unit<MLA_QK, MLA_V, 1, 2, 0>(lds, wave, lane, QF + row0 * NQ + hh * MLA_QK, NQ, KF + (size_t)b * SEQ * NQ + hh * MLA_QK, NQ,
                    VF + (size_t)b * SEQ * NV + hh * MLA_V, NV, XN + row0 * D + hh * MLA_V, D, q0, 0, 4 * (qb + 1), NEGBIG, 0.f, nullptr, karg(18) + hh * MLA_V, SSO + row0 * 64 + hh); } }
        STAMP(4);
        LAS float* biasL = (LAS float*)(lds + 98304);
        const float* sinks = karg(17);
        for (int c = vcu; c < 256; c += G) { const int b = c >> 7, kvh = (c >> 5) & 3;
            swa_unit128(lds, wave, lane, tid, QS + (size_t)b * SEQ * SWAW + kvh * 8 * SWA_D, KS + (size_t)b * SEQ * SWAKW + kvh * SWA_D, VS + (size_t)b * SEQ * SWAKW + kvh * SWA_D,
                        XN + (size_t)b * SEQ * D + NV + kvh * 8 * SWA_D, SSO + (size_t)b * SEQ * 64 + 16 + kvh * 8, 128 * (c & 31), BIAS + kvh * 1024, sinks + kvh * 8, biasL); }
    }
    SEAM(8);
    if (IN(10)) {
        pg8::Gemm g{XN, (const bf16_t*)(ws + WS_WOUT), D, D, D / 2}; pg8::DualOrder S; S.B.init(M, D, G, bx);
        pg8::Unit u0; int rbase = 0; if (S.next(0, u0)) { rbase = (u0.pm >> 2) * 1024; pg8::build_rstd_tab(tabA, SSO, rbase, 0, 16, 1.f / NV, tid); pg8::build_rstd_tab(tabB, SSO, rbase, 16, 32, 1.f / SWAW, tid); }
        const pg8::RowTab ra{tabA, rbase}, rb{tabB, rbase};
        pg8::EpiResNorm<true, false> E{HB, HB, D, 1.0f, rb, ra, rb, SS2}; pg8::gemm_phase<pg8::EpiResNorm<true, false>, pg8::DualOrder, true>(lds, g, S, E);
    }
    SEAM(10);
    if (IN(12)) {
        pg8::Gemm g{HB, (const bf16_t*)(ws + WS_WMQ), D, D, 1024}; pg8::OffsetOrder S; S.init(M / 256, 2, 4, G, bx, 0);
        pg8::Unit u0; int rb = 0; if (S.next(0, u0)) { rb = (u0.pm >> 2) * 1024; pg8::build_rstd_tab(tabA, SS2, rb, 0, 64, 1.f / D, tid); }
        pg8::EpiBf16 E{(bf16_t*)QMP, 512, pg8::RowTab{tabA, rb}, (size_t)M * 512}; pg8::gemm_phase<pg8::EpiBf16, pg8::OffsetOrder, true>(lds, g, S, E);
    }
    SEAM(12);
    REP(14) if (IN(14)) {
        for (int u = bx; u < 128; u += G) { const int b = u >> 6, hh = (u >> 4) & 3, qb = u & 15; const int q0 = qb * 256 + 32 * wave; const size_t row0 = (size_t)b * SEQ + q0;
            attn_unit<MEM_D, MEM_D, 0, 1, 0, 1>(lds, wave, lane, (const bf16_t*)QMP + row0 * 512 + hh * MEM_D, 512, KM + (size_t)b * MEML * 512 + hh * MEM_D, 512,
                VM + (size_t)b * MEML * 512 + hh * MEM_D, 512, OM + row0 * 512 + hh * MEM_D, 512, q0, 0, 4, NEGBIG, 0.f, nullptr, karg(25), nullptr); }
        if (bx >= 128) convert_claimed(ws, wave, lane, tid, ctl + CW_CONV + 128, MISC + 12, NSC_EARLY, NSC_EARLY + SC_GU, 1, 1);
    }
    SEAM(14);
    if (IN(15)) {
        pg8::Gemm g{OM, (const bf16_t*)(ws + WS_WMO), 512, 512, 512}; pg8::StaticOrder S; S.init(M, D, G, bx);
        pg8::EpiResNorm<false, false> E{HB, HB, D, 1.0f, RT_NONE, RT_NONE, RT_NONE, SS3, F8_GUB ? (unsigned char*)(ws + WS_XN2 + 16 * MiB) : nullptr}; pg8::gemm_phase<pg8::EpiResNorm<false, false>, pg8::StaticOrder, true>(lds, g, S, E);
        convert_claimed(ws, wave, lane, tid, ctl + CW_CONV + 128, MISC + 12, NSC_EARLY, NSC_EARLY + SC_GU, 1);
    }
    SEAM(15);
    if (IN(17)) {
        constexpr int KG = F8_GUB ? D / 2 : D;
        pg8::Gemm g{F8_GUB ? (const bf16_t*)(ws + WS_XN2 + 16 * MiB) : HB, (const bf16_t*)(ws + WS_WGU_B), KG, KG, KG}; pg8::StaticOrder S; S.init(M, 2 * FF, G, bx);
        pg8::Unit u0; int rb = 0; if (S.next(0, u0)) { rb = (u0.pm >> 2) * 1024; pg8::build_rstd_tab(tabA, SS3, rb, 0, 64, 1.f / D, tid); }
        pg8::EpiSwiGLU E{ACT, FF, pg8::RowTab{tabA, rb}, F8_B, F8_GUB ? 1.f / (F8_SH * F8_SW) : 1.f}; pg8::gemm_phase<pg8::EpiSwiGLU, pg8::StaticOrder, true, F8_GUB>(lds, g, S, E);
        convert_claimed(ws, wave, lane, tid, ctl + CW_CONV + 64, MISC + 12, NSC_EARLY + SC_GU + (G == 256 ? 128 : 0), NSC);
    }
    SEAM(17);
    if (IN(18)) {
        constexpr int KU = F8_B ? FF / 2 : FF;
        pg8::Gemm g{ACT, (const bf16_t*)(ws + WS_WD_B), KU, KU, KU}; pg8::StaticOrder S; S.init(M, D, G, bx);
        pg8::EpiResOut E{HB, out, D, F8_B ? 0.5f / (F8_SA * F8_SW) : 0.5f}; pg8::gemm_phase<pg8::EpiResOut, pg8::StaticOrder, true, F8_B>(lds, g, S, E);
    }
    if (PROBE_A >= 0 && bx == 0 && tid == 0) {
        const unsigned long long te = __builtin_amdgcn_s_memrealtime();
        const unsigned long long ta = ((unsigned long long)MISC[17 + 2 * PROBE_A] << 32) | MISC[16 + 2 * PROBE_A];
        const unsigned long long tb = (PROBE_B >= NPHASE) ? (PROBE_CYC ? __builtin_amdgcn_s_memtime() : te) : (((unsigned long long)MISC[17 + 2 * PROBE_B] << 32) | MISC[16 + 2 * PROBE_B]);
        const unsigned long long wait = PROBE_CYC ? (tb - ta) / 25ull : (tb - ta) * (unsigned long long)PROBE_MULT;
        while (__builtin_amdgcn_s_memrealtime() - te < wait) __builtin_amdgcn_s_sleep(8);
    }
#undef IN
#undef SEAM
}

extern "C" void kernel_launch(void* const* d_in, const int* in_sizes, int n_in, void* d_out, int out_size, void* d_ws, size_t ws_size, hipStream_t stream) {
    static int grid = 0;
    if (grid == 0) {
        if (n_in != 32 || out_size != M * D || ws_size < WS_END) { fprintf(stderr, "kernel_launch: unexpected problem (n_in %d, out %d, ws %zu); nothing launched\n", n_in, out_size, ws_size); grid = -1; return; }
        int dev = 0, cus = 0, per_cu = 0;
        if (hipGetDevice(&dev) != hipSuccess || hipDeviceGetAttribute(&cus, hipDeviceAttributeMultiprocessorCount, dev) != hipSuccess) { grid = -1; return; }
        if (hipFuncSetAttribute((const void*)fwd_kernel, hipFuncAttributeMaxDynamicSharedMemorySize, LDS_BYTES) != hipSuccess) { fprintf(stderr, "kernel_launch: hipFuncSetAttribute failed\n"); grid = -1; return; }
        if (hipOccupancyMaxActiveBlocksPerMultiprocessor(&per_cu, (const void*)fwd_kernel, NWAVES * 64, LDS_BYTES) != hipSuccess || per_cu < 1)
            fprintf(stderr, "kernel_launch: note: occupancy query reports %d workgroups per CU\n", per_cu);
        (void)hipGetLastError();
        grid = cus;
    }
    if (grid < 0) return;
    if (hipMemsetAsync((char*)d_ws + WS_CTL, 0, CTL_ZERO_BYTES, stream) != hipSuccess) return;
    Args a{};
    for (int i = 0; i < 32; ++i) a.in[i] = (const float*)d_in[i];
    a.out = (float*)d_out; a.ws = (unsigned char*)d_ws;
    if (MK_N_LAUNCHES == 1) {
        a.ph_lo = 0; a.ph_hi = NPHASE;
        hipLaunchKernelGGL(fwd_kernel, dim3(grid), dim3(NWAVES * 64), LDS_BYTES, stream, a);
    } else {
        for (int p = 0; p < NPHASE; ++p) { a.ph_lo = p; a.ph_hi = p + 1; hipLaunchKernelGGL(fwd_kernel, dim3(grid), dim3(NWAVES * 64), LDS_BYTES, stream, a); }
    }
}
```
